# Optimizing an MI355X kernel written in HIP

```python
import jax
import jax.numpy as jnp
from jax import lax
import numpy as np

D_MODEL = 1024
BATCH = 2
SEQ = 8192
DEPTH = 2

HEAD_DIM = 64
D_MIX = D_MODEL
FOX_HEADS = D_MIX // (4 * HEAD_DIM)
FOX_WIDTH = FOX_HEADS * HEAD_DIM
CONV_CH = D_MIX // 4
CONV_TAPS = 31
NSA_HEADS = D_MIX // (2 * HEAD_DIM)
NSA_WIDTH = NSA_HEADS * HEAD_DIM
NSA_KV_GROUPS = 2
NSA_HPG = NSA_HEADS // NSA_KV_GROUPS
NSA_KV_WIDTH = NSA_KV_GROUPS * HEAD_DIM
N_BRANCH = 3
CMP_LEN = 32
CMP_STRIDE = 16
CMP_HIDDEN = 256
SLC_LEN = 64
SLC_TOPK = 16
WINDOW = 512
Q_BLOCK = 128
ROPE_THETA = 500000.0
ROPE_DIM = HEAD_DIM // 4
EPS = 1e-6
NEG_INF = -1e30
FORCED_SCORE = 1e4
IN_SIZES = (FOX_WIDTH, FOX_WIDTH, FOX_WIDTH, FOX_HEADS, FOX_WIDTH,
            2 * CONV_CH, CONV_CH,
            NSA_WIDTH, NSA_KV_WIDTH, NSA_KV_WIDTH, NSA_KV_WIDTH, NSA_KV_WIDTH,
            NSA_KV_WIDTH, NSA_KV_WIDTH, NSA_HEADS * N_BRANCH, NSA_WIDTH)
D_IN = sum(IN_SIZES)

kernel_name = 'hybrid_fox_conformer_nsa'


def rms_norm(x, g):
    xf = x.astype(jnp.float32)
    y = xf * lax.rsqrt(jnp.mean(xf * xf, axis=-1, keepdims=True) + EPS)
    return (y * g.astype(jnp.float32)).astype(x.dtype)


def masked_softmax(s, mask):
    s = jnp.where(mask, s.astype(jnp.float32), NEG_INF)
    return jnp.where(mask, jax.nn.softmax(s, axis=-1), 0.0)


def rope(x, pos):
    half = ROPE_DIM // 2
    inv = ROPE_THETA ** (-jnp.arange(0, ROPE_DIM, 2, dtype=jnp.float32) / ROPE_DIM)
    ang = pos.astype(jnp.float32)[:, None] * inv[None, :]
    cos = jnp.cos(ang)[None, :, None, :].astype(x.dtype)
    sin = jnp.sin(ang)[None, :, None, :].astype(x.dtype)
    x1, x2, rest = x[..., :half], x[..., half:ROPE_DIM], x[..., ROPE_DIM:]
    return jnp.concatenate([x1 * cos - x2 * sin, x1 * sin + x2 * cos, rest], axis=-1)


def fox_attention(q, k, v, f_logit):
    B, T, H, Dh = q.shape
    c = jnp.cumsum(jax.nn.log_sigmoid(f_logit.astype(jnp.float32)), axis=1)
    c = jnp.transpose(c, (0, 2, 1))
    scale = Dh ** -0.5
    kpos = jnp.arange(T)

    def block(i):
        qs = i * Q_BLOCK
        tq = qs + jnp.arange(Q_BLOCK)
        qb = lax.dynamic_slice_in_dim(q, qs, Q_BLOCK, axis=1)
        cb = lax.dynamic_slice_in_dim(c, qs, Q_BLOCK, axis=2)
        s = jnp.einsum('bqhd,bkhd->bhqk', qb, k).astype(jnp.float32) * scale
        s = s + cb[..., :, None] - c[:, :, None, :]
        p = masked_softmax(s, tq[:, None] >= kpos[None, :])
        return jnp.einsum('bhqk,bkhd->bqhd', p.astype(v.dtype), v)

    o = lax.map(block, jnp.arange(T // Q_BLOCK))
    return jnp.moveaxis(o, 0, 1).reshape(B, T, H * Dh)


def conformer_conv(u, conv_w, conv_b, ln_g, ln_b, w_pw):
    a, b = jnp.split(u, 2, axis=-1)
    y = a * jax.nn.sigmoid(b)
    C = y.shape[-1]
    y = lax.conv_general_dilated(
        y, conv_w[:, None, :].astype(y.dtype), window_strides=(1,),
        padding=[(CONV_TAPS - 1, 0)], dimension_numbers=('NWC', 'WIO', 'NWC'),
        feature_group_count=C) + conv_b
    yf = y.astype(jnp.float32)
    mu = jnp.mean(yf, axis=-1, keepdims=True)
    var = jnp.mean(jnp.square(yf - mu), axis=-1, keepdims=True)
    yn = ((yf - mu) * lax.rsqrt(var + EPS) * ln_g + ln_b).astype(y.dtype)
    return jax.nn.silu(yn) @ w_pw


def nsa_attention(q, kc, vc, ks, vs, kw, vw, gate_logit,
                  pe_k, pe_v, k_w1, k_w2, v_w1, v_w2):
    B, T, H, Dh = q.shape
    G = NSA_KV_GROUPS
    dt = q.dtype
    scale = Dh ** -0.5
    pos = jnp.arange(T)
    q = rope(q, pos)
    ks = rope(ks, pos)
    kw = rope(kw, pos)

    n_cmp = (T - CMP_LEN) // CMP_STRIDE + 1
    cmp_start = jnp.arange(n_cmp) * CMP_STRIDE
    cmp_end = cmp_start + CMP_LEN - 1
    cmp_idx = cmp_start[:, None] + jnp.arange(CMP_LEN)[None, :]

    def compress(x, pe, w1, w2):
        blk = x[:, cmp_idx] + pe[None, None, :, None, :]
        blk = jnp.transpose(blk, (0, 1, 3, 2, 4)).reshape(B, n_cmp, G, CMP_LEN * Dh)
        hid = jax.nn.gelu(jnp.einsum('bngi,ih->bngh', blk, w1))
        return jnp.einsum('bngh,ho->bngo', hid, w2)

    k_cmp = rope(compress(kc, pe_k, k_w1, k_w2), cmp_end)
    v_cmp = compress(vc, pe_v, v_w1, v_w2)

    n_slc = T // SLC_LEN
    k_sel = jnp.transpose(ks.reshape(B, n_slc, SLC_LEN, G, Dh), (0, 3, 1, 2, 4))
    v_sel = jnp.transpose(vs.reshape(B, n_slc, SLC_LEN, G, Dh), (0, 3, 1, 2, 4))
    slc_start = jnp.arange(n_slc) * SLC_LEN
    overlap = ((cmp_start[:, None] < slc_start[None, :] + SLC_LEN) &
               (cmp_end[:, None] >= slc_start[None, :])).astype(jnp.float32)
    topk = min(SLC_TOPK, n_slc)
    bi = jnp.arange(B)[:, None, None, None]
    gi = jnp.arange(G)[None, :, None, None]

    kw_p = jnp.pad(kw, ((0, 0), (WINDOW, 0), (0, 0), (0, 0)))
    vw_p = jnp.pad(vw, ((0, 0), (WINDOW, 0), (0, 0), (0, 0)))

    gates = jax.nn.sigmoid(gate_logit.astype(jnp.float32)).reshape(B, T, G, NSA_HPG, N_BRANCH)
    qg = q.reshape(B, T, G, NSA_HPG, Dh)

    def block(i):
        qs = i * Q_BLOCK
        tq = qs + jnp.arange(Q_BLOCK)
        qb = lax.dynamic_slice_in_dim(qg, qs, Q_BLOCK, axis=1)

        s = jnp.einsum('bqghd,bngd->bghqn', qb, k_cmp) * scale
        p_cmp = masked_softmax(s, cmp_end[None, :] <= tq[:, None])
        o_cmp = jnp.einsum('bghqn,bngd->bqghd', p_cmp.astype(dt), v_cmp)

        imp = jnp.einsum('bghqn,nj->bgqj', p_cmp, overlap)
        cur = tq // SLC_LEN
        j = jnp.arange(n_slc)[None, :]
        forced = (j == 0) | (j == cur[:, None]) | (j == cur[:, None] - 1)
        imp = jnp.where(forced, FORCED_SCORE,
                        jnp.where(slc_start[None, :] <= tq[:, None], imp, NEG_INF))
        _, idx = lax.top_k(imp, topk)
        k_g = k_sel[bi, gi, idx]
        v_g = v_sel[bi, gi, idx].reshape(B, G, Q_BLOCK, topk * SLC_LEN, Dh)
        s = jnp.einsum('bqghd,bgqksd->bghqks', qb, k_g) * scale
        s = s.reshape(B, G, NSA_HPG, Q_BLOCK, topk * SLC_LEN)
        key_pos = (idx[..., None] * SLC_LEN + jnp.arange(SLC_LEN)).reshape(
            B, G, 1, Q_BLOCK, topk * SLC_LEN)
        p_slc = masked_softmax(s, key_pos <= tq[:, None])
        o_slc = jnp.einsum('bghqm,bgqmd->bqghd', p_slc.astype(dt), v_g)

        kwb = lax.dynamic_slice_in_dim(kw_p, qs, WINDOW + Q_BLOCK, axis=1)
        vwb = lax.dynamic_slice_in_dim(vw_p, qs, WINDOW + Q_BLOCK, axis=1)
        sp = qs - WINDOW + jnp.arange(WINDOW + Q_BLOCK)
        wmask = ((sp[None, :] >= 0) & (sp[None, :] <= tq[:, None]) &
                 (tq[:, None] - sp[None, :] < WINDOW))
        s = jnp.einsum('bqghd,bkgd->bghqk', qb, kwb) * scale
        o_win = jnp.einsum('bghqk,bkgd->bqghd', masked_softmax(s, wmask).astype(dt), vwb)

        gb = lax.dynamic_slice_in_dim(gates, qs, Q_BLOCK, axis=1)
        o = gb[..., 0:1] * o_cmp + gb[..., 1:2] * o_slc + gb[..., 2:3] * o_win
        return o.astype(dt)

    o = lax.map(block, jnp.arange(T // Q_BLOCK))
    return jnp.moveaxis(o, 0, 1).reshape(B, T, H * Dh)


def hybrid_layer(x, norm_g, w_in, fox_b, conv_w, conv_b, conv_ln_g, conv_ln_b,
                 conv_pw, cmp_pe_k, cmp_pe_v, cmp_k_w1, cmp_k_w2, cmp_v_w1,
                 cmp_v_w2, w_out):
    B, T, _ = x.shape
    h = rms_norm(x, norm_g)
    z = h @ w_in
    split_points = np.cumsum(IN_SIZES)[:-1].tolist()
    (fq, fk, fv, ff, f_gate, glu_in, c_gate,
     nq, nkc, nvc, nks, nvs, nkw, nvw, n_gl, n_gate) = jnp.split(z, split_points, axis=-1)

    def heads(t, n):
        return t.reshape(B, T, n, HEAD_DIM)

    o_a = fox_attention(heads(fq, FOX_HEADS), heads(fk, FOX_HEADS),
                        heads(fv, FOX_HEADS), ff + fox_b) * jax.nn.silu(f_gate)
    o_b = conformer_conv(glu_in, conv_w, conv_b, conv_ln_g, conv_ln_b,
                         conv_pw) * jax.nn.silu(c_gate)
    o_c = nsa_attention(heads(nq, NSA_HEADS), heads(nkc, NSA_KV_GROUPS),
                        heads(nvc, NSA_KV_GROUPS), heads(nks, NSA_KV_GROUPS),
                        heads(nvs, NSA_KV_GROUPS), heads(nkw, NSA_KV_GROUPS),
                        heads(nvw, NSA_KV_GROUPS), n_gl, cmp_pe_k, cmp_pe_v,
                        cmp_k_w1, cmp_k_w2, cmp_v_w1, cmp_v_w2) * jax.nn.silu(n_gate)
    mixed = jnp.concatenate([o_a, o_b, o_c], axis=-1)
    return x + mixed @ w_out


def setup_inputs(seed: int = 0) -> dict:
    key = jax.random.key(seed)
    k = jax.random.split(key, 18)
    L = DEPTH

    def nrm(kk, shape, scale):
        return scale * jax.random.normal(kk, shape, jnp.float32)

    return {
        'x': nrm(k[0], (BATCH, SEQ, D_MODEL), 1.0),
        'norm_g': 1.0 + nrm(k[1], (L, D_MODEL), 0.02),
        'w_in': nrm(k[2], (L, D_MODEL, D_IN), D_MODEL ** -0.5),
        'fox_b': 3.0 + nrm(k[3], (L, FOX_HEADS), 0.5),
        'conv_w': nrm(k[4], (L, CONV_TAPS, CONV_CH), CONV_TAPS ** -0.5),
        'conv_b': nrm(k[5], (L, CONV_CH), 0.02),
        'conv_ln_g': 1.0 + nrm(k[6], (L, CONV_CH), 0.02),
        'conv_ln_b': nrm(k[7], (L, CONV_CH), 0.02),
        'conv_pw': nrm(k[8], (L, CONV_CH, CONV_CH), CONV_CH ** -0.5),
        'cmp_pe_k': nrm(k[9], (L, CMP_LEN, HEAD_DIM), 0.1),
        'cmp_pe_v': nrm(k[10], (L, CMP_LEN, HEAD_DIM), 0.1),
        'cmp_k_w1': nrm(k[11], (L, CMP_LEN * HEAD_DIM, CMP_HIDDEN), (CMP_LEN * HEAD_DIM) ** -0.5),
        'cmp_k_w2': nrm(k[12], (L, CMP_HIDDEN, HEAD_DIM), CMP_HIDDEN ** -0.5),
        'cmp_v_w1': nrm(k[13], (L, CMP_LEN * HEAD_DIM, CMP_HIDDEN), (CMP_LEN * HEAD_DIM) ** -0.5),
        'cmp_v_w2': nrm(k[14], (L, CMP_HIDDEN, HEAD_DIM), CMP_HIDDEN ** -0.5),
        'w_out': nrm(k[15], (L, D_MIX, D_MODEL), D_MIX ** -0.5),
        'final_g': 1.0 + nrm(k[16], (D_MODEL,), 0.02),
    }


def reference(x, norm_g, w_in, fox_b, conv_w, conv_b, conv_ln_g, conv_ln_b,
              conv_pw, cmp_pe_k, cmp_pe_v, cmp_k_w1, cmp_k_w2, cmp_v_w1,
              cmp_v_w2, w_out, final_g):
    for l in range(DEPTH):
        x = hybrid_layer(x, norm_g[l], w_in[l], fox_b[l], conv_w[l], conv_b[l],
                         conv_ln_g[l], conv_ln_b[l], conv_pw[l], cmp_pe_k[l],
                         cmp_pe_v[l], cmp_k_w1[l], cmp_k_w2[l], cmp_v_w1[l],
                         cmp_v_w2[l], w_out[l])
    return rms_norm(x, final_g)
```

```cpp
#include <hip/hip_runtime.h>
#include <hip/hip_cooperative_groups.h>
#include <cstdio>
namespace cg = cooperative_groups;

#ifndef PROBE_REP
#define PROBE_REP 0
#endif
#ifndef EN_FOX
#define EN_FOX 1
#endif
#ifndef EN_NSA
#define EN_NSA 1
#endif

typedef unsigned short u16;
using bf16x8 = __attribute__((ext_vector_type(8))) short;
using f32x16 = __attribute__((ext_vector_type(16))) float;
using u32x4 = __attribute__((ext_vector_type(4))) unsigned;
using u32x2 = __attribute__((ext_vector_type(2))) unsigned;
using f32x4 = __attribute__((ext_vector_type(4))) float;
typedef __attribute__((ext_vector_type(2))) __bf16 bf2_t;
#define DI __device__ __forceinline__
#define EXP2(x) __builtin_amdgcn_exp2f(x)
#define MFMA(a, b, c) __builtin_amdgcn_mfma_f32_32x32x16_bf16((a), (b), (c), 0, 0, 0)

constexpr int T_ = 8192;
constexpr int BT = 16384;
constexpr int NPAD = 3712;
constexpr float LOG2E = 1.4426950408889634f;
constexpr int LDS_BYTES = 67584;

constexpr size_t SZ_WINT = (size_t)NPAD * 1024 * 2;
constexpr size_t OFF_WINT = 0;
constexpr size_t OFF_WOUTT = OFF_WINT + 2 * SZ_WINT;
constexpr size_t OFF_PWT = OFF_WOUTT + 2 * (size_t)1024 * 1024 * 2;
constexpr size_t OFF_W1T = OFF_PWT + 2 * (size_t)256 * 256 * 2;
constexpr size_t OFF_W2T = OFF_W1T + 4 * (size_t)256 * 2048 * 2;
constexpr size_t OFF_CBIAS = OFF_W2T + 4 * (size_t)128 * 256 * 2;
constexpr size_t OFF_ROPE = OFF_CBIAS + 4 * 256 * 4;
constexpr size_t OFF_H = OFF_ROPE + (size_t)8192 * 8 * 2 * 4;
constexpr size_t OFF_OSC = OFF_H;
constexpr size_t OFF_FQ = OFF_H + (size_t)BT * 1024 * 2;
constexpr size_t OFF_FK = OFF_FQ + (size_t)BT * 256 * 2;
constexpr size_t OFF_FVT = OFF_FK + (size_t)BT * 256 * 2;
constexpr size_t OFF_FLOG = OFF_FVT + (size_t)BT * 256 * 2;
constexpr size_t OFF_GATE = OFF_FLOG + (size_t)BT * 4 * 4;
constexpr size_t OFF_GLU = OFF_GATE + (size_t)BT * 1024 * 2;
constexpr size_t OFF_NQ = OFF_GLU + (size_t)BT * 512 * 2;
constexpr size_t OFF_KC = OFF_NQ + (size_t)BT * 512 * 2;
constexpr size_t SZ_KV = (size_t)BT * 128 * 2;
constexpr size_t OFF_VC = OFF_KC + SZ_KV;
constexpr size_t OFF_KS = OFF_VC + SZ_KV;
constexpr size_t OFF_VST = OFF_KS + SZ_KV;
constexpr size_t OFF_KW = OFF_VST + SZ_KV;
constexpr size_t OFF_VWT = OFF_KW + SZ_KV;
constexpr size_t OFF_NGL = OFF_VWT + SZ_KV;
constexpr size_t OFF_KCMP = OFF_NGL + (size_t)BT * 24 * 4;
constexpr size_t OFF_VCMPT = OFF_KCMP + (size_t)4 * 512 * 64 * 2;
constexpr size_t OFF_HID = OFF_VCMPT + (size_t)4 * 512 * 64 * 2;
constexpr size_t OFF_CONVA = OFF_HID + (size_t)32 * 128 * 256 * 2;
constexpr size_t OFF_MIXED = OFF_CONVA + (size_t)BT * 256 * 2;
constexpr size_t OFF_KN2 = OFF_MIXED + (size_t)BT * 1024 * 2;
constexpr size_t OFF_CNT = OFF_KN2 + 256;
constexpr size_t OFF_BAR = OFF_CNT + 256;
constexpr size_t OFF_WTAIL = OFF_BAR + 16384;
constexpr size_t WS_TOTAL = OFF_WTAIL + (size_t)2 * 32 * 1024 * 4;
static_assert(WS_TOTAL <= (size_t)256 * 1024 * 1024, "ws too large");

struct Params {
  const float* x; const float* norm_g; const float* w_in; const float* fox_b; const float* conv_w; const float* conv_b;
  const float* conv_ln_g; const float* conv_ln_b; const float* conv_pw; const float* cmp_pe_k; const float* cmp_pe_v;
  const float* cmp_k_w1; const float* cmp_k_w2; const float* cmp_v_w1; const float* cmp_v_w2; const float* w_out; const float* final_g;
  float* out; char* ws;
};

DI int ltid() { int t = threadIdx.x; asm volatile("" : "+v"(t)); return t; }
DI char* lptr(char* q) { int z = 0; asm volatile("" : "+s"(z)); return q + z; }
#define LDSP(T, a) ((__attribute__((address_space(3))) T*)(a))
DI int tl_of(int ni) { const int t = ltid(); return ((t >> 6) << 4) + 8 * ni + ((t & 31) >> 2); }
DI int h_of() { return (ltid() >> 5) & 1; }
DI u16 f2bf(float x) { __bf16 b = (__bf16)x; return __builtin_bit_cast(u16, b); }
DI unsigned pk2(float x, float y) { bf2_t v; v[0] = (__bf16)x; v[1] = (__bf16)y; return __builtin_bit_cast(unsigned, v); }
DI float bf2f(u16 v) { return __uint_as_float(((unsigned)v) << 16); }
DI float bflo(unsigned v) { return __uint_as_float(v << 16); }
DI float bfhi(unsigned v) { return __uint_as_float(v & 0xffff0000u); }
DI int crow(int reg, int h) { return (reg & 3) + 8 * (reg >> 2) + 4 * h; }
DI float siluf(float x) { return x / (1.f + __expf(-x)); }
DI float sigmf(float x) { return 1.f / (1.f + __expf(-x)); }
DI float geluf(float x) { return 0.5f * x * (1.f + tanhf(0.7978845608028654f * (x + 0.044715f * x * x * x))); }
DI int swz(int row, int chunk) { return row * 128 + ((chunk ^ ((row >> 1) & 7)) << 4); }
DI void zero_acc(f32x16 (&a)[2][2]) {
#pragma unroll
  for (int i = 0; i < 2; ++i)
#pragma unroll
    for (int j = 0; j < 2; ++j)
#pragma unroll
      for (int k = 0; k < 16; ++k) a[i][j][k] = 0.f;
}

DI int swz32(int row, int chunk) { return row * 64 + ((chunk ^ ((row >> 2) & 3)) << 4); }
template <bool SWAP>
DI void gemm_tile(const u16* __restrict__ A, long lda, const u16* __restrict__ B, long ldb, int K, unsigned lds, f32x16 (&acc)[2][2]) {
  const int tid = ltid(), lane = tid & 63, w = tid >> 6, wr = w >> 1, wc = w & 1, r = lane & 31, h = lane >> 5;
  zero_acc(acc);
  const int lrow = tid >> 2, lch = tid & 3;
  const u16* ga = A + (long)lrow * lda + lch * 8;
  const u16* gb = B + (long)lrow * ldb + lch * 8;
  const long a64 = 64 * lda, b64 = 64 * ldb;
  const int n = K >> 5;
  u32x4 s0[4], s1[4], s2[4];
#define GLOAD(S, J) { S[0] = *(const u32x4*)(ga + (J) * 32); S[1] = *(const u32x4*)(ga + a64 + (J) * 32); S[2] = *(const u32x4*)(gb + (J) * 32); S[3] = *(const u32x4*)(gb + b64 + (J) * 32); }
#define SWRITE(S, BUF) { const unsigned bb = lds + (BUF) * 16384; *LDSP(u32x4, bb + swz32(lrow, lch)) = S[0]; *LDSP(u32x4, bb + swz32(lrow + 64, lch)) = S[1]; \
                         *LDSP(u32x4, bb + 8192 + swz32(lrow, lch)) = S[2]; *LDSP(u32x4, bb + 8192 + swz32(lrow + 64, lch)) = S[3]; }
#define COMPUTE(BUF) { const unsigned As = lds + (BUF) * 16384; const unsigned Bs = As + 8192; \
    _Pragma("unroll") for (int ks = 0; ks < 2; ++ks) { bf16x8 af[2], bf[2]; \
      _Pragma("unroll") for (int i = 0; i < 2; ++i) { af[i] = *LDSP(bf16x8, As + swz32(64 * wr + 32 * i + r, 2 * ks + h)); bf[i] = *LDSP(bf16x8, Bs + swz32(64 * wc + 32 * i + r, 2 * ks + h)); } \
      _Pragma("unroll") for (int mi = 0; mi < 2; ++mi) _Pragma("unroll") for (int ni = 0; ni < 2; ++ni) { \
        if (SWAP) acc[mi][ni] = MFMA(bf[ni], af[mi], acc[mi][ni]); else acc[mi][ni] = MFMA(af[mi], bf[ni], acc[mi][ni]); } } }
  GLOAD(s0, 0)
  GLOAD(s1, 1)
  GLOAD(s2, 2)
  __syncthreads();
  SWRITE(s0, 0)
  GLOAD(s0, 3)
  __syncthreads();
  int j = 0, cur = 0;
  while (true) {
    COMPUTE(cur)
    if (j + 1 < n) SWRITE(s1, cur ^ 1)
    if (j + 4 < n) GLOAD(s1, j + 4)
    __syncthreads();
    cur ^= 1; if (++j >= n) break;
    COMPUTE(cur)
    if (j + 1 < n) SWRITE(s2, cur ^ 1)
    if (j + 4 < n) GLOAD(s2, j + 4)
    __syncthreads();
    cur ^= 1; if (++j >= n) break;
    COMPUTE(cur)
    if (j + 1 < n) SWRITE(s0, cur ^ 1)
    if (j + 4 < n) GLOAD(s0, j + 4)
    __syncthreads();
    cur ^= 1; if (++j >= n) break;
  }
#undef GLOAD
#undef SWRITE
#undef COMPUTE
}

DI int win_srccol(int n) {
  if (n < 768) return n;
  if (n < 3072) return n + 4;
  if (n < 3584) return n + 28;
  int i = n - 3584;
  if (i < 4) return 768 + i;
  if (i < 28) return 3076 + (i - 4);
  return -1;
}

DI void transpose_tile(const float* __restrict__ src, int ld, int K, int mapkind, int nsrc, u16* __restrict__ dst, int k0, int n0, unsigned lds) {
  const int tid = ltid(), j = tid & 63, i0 = tid >> 6;
  const int n = n0 + j;
  const int sc = mapkind ? win_srccol(n) : (n < nsrc ? n : -1);
  float v[16];
#pragma unroll
  for (int it = 0; it < 16; ++it) v[it] = (sc >= 0) ? src[(size_t)(k0 + i0 + 4 * it) * ld + sc] : 0.f;
  __syncthreads();
#pragma unroll
  for (int it = 0; it < 16; ++it) *LDSP(float, lds + 4 * ((i0 + 4 * it) * 65 + j)) = v[it];
  __syncthreads();
  const int jn = tid >> 2, kc = (tid & 3) * 16;
  u32x4 o0, o1;
#pragma unroll
  for (int e = 0; e < 4; ++e) {
    o0[e] = pk2(*LDSP(float, lds + 4 * ((kc + 2 * e) * 65 + jn)), *LDSP(float, lds + 4 * ((kc + 2 * e + 1) * 65 + jn)));
    o1[e] = pk2(*LDSP(float, lds + 4 * ((kc + 8 + 2 * e) * 65 + jn)), *LDSP(float, lds + 4 * ((kc + 8 + 2 * e + 1) * 65 + jn)));
  }
  u16* dp = dst + (size_t)(n0 + jn) * K + k0 + kc;
  *(u32x4*)dp = o0;
  *(u32x4*)(dp + 8) = o1;
}

constexpr int P0_PER_LAYER = 928 + 256 + 16 + 256 + 16;
DI void phase0_item(const Params& p, int idx, unsigned lds) {
  const int l = idx / P0_PER_LAYER;
  int r = idx % P0_PER_LAYER;
  char* ws = lptr(p.ws);
  if (r < 928) {
    transpose_tile(p.w_in + (size_t)l * 1024 * 3612, 3612, 1024, 1, 0, (u16*)(ws + OFF_WINT + l * SZ_WINT), (r % 16) * 64, (r / 16) * 64, lds);
    return;
  }
  r -= 928;
  if (r < 256) {
    transpose_tile(p.w_out + (size_t)l * 1024 * 1024, 1024, 1024, 0, 1024, (u16*)(ws + OFF_WOUTT) + (size_t)l * 1024 * 1024, (r % 16) * 64, (r / 16) * 64, lds);
    return;
  }
  r -= 256;
  if (r < 16) {
    transpose_tile(p.conv_pw + (size_t)l * 256 * 256, 256, 256, 0, 256, (u16*)(ws + OFF_PWT) + (size_t)l * 256 * 256, (r % 4) * 64, (r / 4) * 64, lds);
    return;
  }
  r -= 16;
  if (r < 256) {
    const int kv = r >> 7; r &= 127;
    const float* src = (kv ? p.cmp_v_w1 : p.cmp_k_w1) + (size_t)l * 2048 * 256;
    transpose_tile(src, 256, 2048, 0, 256, (u16*)(ws + OFF_W1T) + (size_t)(l * 2 + kv) * 256 * 2048, (r % 32) * 64, (r / 32) * 64, lds);
    return;
  }
  r -= 256;
  {
    const int kv = r >> 3; r &= 7;
    const float* src = (kv ? p.cmp_v_w2 : p.cmp_k_w2) + (size_t)l * 256 * 64;
    transpose_tile(src, 64, 256, 0, 64, (u16*)(ws + OFF_W2T) + (size_t)(l * 2 + kv) * 128 * 256, (r % 4) * 64, (r / 4) * 64, lds);
  }
}

DI void cbias_item(const Params& p, int item, unsigned lds) {
  const int idx = item >> 3, ng = item & 7;
  const int l = idx >> 1, kv = idx & 1;
  const float* pe = (kv ? p.cmp_pe_v : p.cmp_pe_k) + (size_t)l * 2048;
  const float* w1 = (kv ? p.cmp_v_w1 : p.cmp_k_w1) + (size_t)l * 2048 * 256;
  const int tid = ltid(), nn = tid & 31, ksl = tid >> 5;
  const int n = ng * 32 + nn;
  float s0 = 0.f, s1 = 0.f, s2 = 0.f, s3 = 0.f;
  const float* wp = w1 + (size_t)(ksl * 256) * 256 + n;
  const float* pp = pe + ksl * 256;
#pragma unroll 4
  for (int i = 0; i < 256; i += 4) {
    s0 = fmaf(pp[i], wp[(size_t)i * 256], s0);
    s1 = fmaf(pp[i + 1], wp[(size_t)(i + 1) * 256], s1);
    s2 = fmaf(pp[i + 2], wp[(size_t)(i + 2) * 256], s2);
    s3 = fmaf(pp[i + 3], wp[(size_t)(i + 3) * 256], s3);
  }
  __syncthreads();
  *LDSP(float, lds + 4 * tid) = (s0 + s1) + (s2 + s3);
  __syncthreads();
  if (tid < 32) {
    float t = 0.f;
#pragma unroll
    for (int k = 0; k < 8; ++k) t += *LDSP(float, lds + 4 * (k * 32 + tid));
    ((float*)(p.ws + OFF_CBIAS))[idx * 256 + n] = t;
  }
}

DI void rope_item(const Params& p, int idx) {
  const int e = idx * 256 + ltid();
  const int pos = e >> 3, i = e & 7;
  const float inv = powf(500000.0f, -(float)(2 * i) / 16.0f);
  const float ang = (float)pos * inv;
  float2 cs; cs.x = cosf(ang); cs.y = sinf(ang);
  ((float2*)(p.ws + OFF_ROPE))[e] = cs;
}

DI void wtail_item(const Params& p, int item) {
  const int l = item >> 5, j = item & 31;
  float* dst = (float*)(p.ws + OFF_WTAIL) + (size_t)item * 1024;
  const int tid = ltid();
  const int col = (j < 4) ? 768 + j : 3076 + (j - 4);
#pragma unroll
  for (int i = 0; i < 4; ++i) {
    const int k = tid + 256 * i;
    dst[k] = (j < 28) ? p.w_in[((size_t)l * 1024 + k) * 3612 + col] : 0.f;
  }
}

DI void norm_item(const float* __restrict__ src, const float* __restrict__ g, u16* dstb, float* dstf, int item,
                  const float* __restrict__ wt, const float* __restrict__ foxb, float* flog, float* ngl) {
  const int tid_ = ltid(); const int lane = tid_ & 63, w = tid_ >> 6;
  const int row = item * 4 + w;
  const float4* s4 = (const float4*)(src + (size_t)row * 1024);
  float4 v[4];
  float ss = 0.f;
#pragma unroll
  for (int i = 0; i < 4; ++i) { v[i] = s4[lane + 64 * i]; ss += v[i].x * v[i].x + v[i].y * v[i].y + v[i].z * v[i].z + v[i].w * v[i].w; }
#pragma unroll
  for (int o = 32; o > 0; o >>= 1) ss += __shfl_xor(ss, o);
  const float rs = rsqrtf(ss * (1.0f / 1024.0f) + 1e-6f);
#pragma unroll
  for (int i = 0; i < 4; ++i) {
    float4 gg = ((const float4*)g)[lane + 64 * i];
    float4 o = {v[i].x * rs * gg.x, v[i].y * rs * gg.y, v[i].z * rs * gg.z, v[i].w * rs * gg.w};
    v[i] = o;
    if (dstb) {
      u32x2 pk; pk[0] = pk2(o.x, o.y); pk[1] = pk2(o.z, o.w);
      *(u32x2*)(dstb + (size_t)row * 1024 + (lane + 64 * i) * 4) = pk;
    } else {
      ((float4*)(dstf + (size_t)row * 1024))[lane + 64 * i] = o;
    }
  }
  if (wt) {
    float a[32];
#pragma unroll
    for (int j = 0; j < 32; ++j) {
      float acc = 0.f;
      if (j < 28) {
#pragma unroll
        for (int i = 0; i < 4; ++i) {
          const float4 ww = ((const float4*)(wt + (size_t)j * 1024))[lane + 64 * i];
          acc = fmaf(v[i].x, ww.x, acc); acc = fmaf(v[i].y, ww.y, acc); acc = fmaf(v[i].z, ww.z, acc); acc = fmaf(v[i].w, ww.w, acc);
        }
      }
      a[j] = acc;
    }
#pragma unroll
    for (int t = 0; t < 16; ++t) { const bool up = (lane & 32) != 0; const float send = up ? a[t] : a[t + 16]; const float keep = up ? a[t + 16] : a[t]; a[t] = keep + __shfl_xor(send, 32); }
#pragma unroll
    for (int t = 0; t < 8; ++t) { const bool up = (lane & 16) != 0; const float send = up ? a[t] : a[t + 8]; const float keep = up ? a[t + 8] : a[t]; a[t] = keep + __shfl_xor(send, 16); }
#pragma unroll
    for (int t = 0; t < 4; ++t) { const bool up = (lane & 8) != 0; const float send = up ? a[t] : a[t + 4]; const float keep = up ? a[t + 4] : a[t]; a[t] = keep + __shfl_xor(send, 8); }
#pragma unroll
    for (int t = 0; t < 2; ++t) { const bool up = (lane & 4) != 0; const float send = up ? a[t] : a[t + 2]; const float keep = up ? a[t + 2] : a[t]; a[t] = keep + __shfl_xor(send, 4); }
    { const bool up = (lane & 2) != 0; const float send = up ? a[0] : a[1]; const float keep = up ? a[1] : a[0]; a[0] = keep + __shfl_xor(send, 2); }
    a[0] += __shfl_xor(a[0], 1);
    const int col = lane >> 1;
    if ((lane & 1) == 0) {
      const float val = a[0];
      if (col < 4) {
        const float xx = val + foxb[col];
        flog[(size_t)row * 4 + col] = fminf(xx, 0.f) - __logf(1.f + __expf(-fabsf(xx)));
      } else if (col < 28) {
        ngl[(size_t)row * 24 + (col - 4)] = sigmf(val);
      }
    }
  }
}

DI void gemm1_item(const Params& p, int l, int item, unsigned lds) {
  const int mt = item / 29, nt = item % 29;
  const int m0 = mt * 128;
  char* ws = lptr(p.ws);
  const u16* A = (const u16*)(ws + OFF_H) + (size_t)m0 * 1024;
  const u16* B = (const u16*)(ws + OFF_WINT + l * SZ_WINT) + (size_t)nt * 128 * 1024;
  const bool swap = (nt == 4 || nt == 5 || nt == 21 || nt == 23);
  f32x16 acc[2][2];
  if (swap) gemm_tile<true>(A, 1024, B, 1024, 1024, lds, acc);
  else gemm_tile<false>(A, 1024, B, 1024, 1024, lds, acc);
  const int tid = ltid(), lane = tid & 63, w = tid >> 6, wr = w >> 1, wc = w & 1, r = lane & 31, h = lane >> 5;
  const int b = m0 >> 13, t0 = m0 & 8191;
  if (swap) {
    u16* base;
    if (nt == 4 || nt == 5) { const int head = (nt - 4) * 2 + wc; base = (u16*)(ws + OFF_FVT) + (size_t)(b * 4 + head) * 64 * T_; }
    else if (nt == 21) base = (u16*)(ws + OFF_VST) + (size_t)(b * 2 + wc) * 64 * T_;
    else base = (u16*)(ws + OFF_VWT) + (size_t)(b * 2 + wc) * 64 * T_;
#pragma unroll
    for (int mi = 0; mi < 2; ++mi)
#pragma unroll
      for (int ni = 0; ni < 2; ++ni)
#pragma unroll
        for (int reg = 0; reg < 16; ++reg) {
          const int d = 32 * ni + crow(reg, h);
          const int t = t0 + 64 * wr + 32 * mi + r;
          base[(size_t)d * T_ + t] = f2bf(acc[mi][ni][reg]);
        }
    return;
  }
  if (nt < 4 || nt == 18 || nt == 19 || nt == 20 || nt == 22 || (nt >= 14 && nt <= 17)) {
    u16* base; long rstride; float scale = 1.f; bool rope = false;
    if (nt < 2) { base = (u16*)(ws + OFF_FQ) + ((size_t)(b * 4 + nt * 2 + wc) * T_ + t0) * 64; rstride = 64; scale = 0.125f; }
    else if (nt < 4) { base = (u16*)(ws + OFF_FK) + ((size_t)(b * 4 + (nt - 2) * 2 + wc) * T_ + t0) * 64; rstride = 64; }
    else if (nt >= 14 && nt <= 17) {
      const int head8 = (nt - 14) * 2 + wc, g = head8 >> 2, hh = head8 & 3;
      base = (u16*)(ws + OFF_NQ) + (((size_t)(b * 2 + g) * T_ + t0) * 4 + hh) * 64; rstride = 256; scale = 0.125f; rope = true;
    } else {
      const size_t off = (nt == 18) ? OFF_KC : (nt == 19) ? OFF_VC : (nt == 20) ? OFF_KS : OFF_KW;
      base = (u16*)(ws + off) + ((size_t)(b * 2 + wc) * T_ + t0) * 64; rstride = 64; rope = (nt == 20 || nt == 22);
    }
    const float2* rt = (const float2*)(ws + OFF_ROPE);
    if (nt == 2 || nt == 3) {
      float mxn = 0.f;
#pragma unroll
      for (int mi = 0; mi < 2; ++mi)
#pragma unroll
        for (int reg = 0; reg < 16; ++reg) {
          const float a0 = bf2f(f2bf(acc[mi][0][reg])), a1 = bf2f(f2bf(acc[mi][1][reg]));
          float ss = a0 * a0 + a1 * a1;
          ss += __shfl_xor(ss, 1); ss += __shfl_xor(ss, 2); ss += __shfl_xor(ss, 4); ss += __shfl_xor(ss, 8); ss += __shfl_xor(ss, 16);
          mxn = fmaxf(mxn, ss);
        }
      mxn = fmaxf(mxn, __shfl_xor(mxn, 32));
      if (lane == 0) atomicMax((unsigned*)(ws + OFF_KN2) + l * 8 + b * 4 + (nt - 2) * 2 + wc, __float_as_uint(mxn));
    }
#pragma unroll
    for (int mi = 0; mi < 2; ++mi)
#pragma unroll
      for (int ni = 0; ni < 2; ++ni)
#pragma unroll
        for (int reg = 0; reg < 16; ++reg) {
          const int row = 64 * wr + 32 * mi + crow(reg, h);
          float v = acc[mi][ni][reg];
          if (ni == 0 && rope) {
            const float pv = __shfl_xor(v, 8);
            if (r < 16) {
              const float2 cs = rt[(t0 + row) * 8 + (r & 7)];
              v = (r & 8) ? (pv * cs.y + v * cs.x) : (v * cs.x - pv * cs.y);
            }
          }
          base[(size_t)row * rstride + 32 * ni + r] = f2bf(v * scale);
        }
    return;
  }
  if (nt == 28) {
    float* flog = (float*)(ws + OFF_FLOG);
    float* ngl = (float*)(ws + OFF_NGL);
    if (wc == 0) {
      const int col = r;
      const float fb = (col < 4) ? p.fox_b[l * 4 + col] : 0.f;
#pragma unroll
      for (int mi = 0; mi < 2; ++mi)
#pragma unroll
        for (int reg = 0; reg < 16; ++reg) {
          const int m = m0 + 64 * wr + 32 * mi + crow(reg, h);
          const float v = acc[mi][0][reg];
          if (col < 4) {
            const float xx = v + fb;
            flog[(size_t)m * 4 + col] = fminf(xx, 0.f) - __logf(1.f + __expf(-fabsf(xx)));
          } else if (col < 28) {
            ngl[(size_t)m * 24 + (col - 4)] = sigmf(v);
          }
        }
    }
    return;
  }
  {
    u16* base; int ld; bool silu = true;
    if (nt == 6 || nt == 7) { base = (u16*)(ws + OFF_GATE) + (nt - 6) * 128; ld = 1024; }
    else if (nt >= 8 && nt <= 11) { base = (u16*)(ws + OFF_GLU) + (nt - 8) * 128; ld = 512; silu = false; }
    else if (nt == 12 || nt == 13) { base = (u16*)(ws + OFF_GATE) + 256 + (nt - 12) * 128; ld = 1024; }
    else { base = (u16*)(ws + OFF_GATE) + 512 + (nt - 24) * 128; ld = 1024; }
#pragma unroll
    for (int mi = 0; mi < 2; ++mi)
#pragma unroll
      for (int ni = 0; ni < 2; ++ni)
#pragma unroll
        for (int reg = 0; reg < 16; ++reg) {
          const int m = m0 + 64 * wr + 32 * mi + crow(reg, h);
          float v = acc[mi][ni][reg];
          if (silu) v = siluf(v);
          base[(size_t)m * ld + 64 * wc + 32 * ni + r] = f2bf(v);
        }
  }
}

DI void tail_item(const Params& p, int l, int mt) {
  char* ws = lptr(p.ws);
  const int tid = ltid(), lane = tid & 63, w = tid >> 6, r = lane & 31, h = lane >> 5;
  const int m0 = mt * 128;
  const u16* ap = (const u16*)(ws + OFF_H) + (size_t)(m0 + 32 * w + r) * 1024 + 8 * h;
  const u16* bp = (const u16*)(ws + OFF_WINT + l * SZ_WINT) + (size_t)(3584 + r) * 1024 + 8 * h;
  f32x16 acc0, acc1;
#pragma unroll
  for (int k = 0; k < 16; ++k) { acc0[k] = 0.f; acc1[k] = 0.f; }
  for (int kb = 0; kb < 8; ++kb) {
    bf16x8 af[8], bf[8];
#pragma unroll
    for (int ks = 0; ks < 8; ++ks) { af[ks] = *(const bf16x8*)(ap + (kb * 8 + ks) * 16); bf[ks] = *(const bf16x8*)(bp + (kb * 8 + ks) * 16); }
#pragma unroll
    for (int ks = 0; ks < 8; ks += 2) { acc0 = MFMA(af[ks], bf[ks], acc0); acc1 = MFMA(af[ks + 1], bf[ks + 1], acc1); }
  }
  float* flog = (float*)(ws + OFF_FLOG);
  float* ngl = (float*)(ws + OFF_NGL);
  const int col = r;
  const float fb = (col < 4) ? p.fox_b[l * 4 + col] : 0.f;
#pragma unroll
  for (int reg = 0; reg < 16; ++reg) {
    const int m = m0 + 32 * w + crow(reg, h);
    const float v = acc0[reg] + acc1[reg];
    if (col < 4) {
      const float xx = v + fb;
      flog[(size_t)m * 4 + col] = fminf(xx, 0.f) - __logf(1.f + __expf(-fabsf(xx)));
    } else if (col < 28) {
      ngl[(size_t)m * 24 + (col - 4)] = sigmf(v);
    }
  }
}

DI void gemm2_item(const Params& p, int l, int item, unsigned lds) {
  const int mt = item >> 3, nt = item & 7;
  const int m0 = mt * 128, n0 = nt * 128;
  char* ws = lptr(p.ws);
  const u16* A = (const u16*)(ws + OFF_MIXED) + (size_t)m0 * 1024;
  const u16* B = (const u16*)(ws + OFF_WOUTT) + (size_t)l * 1024 * 1024 + (size_t)n0 * 1024;
  f32x16 acc[2][2];
  gemm_tile<false>(A, 1024, B, 1024, 1024, lds, acc);
  const int tid = ltid(), lane = tid & 63, w = tid >> 6, wr = w >> 1, wc = w & 1, r = lane & 31, h = lane >> 5;
  const float* res = (l == 0) ? p.x : p.out;
#pragma unroll
  for (int mi = 0; mi < 2; ++mi)
#pragma unroll
    for (int ni = 0; ni < 2; ++ni)
#pragma unroll
      for (int reg = 0; reg < 16; ++reg) {
        const size_t idx = (size_t)(m0 + 64 * wr + 32 * mi + crow(reg, h)) * 1024 + n0 + 64 * wc + 32 * ni + r;
        p.out[idx] = res[idx] + acc[mi][ni][reg];
      }
}

DI void conv_item(const Params& p, int l, int item, unsigned lds) {
  char* ws = lptr(p.ws);
  const int m0 = item * 64, t0 = m0 & 8191;
  const int tid = ltid(), lane = tid & 63, w = tid >> 6;
  const u16* glu = (const u16*)(ws + OFF_GLU);
  const unsigned at = lds + 32768;
  {
    f32x4 wt[31];
    const float* cw = p.conv_w + (size_t)l * 31 * 256 + lane * 4;
#pragma unroll
    for (int k = 0; k < 31; ++k) wt[k] = *(const f32x4*)(cw + k * 256);
    const float4 cb = *(const float4*)(p.conv_b + l * 256 + lane * 4);
    const float4 lg = *(const float4*)(p.conv_ln_g + l * 256 + lane * 4);
    const float4 lb = *(const float4*)(p.conv_ln_b + l * 256 + lane * 4);
    for (int sub = 0; sub < 2; ++sub) {
      const int ts = t0 + 32 * sub;
      __syncthreads();
      {
        const int c8 = (tid & 31) * 8, rsub = tid >> 5;
#pragma unroll
        for (int pb = 0; pb < 8; pb += 4) {
          u32x4 av[4], bv[4];
#pragma unroll
          for (int q = 0; q < 4; ++q) {
            const int i = (pb + q) * 8 + rsub;
            int t = ts - 30 + i; if (t < 0) t = 0; if (t > T_ - 1) t = T_ - 1;
            const size_t m = (size_t)(m0 - t0 + t);
            av[q] = *(const u32x4*)(glu + m * 512 + c8);
            bv[q] = *(const u32x4*)(glu + m * 512 + 256 + c8);
          }
#pragma unroll
          for (int q = 0; q < 4; ++q) {
            const int i = (pb + q) * 8 + rsub;
            const bool ok = (ts - 30 + i) >= 0;
            u32x4 yv;
#pragma unroll
            for (int e = 0; e < 4; ++e) {
              const unsigned y = pk2(bflo(av[q][e]) * sigmf(bflo(bv[q][e])), bfhi(av[q][e]) * sigmf(bfhi(bv[q][e])));
              yv[e] = ok ? y : 0u;
            }
            if (i < 62) *LDSP(u32x4, lds + i * 512 + c8 * 2) = yv;
          }
        }
      }
      __syncthreads();
#pragma unroll 2
      for (int j = 0; j < 8; ++j) {
        const int tt = 8 * w + j;
        float4 o = cb;
#pragma unroll
        for (int k = 0; k < 31; ++k) {
          const u32x2 yy = *LDSP(u32x2, lds + (tt + k) * 512 + lane * 8);
          o.x = fmaf(wt[k][0], bflo(yy[0]), o.x);
          o.y = fmaf(wt[k][1], bfhi(yy[0]), o.y);
          o.z = fmaf(wt[k][2], bflo(yy[1]), o.z);
          o.w = fmaf(wt[k][3], bfhi(yy[1]), o.w);
        }
        float s = o.x + o.y + o.z + o.w;
#pragma unroll
        for (int of = 32; of > 0; of >>= 1) s += __shfl_xor(s, of);
        const float mu = s * (1.f / 256.f);
        const float dx = o.x - mu, dy = o.y - mu, dz = o.z - mu, dw = o.w - mu;
        float vs = dx * dx + dy * dy + dz * dz + dw * dw;
#pragma unroll
        for (int of = 32; of > 0; of >>= 1) vs += __shfl_xor(vs, of);
        const float rs = rsqrtf(vs * (1.f / 256.f) + 1e-6f);
        const float y0 = siluf(dx * rs * lg.x + lb.x), y1 = siluf(dy * rs * lg.y + lb.y);
        const float y2 = siluf(dz * rs * lg.z + lb.z), y3 = siluf(dw * rs * lg.w + lb.w);
        u32x2 pk; pk[0] = pk2(y0, y1); pk[1] = pk2(y2, y3);
        const int row = 32 * sub + tt;
        *LDSP(u32x2, at + row * 512 + (((lane >> 1) ^ (row & 15)) << 4) + 8 * (lane & 1)) = pk;
      }
    }
  }
  __syncthreads();
  const int r = lane & 31, h = lane >> 5;
  const u16* pw = (const u16*)(ws + OFF_PWT) + (size_t)l * 65536 + (size_t)(64 * w + r) * 256 + 8 * h;
  f32x16 acc[2][2];
  zero_acc(acc);
#pragma unroll
  for (int kb = 0; kb < 2; ++kb) {
    bf16x8 bfr[8][2];
#pragma unroll
    for (int ks = 0; ks < 8; ++ks)
#pragma unroll
      for (int ni = 0; ni < 2; ++ni) bfr[ks][ni] = *(const bf16x8*)(pw + (size_t)ni * 32 * 256 + (kb * 8 + ks) * 16);
#pragma unroll
    for (int ks = 0; ks < 8; ++ks) {
      const int kk = kb * 8 + ks;
      bf16x8 af[2];
#pragma unroll
      for (int mi = 0; mi < 2; ++mi) { const int row = 32 * mi + r; af[mi] = *LDSP(bf16x8, at + row * 512 + (((2 * kk + h) ^ (row & 15)) << 4)); }
#pragma unroll
      for (int mi = 0; mi < 2; ++mi)
#pragma unroll
        for (int ni = 0; ni < 2; ++ni) acc[mi][ni] = MFMA(af[mi], bfr[ks][ni], acc[mi][ni]);
    }
  }
  const u16* gate = (const u16*)(ws + OFF_GATE);
  u16* mixed = (u16*)(ws + OFF_MIXED);
#pragma unroll
  for (int mi = 0; mi < 2; ++mi)
#pragma unroll
    for (int ni = 0; ni < 2; ++ni)
#pragma unroll
      for (int reg = 0; reg < 16; ++reg) {
        const size_t idx = (size_t)(m0 + 32 * mi + crow(reg, h)) * 1024 + 256 + 64 * w + 32 * ni + r;
        mixed[idx] = f2bf(acc[mi][ni][reg] * bf2f(gate[idx]));
      }
}

DI void compress_item(const Params& p, int l, int item64, unsigned lds) {
  char* ws = lptr(p.ws);
  const int nh = item64 & 1, item = item64 >> 1;
  const int mtile = item & 3, kv = (item >> 2) & 1, bg = item >> 3;
  const u16* src = (const u16*)(ws + (kv ? OFF_VC : OFF_KC)) + ((size_t)bg * T_ + (size_t)16 * 128 * mtile) * 64;
  const u16* w1t = (const u16*)(ws + OFF_W1T) + (size_t)(l * 2 + kv) * 256 * 2048;
  const u16* w2t = (const u16*)(ws + OFF_W2T) + (size_t)(l * 2 + kv) * 128 * 256;
  const float* bias = (const float*)(ws + OFF_CBIAS) + (l * 2 + kv) * 256;
  u16* hid = (u16*)(ws + OFF_HID) + (size_t)item * 128 * 256;
  const int tid = ltid(), lane = tid & 63, w = tid >> 6, wr = w >> 1, wc = w & 1, r = lane & 31, h = lane >> 5;
  {
    f32x16 acc[2][2];
    gemm_tile<false>(src, 1024, w1t + (size_t)nh * 128 * 2048, 2048, 2048, lds, acc);
#pragma unroll
    for (int ni = 0; ni < 2; ++ni) {
      const int col = nh * 128 + 64 * wc + 32 * ni + r;
      const float bb = bias[col];
#pragma unroll
      for (int mi = 0; mi < 2; ++mi)
#pragma unroll
        for (int reg = 0; reg < 16; ++reg) {
          const int row = 64 * wr + 32 * mi + crow(reg, h);
          hid[(size_t)row * 256 + col] = f2bf(geluf(acc[mi][ni][reg] + bb));
        }
    }
  }
  __threadfence();
  __syncthreads();
  if (tid == 0) {
    const int old = atomicAdd((int*)(ws + OFF_CNT) + l * 32 + item, 1);
    *LDSP(int, lds) = old;
  }
  __syncthreads();
  const int arrived = *LDSP(int, lds);
  if (arrived == 0) return;
  __threadfence();
  f32x16 acc[2][2];
  if (kv == 0) {
    gemm_tile<false>(hid, 256, w2t, 256, 256, lds, acc);
    if (wc == 0) {
      u16* kcmp = (u16*)(ws + OFF_KCMP) + (size_t)bg * 512 * 64;
      const float2* rt = (const float2*)(ws + OFF_ROPE);
#pragma unroll
      for (int mi = 0; mi < 2; ++mi)
#pragma unroll
        for (int ni = 0; ni < 2; ++ni)
#pragma unroll
          for (int reg = 0; reg < 16; ++reg) {
            const int n = 128 * mtile + 64 * wr + 32 * mi + crow(reg, h);
            float v = acc[mi][ni][reg];
            if (ni == 0) {
              const float pv = __shfl_xor(v, 8);
              if (r < 16) {
                int pos = 16 * n + 31; if (pos > 8191) pos = 8191;
                const float2 cs = rt[pos * 8 + (r & 7)];
                v = (r & 8) ? (pv * cs.y + v * cs.x) : (v * cs.x - pv * cs.y);
              }
            }
            kcmp[(size_t)n * 64 + 32 * ni + r] = f2bf(v);
          }
    }
  } else {
    gemm_tile<true>(hid, 256, w2t, 256, 256, lds, acc);
    if (wc == 0) {
      u16* vcmpT = (u16*)(ws + OFF_VCMPT) + (size_t)bg * 64 * 512;
#pragma unroll
      for (int mi = 0; mi < 2; ++mi)
#pragma unroll
        for (int ni = 0; ni < 2; ++ni)
#pragma unroll
          for (int reg = 0; reg < 16; ++reg) {
            const int n = 128 * mtile + 64 * wr + 32 * mi + r;
            const int d = 32 * ni + crow(reg, h);
            vcmpT[(size_t)d * 512 + n] = (n < 511) ? f2bf(acc[mi][ni][reg]) : (u16)0;
          }
    }
  }
  asm volatile("s_waitcnt vmcnt(0)" ::: "memory");
  __syncthreads();
  if (tid == 0) {
    __builtin_amdgcn_fence(__ATOMIC_RELEASE, "agent");
    asm volatile("s_waitcnt vmcnt(0)" ::: "memory");
    __hip_atomic_fetch_add((unsigned*)(ws + OFF_BAR) + 3800 + l * 4 + bg, 1u, __ATOMIC_RELAXED, __HIP_MEMORY_SCOPE_AGENT);
  }
}

struct TileRegs { u32x4 k0, k1, v0, v1; };
DI void tile_gload(TileRegs& tr, const u16* __restrict__ kbase, long kstride, const u16* __restrict__ vbase, long vstride) {
  const int tid = ltid(), row = tid >> 2, c0 = (tid & 3) * 2;
  const u16* kp = kbase + (long)row * kstride + c0 * 8;
  const u16* vp = vbase + (long)row * vstride + c0 * 8;
  tr.k0 = *(const u32x4*)kp; tr.k1 = *(const u32x4*)(kp + 8);
  tr.v0 = *(const u32x4*)vp; tr.v1 = *(const u32x4*)(vp + 8);
}
DI void tile_swrite(const TileRegs& tr, unsigned buf) {
  const int tid = ltid(), row = tid >> 2, c0 = (tid & 3) * 2;
  *LDSP(u32x4, buf + swz(row, c0)) = tr.k0;
  *LDSP(u32x4, buf + swz(row, c0 + 1)) = tr.k1;
  *LDSP(u32x4, buf + 8192 + swz(row, c0)) = tr.v0;
  *LDSP(u32x4, buf + 8192 + swz(row, c0 + 1)) = tr.v1;
}
DI void load_qfrags(bf16x8 (&QB)[2][4], const u16* __restrict__ qrows  ) {
  const int lane = ltid() & 63, r = lane & 31, h = lane >> 5;
#pragma unroll
  for (int ni = 0; ni < 2; ++ni)
#pragma unroll
    for (int ks = 0; ks < 4; ++ks) QB[ni][ks] = *(const bf16x8*)(qrows + (size_t)(32 * ni + r) * 64 + 16 * ks + 8 * h);
}
DI float dpp_xor1(float x) { return __builtin_bit_cast(float, __builtin_amdgcn_mov_dpp(__builtin_bit_cast(int, x), 0xB1, 0xF, 0xF, true)); }
DI float dpp_xor2(float x) { return __builtin_bit_cast(float, __builtin_amdgcn_mov_dpp(__builtin_bit_cast(int, x), 0x4E, 0xF, 0xF, true)); }
DI int dpp_xor1i(int x) { return __builtin_amdgcn_mov_dpp(x, 0xB1, 0xF, 0xF, true); }
DI int dpp_xor2i(int x) { return __builtin_amdgcn_mov_dpp(x, 0x4E, 0xF, 0xF, true); }
DI int dpp_hmi(int x) { return __builtin_amdgcn_mov_dpp(x, 0x141, 0xF, 0xF, true); }
DI float xhalf_max(float x) {
  const unsigned u = __float_as_uint(x);
  const auto rr = __builtin_amdgcn_permlane32_swap(u, u, false, false);
  return fmaxf(__uint_as_float(rr[0]), __uint_as_float(rr[1]));
}
DI float xhalf_sum(float x) {
  const unsigned u = __float_as_uint(x);
  const auto rr = __builtin_amdgcn_permlane32_swap(u, u, false, false);
  return __uint_as_float(rr[0]) + __uint_as_float(rr[1]);
}
template <int MODE, bool BIAS = false>
DI void attn_step1(const bf16x8 (&QB)[2][4], const unsigned Ks, f32x16 (&ot)[2][2], float (&m)[2], float (&l)[2], const int bnd, const bool rowok, const float sc2,
                   const bool first, const float cq = 0.f, const unsigned ck = 0u) {
  const int lane = ltid() & 63, r = lane & 31, h = lane >> 5;
  f32x16 s0, s1;
#pragma unroll
  for (int k = 0; k < 16; ++k) { s0[k] = 0.f; s1[k] = 0.f; }
#pragma unroll
  for (int ks = 0; ks < 4; ++ks) {
    const bf16x8 k0 = *LDSP(bf16x8, Ks + swz(r, 2 * ks + h));
    const bf16x8 k1 = *LDSP(bf16x8, Ks + swz(32 + r, 2 * ks + h));
    s0 = MFMA(k0, QB[0][ks], s0);
    s1 = MFMA(k1, QB[0][ks], s1);
  }
  if (BIAS) {
#pragma unroll
    for (int g4 = 0; g4 < 4; ++g4) {
      const f32x4 ca = *LDSP(f32x4, ck + 4 * (8 * g4 + 4 * h));
      const f32x4 cb = *LDSP(f32x4, ck + 4 * (32 + 8 * g4 + 4 * h));
#pragma unroll
      for (int e = 0; e < 4; ++e) {
        s0[4 * g4 + e] = fmaf(s0[4 * g4 + e], LOG2E, cq - ca[e]);
        s1[4 * g4 + e] = fmaf(s1[4 * g4 + e], LOG2E, cq - cb[e]);
      }
    }
  }
  if (MODE == 1) {
#pragma unroll
    for (int reg = 0; reg < 16; ++reg) {
      const int keyc = (reg & 3) + 8 * (reg >> 2);
      s0[reg] = (keyc <= bnd) ? s0[reg] : -1e30f;
      s1[reg] = (keyc + 32 <= bnd) ? s1[reg] : -1e30f;
    }
  }
  if (MODE == 2) {
#pragma unroll
    for (int reg = 0; reg < 16; ++reg) {
      const int keyc = (reg & 3) + 8 * (reg >> 2);
      s0[reg] = (keyc >= bnd) ? s0[reg] : -1e30f;
      s1[reg] = (keyc + 32 >= bnd) ? s1[reg] : -1e30f;
    }
  }
  if (first) {
    float mx = fmaxf(s0[0], s1[0]);
#pragma unroll
    for (int reg = 1; reg < 16; ++reg) mx = fmaxf(mx, fmaxf(s0[reg], s1[reg]));
    mx = xhalf_max(mx);
    if (MODE == 3) mx = rowok ? mx : -1e30f;
    m[0] = fmaxf(-1e20f, mx);
  }
  float mb = -m[0] * sc2;
  if (MODE == 3) mb = rowok ? mb : -__builtin_inff();
  float rs0 = 0.f, rs1 = 0.f;
#pragma unroll
  for (int reg = 0; reg < 16; ++reg) {
    const float p0 = EXP2(fmaf(s0[reg], sc2, mb)); s0[reg] = p0; rs0 += p0;
    const float p1 = EXP2(fmaf(s1[reg], sc2, mb)); s1[reg] = p1; rs1 += p1;
  }
  l[0] += xhalf_sum(rs0 + rs1);
  const unsigned Vs = Ks + 8192;
#pragma unroll
  for (int kk = 0; kk < 4; ++kk) {
    const int mi = kk >> 1, s = kk & 1;
    u32x4 pk;
#pragma unroll
    for (int i = 0; i < 4; ++i) pk[i] = mi ? pk2(s1[8 * s + 2 * i], s1[8 * s + 2 * i + 1]) : pk2(s0[8 * s + 2 * i], s0[8 * s + 2 * i + 1]);
    const bf16x8 pf = __builtin_bit_cast(bf16x8, pk);
    bf16x8 vf[2];
#pragma unroll
    for (int di = 0; di < 2; ++di) {
      const int d = 32 * di + r;
      const int sw = (d >> 1) & 7;
      const u32x2 lo = *LDSP(u32x2, Vs + d * 128 + (((4 * mi + 2 * s) ^ sw) << 4) + 8 * h);
      const u32x2 hi = *LDSP(u32x2, Vs + d * 128 + (((4 * mi + 2 * s + 1) ^ sw) << 4) + 8 * h);
      u32x4 vv; vv[0] = lo[0]; vv[1] = lo[1]; vv[2] = hi[0]; vv[3] = hi[1];
      vf[di] = __builtin_bit_cast(bf16x8, vv);
    }
#pragma unroll
    for (int di = 0; di < 2; ++di) ot[di][0] = MFMA(vf[di], pf, ot[di][0]);
  }
}

template <class LoadF, class BodyF>
DI void tile_pipeline(const int n, const unsigned lds, LoadF&& ld, BodyF&& body) {
  TileRegs A, B;
  ld(A, 0);
  __syncthreads();
  tile_swrite(A, lds);
  if (n > 1) ld(A, 1);
  if (n > 2) ld(B, 2);
  __syncthreads();
  int j = 0;
  while (true) {
    body(j, lds);
    if (j + 1 < n) tile_swrite(A, lds + 16384);
    if (j + 3 < n) ld(A, j + 3);
    __syncthreads();
    if (++j >= n) break;
    body(j, lds + 16384);
    if (j + 1 < n) tile_swrite(B, lds);
    if (j + 3 < n) ld(B, j + 3);
    __syncthreads();
    if (++j >= n) break;
  }
}

template <int MI, int NIM>
DI void qk_half(const bf16x8 (&QB)[2][4], const unsigned Ks, f32x16 (&st)[2]) {
  const int lane = ltid() & 63, r = lane & 31, h = lane >> 5;
#pragma unroll
  for (int j = 0; j < 2; ++j)
#pragma unroll
    for (int k = 0; k < 16; ++k) st[j][k] = 0.f;
#pragma unroll
  for (int ks = 0; ks < 4; ++ks) {
    const bf16x8 kf = *LDSP(bf16x8, Ks + swz(32 * MI + r, 2 * ks + h));
#pragma unroll
    for (int ni = 0; ni < 2; ++ni)
      if (NIM & (1 << ni)) st[ni] = MFMA(kf, QB[ni][ks], st[ni]);
  }
}
template <int MI>
DI void mask_hi(f32x16 (&st)[2], const int (&hi)[2]) {
#pragma unroll
  for (int reg = 0; reg < 16; ++reg) {
    const int keyc = 32 * MI + (reg & 3) + 8 * (reg >> 2);
#pragma unroll
    for (int ni = 0; ni < 2; ++ni) st[ni][reg] = (keyc <= hi[ni]) ? st[ni][reg] : -1e30f;
  }
}
template <int MI>
DI void mask_lo(f32x16 (&st)[2], const int (&lo)[2]) {
#pragma unroll
  for (int reg = 0; reg < 16; ++reg) {
    const int keyc = 32 * MI + (reg & 3) + 8 * (reg >> 2);
#pragma unroll
    for (int ni = 0; ni < 2; ++ni) st[ni][reg] = (keyc >= lo[ni]) ? st[ni][reg] : -1e30f;
  }
}
template <int MI, int NIM, bool ROWSEL>
DI void softmax_pv(f32x16 (&st)[2], const unsigned Vs, f32x16 (&ot)[2][2], float (&m)[2], float (&l)[2], const float sc2, const bool (&rowok)[2]) {
  const int lane = ltid() & 63, r = lane & 31, h = lane >> 5;
#pragma unroll
  for (int ni = 0; ni < 2; ++ni) {
    if (!(NIM & (1 << ni))) continue;
    float mx = st[ni][0];
#pragma unroll
    for (int reg = 1; reg < 16; ++reg) mx = fmaxf(mx, st[ni][reg]);
    mx = fmaxf(mx, __shfl_xor(mx, 32));
    if (ROWSEL) mx = rowok[ni] ? mx : -1e30f;
    const float mold = m[ni];
    const float mnew = fmaxf(mold, mx);
    const float alpha = EXP2((mold - mnew) * sc2);
    m[ni] = mnew;
    float mb = -mnew * sc2;
    if (ROWSEL) mb = rowok[ni] ? mb : -__builtin_inff();
    float rs = 0.f;
#pragma unroll
    for (int reg = 0; reg < 16; ++reg) { const float pp = EXP2(fmaf(st[ni][reg], sc2, mb)); st[ni][reg] = pp; rs += pp; }
    rs += __shfl_xor(rs, 32);
    l[ni] = l[ni] * alpha + rs;
    if (__builtin_amdgcn_ballot_w64(mnew > mold) != 0ull) {
#pragma unroll
      for (int di = 0; di < 2; ++di)
#pragma unroll
        for (int reg = 0; reg < 16; ++reg) ot[di][ni][reg] *= alpha;
    }
  }
#pragma unroll
  for (int s = 0; s < 2; ++s) {
    bf16x8 pf[2], vf[2];
#pragma unroll
    for (int ni = 0; ni < 2; ++ni) {
      if (!(NIM & (1 << ni))) continue;
      u32x4 pk;
#pragma unroll
      for (int i = 0; i < 4; ++i) pk[i] = pk2(st[ni][8 * s + 2 * i], st[ni][8 * s + 2 * i + 1]);
      pf[ni] = __builtin_bit_cast(bf16x8, pk);
    }
#pragma unroll
    for (int di = 0; di < 2; ++di) {
      const int d = 32 * di + r;
      const int sw = (d >> 1) & 7;
      const u32x2 lo = *LDSP(u32x2, Vs + d * 128 + (((4 * MI + 2 * s) ^ sw) << 4) + 8 * h);
      const u32x2 hi = *LDSP(u32x2, Vs + d * 128 + (((4 * MI + 2 * s + 1) ^ sw) << 4) + 8 * h);
      u32x4 vv; vv[0] = lo[0]; vv[1] = lo[1]; vv[2] = hi[0]; vv[3] = hi[1];
      vf[di] = __builtin_bit_cast(bf16x8, vv);
    }
#pragma unroll
    for (int di = 0; di < 2; ++di)
#pragma unroll
      for (int ni = 0; ni < 2; ++ni)
        if (NIM & (1 << ni)) ot[di][ni] = MFMA(vf[di], pf[ni], ot[di][ni]);
  }
}
template <int NIM, int MODE>
DI void attn_step(const bf16x8 (&QB)[2][4], const unsigned Ks, f32x16 (&ot)[2][2], float (&m)[2], float (&l)[2], const int (&bnd)[2], const bool (&rowok)[2]) {
  {
    f32x16 st[2];
    qk_half<0, NIM>(QB, Ks, st);
    if (MODE == 1) mask_hi<0>(st, bnd);
    if (MODE == 2) mask_lo<0>(st, bnd);
    softmax_pv<0, NIM, MODE == 3>(st, Ks + 8192, ot, m, l, LOG2E, rowok);
  }
  {
    f32x16 st[2];
    qk_half<1, NIM>(QB, Ks, st);
    if (MODE == 1) mask_hi<1>(st, bnd);
    if (MODE == 2) mask_lo<1>(st, bnd);
    softmax_pv<1, NIM, MODE == 3>(st, Ks + 8192, ot, m, l, LOG2E, rowok);
  }
}

DI void fox_item(const Params& p, int l, int item, unsigned lds) {
  char* ws = lptr(p.ws);
  const int bh = item & 7, qt = 63 - (item >> 3);
  const int b = bh >> 2, hd = bh & 3;
  const int q0 = qt * 128;
  const int tid = ltid(), lane = tid & 63, w = tid >> 6, r = lane & 31, h = lane >> 5;
  const u16* kb = (const u16*)(ws + OFF_FK) + (size_t)bh * T_ * 64;
  const u16* vb = (const u16*)(ws + OFF_FVT) + (size_t)bh * 64 * T_;
  const float* flog = (const float*)(ws + OFF_FLOG) + (size_t)b * T_ * 4 + hd;
  const unsigned rq = lds + 32768, ckb = lds + 32768 + 1024, wsum = lds + 32768 + 1024 + 512;
  __syncthreads();
  bf16x8 QB[2][4];
  {
    const u16* qrows = (const u16*)(ws + OFF_FQ) + ((size_t)bh * T_ + q0 + 32 * w) * 64;
#pragma unroll
    for (int ks = 0; ks < 4; ++ks) { QB[0][ks] = *(const bf16x8*)(qrows + (size_t)r * 64 + 16 * ks + 8 * h); QB[1][ks] = QB[0][ks]; }
  }
  {
    float v = (tid < 128) ? flog[(size_t)(q0 + tid) * 4] * LOG2E : 0.f;
#pragma unroll
    for (int o = 1; o < 64; o <<= 1) { const float u = __shfl_up(v, o); if (lane >= o) v += u; }
    if (tid == 63) *LDSP(float, wsum) = v;
    __syncthreads();
    if (w == 1) v += *LDSP(float, wsum);
    if (tid < 128) *LDSP(float, rq + 4 * tid) = v;
  }
  const int nkt = 2 * qt + 2;
  float qkb;
  {
    const float kn = sqrtf(((const float*)(ws + OFF_KN2))[l * 8 + bh]) * 1.02f + 1e-3f;
    float ss = 0.f;
#pragma unroll
    for (int ks = 0; ks < 4; ++ks)
#pragma unroll
      for (int e = 0; e < 8; ++e) { const float qv = bf2f((u16)QB[0][ks][e]); ss = fmaf(qv, qv, ss); }
    ss = xhalf_sum(ss);
    qkb = sqrtf(ss) * kn * LOG2E;
  }
  TileRegs tr;
  float carry = 0.f;
  float cknext = 0.f;
  tile_gload(tr, kb + (size_t)(nkt - 1) * 64 * 64, 64, vb + (size_t)(nkt - 1) * 64, T_);
  __syncthreads();
  tile_swrite(tr, lds);
  if (w == 0) *LDSP(float, ckb + 4 * lane) = *LDSP(float, rq + 4 * (64 + lane));
  __syncthreads();
  f32x16 ot[2][2]; zero_acc(ot);
  float m[2] = {-1e20f, -1e20f}, ls[2] = {0.f, 0.f};
  const float cq = *LDSP(float, rq + 4 * (32 * w + r));
  int cur = 0;
  for (int kt = nkt - 1; kt >= 0; --kt) {
    const bool more = kt > 0;
    if (more) {
      tile_gload(tr, kb + (size_t)(kt - 1) * 64 * 64, 64, vb + (size_t)(kt - 1) * 64, T_);
      if (w == 0) {
        const int ktn = kt - 1 - 2 * qt;
        if (ktn >= 0) cknext = *LDSP(float, rq + 4 * (64 * ktn + lane));
        else {
          const float v = -flog[(size_t)((kt - 1) * 64 + lane) * 4] * LOG2E;
          float inc = v;
#pragma unroll
          for (int o = 1; o < 64; o <<= 1) { const float u = __shfl_down(inc, o); if (lane + o < 64) inc += u; }
          cknext = carry + inc - v;
          carry += __shfl(inc, 0);
        }
      }
    }
    const int ktp = kt - 2 * qt;
    if (ktp <= 0 || w >= 2) {
      const unsigned Ks = lds + cur * 16384;
      const unsigned ck = ckb + cur * 256;
      const bool masked = (ktp == 1) || (ktp == 0 && w < 2);
      if (masked) attn_step1<1, true>(QB, Ks, ot, m, ls, 32 * w + r - 64 * ktp - 4 * h, true, 1.0f, true, cq, ck);
      else attn_step1<0, true>(QB, Ks, ot, m, ls, 0, true, 1.0f, false, cq, ck);
    }
    if (more) {
      tile_swrite(tr, lds + (cur ^ 1) * 16384);
      if (w == 0) *LDSP(float, ckb + 4 * ((cur ^ 1) * 64 + lane)) = cknext;
    }
    if (kt <= 2 * qt && kt > 0 && (kt & 1) == 0) {
      const float cmin = __shfl(cknext, 63);
      if (w == 0 && lane == 0) *LDSP(float, wsum + 16) = cmin;
      __syncthreads();
      const float cm = *LDSP(float, wsum + 16);
      const bool done = (qkb + cq - cm - m[0] < -40.f);
      if (__syncthreads_and(done ? 1 : 0)) break;
    } else {
      __syncthreads();
    }
    cur ^= 1;
  }
  const u16* gate = (const u16*)(ws + OFF_GATE);
  u16* mixed = (u16*)(ws + OFF_MIXED);
  {
    const float il = 1.f / ls[0];
    const size_t mrow = (size_t)(b * T_ + q0 + 32 * w + r) * 1024 + hd * 64;
#pragma unroll
    for (int di = 0; di < 2; ++di)
#pragma unroll
      for (int g4 = 0; g4 < 4; ++g4) {
        const int d = 32 * di + 8 * g4 + 4 * h;
        const u32x2 gv = *(const u32x2*)(gate + mrow + d);
        u32x2 o;
        o[0] = pk2(ot[di][0][4 * g4] * il * bflo(gv[0]), ot[di][0][4 * g4 + 1] * il * bfhi(gv[0]));
        o[1] = pk2(ot[di][0][4 * g4 + 2] * il * bflo(gv[1]), ot[di][0][4 * g4 + 3] * il * bfhi(gv[1]));
        *(u32x2*)(mixed + mrow + d) = o;
      }
  }
}

DI int tl32() { const int t = ltid(); return ((t >> 6) << 3) + ((t & 31) >> 2); }
DI void nsa_flush32(const Params& p, int mode, f32x16 (&ot)[2][2], const float ls0, int b, int g, int tbase, int br) {
  char* ws = lptr(p.ws);
  const int tid_ = ltid(); const int lane = tid_ & 63, r = lane & 31, h = lane >> 5;
  float* osc = (float*)(ws + OFF_OSC);
  const float* ngl = (const float*)(ws + OFF_NGL);
  const u16* gate = (const u16*)(ws + OFF_GATE);
  u16* mixed = (u16*)(ws + OFF_MIXED);
  const int t = tbase + tl32(), hh = r & 3;
  const size_t m = (size_t)b * T_ + t;
  const float gsig = ngl[m * 24 + (g * 4 + hh) * 3 + br];
  const float sc = (ls0 > 0.f) ? gsig / ls0 : 0.f;
  const size_t cb = m * 512 + (g * 4 + hh) * 64;
#pragma unroll
  for (int di = 0; di < 2; ++di)
#pragma unroll
    for (int g4 = 0; g4 < 4; ++g4) {
      const int d = 32 * di + 8 * g4 + 4 * h;
      float4 v = {ot[di][0][4 * g4] * sc, ot[di][0][4 * g4 + 1] * sc, ot[di][0][4 * g4 + 2] * sc, ot[di][0][4 * g4 + 3] * sc};
      if (mode > 0) { const float4 o = *(const float4*)(osc + cb + d); v.x += o.x; v.y += o.y; v.z += o.z; v.w += o.w; }
      if (mode < 2) *(float4*)(osc + cb + d) = v;
      else {
        const size_t mi2 = m * 1024 + 512 + (g * 4 + hh) * 64 + d;
        const u32x2 gv = *(const u32x2*)(gate + mi2);
        u32x2 o; o[0] = pk2(v.x * bflo(gv[0]), v.y * bfhi(gv[0])); o[1] = pk2(v.z * bflo(gv[1]), v.w * bfhi(gv[1]));
        *(u32x2*)(mixed + mi2) = o;
      }
    }
}

DI void nsa_accum32(const Params& p, f32x16 (&osum)[2], const f32x16 (&ot)[2][2], const float ls0, int b, int g, int tbase, int br, bool first) {
  char* ws = lptr(p.ws);
  const int r = ltid() & 31;
  const float* ngl = (const float*)(ws + OFF_NGL);
  const size_t m = (size_t)b * T_ + tbase + tl32();
  const float gsig = ngl[m * 24 + (g * 4 + (r & 3)) * 3 + br];
  const float sc = (ls0 > 0.f) ? gsig / ls0 : 0.f;
#pragma unroll
  for (int di = 0; di < 2; ++di)
#pragma unroll
    for (int k = 0; k < 16; ++k) osum[di][k] = first ? ot[di][0][k] * sc : fmaf(ot[di][0][k], sc, osum[di][k]);
}
DI void nsa_store32(const Params& p, const f32x16 (&osum)[2], int b, int g, int tbase) {
  char* ws = lptr(p.ws);
  const int lane = ltid() & 63, r = lane & 31, h = lane >> 5;
  const u16* gate = (const u16*)(ws + OFF_GATE);
  u16* mixed = (u16*)(ws + OFF_MIXED);
  const size_t m = (size_t)b * T_ + tbase + tl32();
  const size_t base = m * 1024 + 512 + (g * 4 + (r & 3)) * 64;
#pragma unroll
  for (int di = 0; di < 2; ++di)
#pragma unroll
    for (int g4 = 0; g4 < 4; ++g4) {
      const int d = 32 * di + 8 * g4 + 4 * h;
      const u32x2 gv = *(const u32x2*)(gate + base + d);
      u32x2 o;
      o[0] = pk2(osum[di][4 * g4] * bflo(gv[0]), osum[di][4 * g4 + 1] * bfhi(gv[0]));
      o[1] = pk2(osum[di][4 * g4 + 2] * bflo(gv[1]), osum[di][4 * g4 + 3] * bfhi(gv[1]));
      *(u32x2*)(mixed + base + d) = o;
    }
}

DI void nsa_item32(const Params& p, int l, int item, unsigned lds) {
  char* ws = lptr(p.ws);
  const int bg = item & 3, c32 = 255 - (item >> 2);
  const int b = bg >> 1, g = bg & 1;
  const int tbase = 32 * c32, c = c32 >> 1, toff = tbase & 63;
  const int tid = ltid(), lane = tid & 63, w = tid >> 6, r = lane & 31, h = lane >> 5;
  if (tid == 0 && *LDSP(unsigned, lds + 67540 + 4 * (l * 4 + bg)) == 0u) {
    unsigned* dn = (unsigned*)(ws + OFF_BAR) + 3800 + l * 4 + bg;
    while (__hip_atomic_load(dn, __ATOMIC_RELAXED, __HIP_MEMORY_SCOPE_AGENT) < 8u) __builtin_amdgcn_s_sleep(4);
    __builtin_amdgcn_fence(__ATOMIC_ACQUIRE, "agent");
    asm volatile("s_waitcnt vmcnt(0)" ::: "memory");
    *LDSP(unsigned, lds + 67540 + 4 * (l * 4 + bg)) = 1u;
  }
  const unsigned imp = lds + 32768;
  const unsigned selw = lds + 32768 + 16384;
  __syncthreads();
  bf16x8 QB[2][4];
  {
    const u16* qrows = (const u16*)(ws + OFF_NQ) + (((size_t)bg * T_ + tbase) * 4 + 32 * w) * 64;
#pragma unroll
    for (int ks = 0; ks < 4; ++ks) { QB[0][ks] = *(const bf16x8*)(qrows + (size_t)r * 64 + 16 * ks + 8 * h); QB[1][ks] = QB[0][ks]; }
  }
  for (int i = tid; i < 32 * 128; i += 256) *LDSP(float, imp + 4 * i) = 0.f;
  f32x16 ot[2][2];
  f32x16 osum[2];
  float m[2], ls[2];
  const bool rk[2] = {true, true};
  const u16* kcb = (const u16*)(ws + OFF_KCMP) + (size_t)bg * 512 * 64;
  const u16* vcb = (const u16*)(ws + OFF_VCMPT) + (size_t)bg * 64 * 512;
  const int nbc = (2 * c32) / 64 + 1;
  {
    zero_acc(ot); m[0] = m[1] = -1e20f; ls[0] = ls[1] = 0.f;
    tile_pipeline(nbc, lds,
      [&](TileRegs& t, int nb) __attribute__((always_inline)) { tile_gload(t, kcb + (size_t)nb * 64 * 64, 64, vcb + (size_t)nb * 64, 512); },
      [&](int nb, unsigned Ks) __attribute__((always_inline)) {
        const int hb = ((tbase + tl32() - 31) >> 4) - 64 * nb - 4 * h_of();
        if (64 * nb + 63 <= ((tbase - 31) >> 4)) attn_step1<0>(QB, Ks, ot, m, ls, hb, true, LOG2E, nb == 0);
        else attn_step1<1>(QB, Ks, ot, m, ls, hb, true, LOG2E, nb == 0);
      });
    nsa_accum32(p, osum, ot, ls[0], b, g, tbase, 0, true);
  }
  if (c >= 16) {
    const float il0 = (ls[0] > 0.f) ? 1.f / ls[0] : 0.f;
#define IMP_HALF(MI)                                                                               \
      {                                                                                            \
        f32x16 st[2];                                                                              \
        qk_half<MI, 1>(QB, Ks, st);                                                                \
        const int tlv = tl32(); const int hbv = ((tbase + tlv - 31) >> 4) - 64 * nb - 4 * h_of();  \
        _Pragma("unroll") for (int g4 = 0; g4 < 4; ++g4) {                                         \
          float pg[4];                                                                             \
          _Pragma("unroll") for (int e = 0; e < 4; ++e) {                                          \
            const int keyc = 32 * MI + 8 * g4 + e;                                                 \
            float pp = (keyc <= hbv) ? EXP2((st[0][4 * g4 + e] - m[0]) * LOG2E) * il0 : 0.f;       \
            pp += dpp_xor1(pp);                                                                    \
            pp += dpp_xor2(pp);                                                                    \
            pg[e] = pp;                                                                            \
          }                                                                                        \
          if ((r & 3) == g4) {                                                                     \
            const int j = 16 * nb + 8 * MI + 2 * g4 + h;                                           \
            const float G = (pg[0] + pg[1]) + (pg[2] + pg[3]);                                     \
            __hip_atomic_fetch_add(LDSP(float, imp + 4 * (tlv * 128 + j)), G, __ATOMIC_RELAXED, __HIP_MEMORY_SCOPE_WORKGROUP); \
            if (j + 1 < 128) __hip_atomic_fetch_add(LDSP(float, imp + 4 * (tlv * 128 + j + 1)), pg[3], __ATOMIC_RELAXED, __HIP_MEMORY_SCOPE_WORKGROUP); \
          }                                                                                        \
        }                                                                                          \
      }
    tile_pipeline(nbc, lds,
      [&](TileRegs& t, int nb) __attribute__((always_inline)) { tile_gload(t, kcb + (size_t)nb * 64 * 64, 64, vcb + (size_t)nb * 64, 512); },
      [&](int nb, unsigned Ks) __attribute__((always_inline)) {
        IMP_HALF(0)
        IMP_HALF(1)
      });
#undef IMP_HALF
  }
  {
    const int tok = tid >> 3, sub = tid & 7;
    unsigned word;
    if (c < 16) {
      word = 0xffffu;
    } else {
      unsigned key[16];
      word = 0;
#pragma unroll
      for (int i = 0; i < 16; ++i) {
        const int j = 16 * sub + i;
        const float v = *LDSP(float, imp + 4 * (tok * 128 + j));
        const bool cand = (j >= 1) && (j <= c - 2);
        key[i] = cand ? (__float_as_uint(v) + 1u) : 0u;
        if (j == 0 || j == c || j == c - 1) word |= (1u << i);
      }
      unsigned thr = 0;
      for (int bit = 30; bit >= 0; --bit) {
        const unsigned cd = thr | (1u << bit);
        int cnt = 0;
#pragma unroll
        for (int i = 0; i < 16; ++i) cnt += (key[i] >= cd) ? 1 : 0;
        cnt += dpp_xor1i(cnt);
        cnt += dpp_xor2i(cnt);
        cnt += dpp_hmi(cnt);
        if (cnt >= 13) thr = cd;
      }
      int gt = 0, eq = 0;
#pragma unroll
      for (int i = 0; i < 16; ++i) { gt += (key[i] > thr) ? 1 : 0; eq += (key[i] == thr) ? 1 : 0; }
      int gtt = gt; gtt += dpp_xor1i(gtt); gtt += dpp_xor2i(gtt); gtt += dpp_hmi(gtt);
      int eqb = 0;
#pragma unroll
      for (int k = 0; k < 7; ++k) { const int ek = __shfl(eq, (lane & ~7) + k); if (sub > k) eqb += ek; }
      int need = 13 - gtt - eqb;
#pragma unroll
      for (int i = 0; i < 16; ++i) {
        if (key[i] > thr) word |= (1u << i);
        else if (key[i] == thr && thr != 0u) { if (need > 0) word |= (1u << i); --need; }
      }
    }
    *LDSP(u16, selw + 16 * tok + 2 * sub) = (u16)word;
  }
  __syncthreads();
  {
    const u16* kb = (const u16*)(ws + OFF_KS) + (size_t)bg * T_ * 64;
    const u16* vb = (const u16*)(ws + OFF_VST) + (size_t)bg * 64 * T_;
    zero_acc(ot); m[0] = m[1] = -1e20f; ls[0] = ls[1] = 0.f;
    tile_pipeline(c + 1, lds,
      [&](TileRegs& t, int j) __attribute__((always_inline)) { tile_gload(t, kb + (size_t)j * 64 * 64, 64, vb + (size_t)j * 64, T_); },
      [&](int j, unsigned Ks) __attribute__((always_inline)) {
        const bool selb = ((*LDSP(unsigned, selw + 16 * tl32() + 4 * (j >> 5)) >> (j & 31)) & 1u) != 0u;
        if (j == c) {
          attn_step1<1>(QB, Ks, ot, m, ls, toff + tl32() - 4 * h_of(), true, LOG2E, j == 0);
        } else {
          if (__builtin_amdgcn_ballot_w64(selb) != 0ull) attn_step1<3>(QB, Ks, ot, m, ls, 0, selb, LOG2E, j == 0);
        }
        if (PROBE_REP == 7) attn_step1<3>(QB, Ks, ot, m, ls, 0, false, LOG2E, false);
      });
    nsa_accum32(p, osum, ot, ls[0], b, g, tbase, 1, false);
  }
  {
    const u16* kb = (const u16*)(ws + OFF_KW) + (size_t)bg * T_ * 64;
    const u16* vb = (const u16*)(ws + OFF_VWT) + (size_t)bg * 64 * T_;
    zero_acc(ot); m[0] = m[1] = -1e20f; ls[0] = ls[1] = 0.f;
    const int jlo = (c >= 8) ? c - 8 : 0;
    tile_pipeline(c - jlo + 1, lds,
      [&](TileRegs& t, int i) __attribute__((always_inline)) { const int j = c - i; tile_gload(t, kb + (size_t)j * 64 * 64, 64, vb + (size_t)j * 64, T_); },
      [&](int i, unsigned Ks) __attribute__((always_inline)) {
        const int j = c - i;
        const bool diag = (j == c), far = (j == c - 8);
        if (diag) attn_step1<1>(QB, Ks, ot, m, ls, toff + tl32() - 4 * h_of(), true, LOG2E, true);
        else if (far) attn_step1<2>(QB, Ks, ot, m, ls, toff + tl32() + 1 - 4 * h_of(), true, LOG2E, false);
        else attn_step1<0>(QB, Ks, ot, m, ls, 0, true, LOG2E, false);
      });
    nsa_accum32(p, osum, ot, ls[0], b, g, tbase, 2, false);
    nsa_store32(p, osum, b, g, tbase);
  }
}

#define XB_TMO      128
#define XB_XCNT(j)  (256  + 64 * (j))
#define XB_XSUB(j)  (1280 + 64 * (j))
#define XB_XGEN(j)  (2304 + 64 * (j))
#define XB_TOP      3328
#define XB_TOPGEN   3392
#define XCD_BAR_WORDS 3456
#define XB_SPIN_CAP (1u << 18)
#define LAS __attribute__((address_space(3)))

__device__ __forceinline__ unsigned xb_ld(unsigned* p)              { return __hip_atomic_load(p, __ATOMIC_RELAXED, __HIP_MEMORY_SCOPE_AGENT); }
__device__ __forceinline__ unsigned xb_add(unsigned* p, unsigned v) { return __hip_atomic_fetch_add(p, v, __ATOMIC_RELAXED, __HIP_MEMORY_SCOPE_AGENT); }
__device__ __forceinline__ unsigned xb_xcc_id() { return (unsigned)__builtin_amdgcn_s_getreg((3 << 11) | 20) & 0xFu; }
#define XB_SPIN(cond, bar) do { unsigned _sp = 0; while (cond) { __builtin_amdgcn_s_sleep(1); \
    if ((++_sp & 255u) == 0u) { if (xb_ld(&(bar)[XB_TMO])) break; if (_sp > XB_SPIN_CAP) { atomicAdd(&(bar)[XB_TMO], 1u); break; } } } } while (0)

struct XcdBarrier {
    unsigned* bar; unsigned x;
    volatile LAS unsigned* st;
};

__device__ __forceinline__ XcdBarrier xcd_barrier_post(unsigned* bar, volatile LAS unsigned* st) {
    XcdBarrier b; b.bar = bar; b.x = xb_xcc_id(); b.st = st;
    if (threadIdx.x == 0) (void)xb_add(&bar[XB_XCNT(b.x)], 1u);
    return b;
}
__device__ __forceinline__ void xcd_barrier_complete(unsigned* bar, unsigned x, unsigned& nloc, unsigned& nx) {
    const unsigned G = gridDim.x * gridDim.y * gridDim.z;
    unsigned sum, cnt, mine, sp = 0u;
    for (;;) {
        sum = 0u; cnt = 0u; mine = 0u;
#pragma unroll
        for (unsigned j = 0; j < 16; ++j) { const unsigned c = xb_ld(&bar[XB_XCNT(j)]); sum += c; cnt += (c > 0u) ? 1u : 0u; mine = (j == x) ? c : mine; }
        if (sum == G) break;
        __builtin_amdgcn_s_sleep(1);
        if ((++sp & 255u) == 0u) { if (xb_ld(&bar[XB_TMO])) break; if (sp > XB_SPIN_CAP) { atomicAdd(&bar[XB_TMO], 1u); break; } }
    }
    nloc = mine > 0u ? mine : 1u; nx = cnt > 0u ? cnt : 1u;
}

__device__ __forceinline__ void xcd_barrier(const XcdBarrier& b) {
    asm volatile("s_waitcnt vmcnt(0)" ::: "memory");
    __syncthreads();
    if (threadIdx.x == 0) {
        unsigned* bar = b.bar;
        __builtin_amdgcn_s_waitcnt(0);
        unsigned nloc = b.st[0], nx = b.st[1];
        if (nloc == 0u) { xcd_barrier_complete(bar, b.x, nloc, nx); b.st[0] = nloc; b.st[1] = nx; }
        const unsigned old = xb_add(&bar[XB_XSUB(b.x)], 1u);
        const unsigned gen = old / nloc;
        if (old + 1u == (gen + 1u) * nloc) {
            __builtin_amdgcn_fence(__ATOMIC_RELEASE, "agent");
            asm volatile("s_waitcnt vmcnt(0)" ::: "memory");
            const unsigned og = xb_add(&bar[XB_TOP], 1u);
            const unsigned tg = og / nx;
            if (og + 1u == (tg + 1u) * nx) xb_add(&bar[XB_TOPGEN], 1u);
            else XB_SPIN(xb_ld(&bar[XB_TOPGEN]) == tg, bar);
            __builtin_amdgcn_fence(__ATOMIC_ACQUIRE, "agent");
            xb_add(&bar[XB_XGEN(b.x)], 1u);
            asm volatile("s_waitcnt vmcnt(0)" ::: "memory");
        } else {
            XB_SPIN(xb_ld(&bar[XB_XGEN(b.x)]) == gen, bar);
            __builtin_amdgcn_fence(__ATOMIC_ACQUIRE, "agent");
            asm volatile("s_waitcnt vmcnt(0)" ::: "memory");
        }
    }
    __syncthreads();
}


__global__ void __launch_bounds__(256, 2) fwd_megakernel(Params p) {
  cg::grid_group grid = cg::this_grid();
  __shared__ __attribute__((aligned(16))) char lds_arr[LDS_BYTES];
  const unsigned lds = (unsigned)(size_t)lds_arr;
  if (threadIdx.x < 16) *LDSP(unsigned, lds + 67520 + 4 * threadIdx.x) = 0u;
  __syncthreads();
  const XcdBarrier xb = xcd_barrier_post((unsigned*)(p.ws + OFF_BAR), (volatile LAS unsigned*)(lds + 67520));
#define GSYNC() xcd_barrier(xb)
  if (gridDim.x == 0x7fffffffu) grid.sync();
  const int G = gridDim.x, bid = blockIdx.x;
  for (int whole = 0; whole < (PROBE_REP == 6 ? 2 : 1); ++whole) {
  if (whole) GSYNC();
  for (int rep0 = 0; rep0 < (PROBE_REP == 4 ? 2 : 1); ++rep0) {
  for (int i = bid; i < 2 * P0_PER_LAYER; i += G) phase0_item(p, i, lds);
  for (int i = G - 1 - bid; i < 32; i += G) cbias_item(p, i, lds);
  if (bid == 0 && threadIdx.x < 128) ((unsigned*)(p.ws + OFF_KN2))[threadIdx.x] = 0u;
  for (int i = bid; i < 256; i += G) rope_item(p, i);
  for (int i = bid; i < BT / 4; i += G) norm_item(p.x, p.norm_g, (u16*)(p.ws + OFF_H), nullptr, i, nullptr, nullptr, nullptr, nullptr);
  }
  GSYNC();
  for (int l = 0; l < 2; ++l) {
    for (int rep = 0; rep < (PROBE_REP == 1 ? 2 : 1); ++rep) {
    if (rep) GSYNC();
    if (G == 512) {
      const int xcd = bid & 7, lb = bid >> 3, y = xcd >> 1;
      for (int k = lb; k < 448; k += 64) {
        int mt, nt;
        if ((xcd & 1) == 0) {
          if (k < 256) { mt = k >> 2; nt = 7 * y + (k & 3); } else { const int k2 = k - 256; mt = 64 + k2 / 3; nt = 7 * y + k2 % 3; }
        } else {
          if (k < 192) { mt = k / 3; nt = 7 * y + 4 + k % 3; } else { const int k2 = k - 192; mt = 64 + (k2 >> 2); nt = 7 * y + 3 + (k2 & 3); }
        }
        gemm1_item(p, l, mt * 29 + nt, lds);
      }
    } else {
      for (int i = bid; i < 128 * 28; i += G) gemm1_item(p, l, (i / 28) * 29 + (i % 28), lds);
    }
    for (int i = bid; i < 128; i += G) tail_item(p, l, i);
    }
    GSYNC();
    {
      int i = bid;
      unsigned* qctr = (unsigned*)(p.ws + OFF_BAR) + 3600 + 64 * l;
      while (i < 64 + 512 + 256 + 1024) {
        if (i < 64) {
          compress_item(p, l, i, lds);
        } else if (i < 576) {
          fox_item(p, l, i - 64, lds);
        } else if (i < 832) {
          conv_item(p, l, i - 576, lds);
        } else {
          nsa_item32(p, l, i - 832, lds);
        }
        __syncthreads();
        if (threadIdx.x == 0) *LDSP(unsigned, lds + 67536) = (unsigned)G + __hip_atomic_fetch_add(qctr, 1u, __ATOMIC_RELAXED, __HIP_MEMORY_SCOPE_AGENT);
        __syncthreads();
        i = (int)*LDSP(unsigned, lds + 67536);
      }
    }
    GSYNC();
    if (G == 512) {
      const int xcd = bid & 7, lb = bid >> 3;
      for (int k = lb; k < 128; k += 64) gemm2_item(p, l, xcd * 128 + k, lds);
    } else {
      for (int i = bid; i < 1024; i += G) gemm2_item(p, l, i, lds);
    }
    GSYNC();
    if (l == 0) for (int i = bid; i < BT / 4; i += G) norm_item(p.out, p.norm_g + 1024, (u16*)(p.ws + OFF_H), nullptr, i, nullptr, nullptr, nullptr, nullptr);
    else for (int i = bid; i < BT / 4; i += G) norm_item(p.out, p.final_g, nullptr, p.out, i, nullptr, nullptr, nullptr, nullptr);
    if (l == 0) GSYNC();
  }
  }
}

__global__ void zero_mixed(unsigned* m, size_t n) {
  size_t i = (size_t)blockIdx.x * blockDim.x + threadIdx.x;
  if (i < n) m[i] = 0;
}

extern "C" void kernel_launch(void* const* d_in, const int* in_sizes, int n_in, void* d_out,
                              int out_size, void* d_ws, size_t ws_size, hipStream_t stream) {
  static int grid_blocks = 0;
  if (!grid_blocks) {
    int dev = 0, cus = 0, per_cu = 0;
    (void)hipGetDevice(&dev);
    (void)hipDeviceGetAttribute(&cus, hipDeviceAttributeMultiprocessorCount, dev);
    (void)hipOccupancyMaxActiveBlocksPerMultiprocessor(&per_cu, fwd_megakernel, 256, 0);
    if (per_cu > 2) per_cu = 2;
    if (per_cu < 1) per_cu = 1;
    grid_blocks = cus * per_cu;
  }
  Params p{};
  p.x = (const float*)d_in[0]; p.norm_g = (const float*)d_in[1]; p.w_in = (const float*)d_in[2]; p.fox_b = (const float*)d_in[3];
  p.conv_w = (const float*)d_in[4]; p.conv_b = (const float*)d_in[5]; p.conv_ln_g = (const float*)d_in[6]; p.conv_ln_b = (const float*)d_in[7];
  p.conv_pw = (const float*)d_in[8]; p.cmp_pe_k = (const float*)d_in[9]; p.cmp_pe_v = (const float*)d_in[10];
  p.cmp_k_w1 = (const float*)d_in[11]; p.cmp_k_w2 = (const float*)d_in[12]; p.cmp_v_w1 = (const float*)d_in[13]; p.cmp_v_w2 = (const float*)d_in[14];
  p.w_out = (const float*)d_in[15]; p.final_g = (const float*)d_in[16];
  p.out = (float*)d_out; p.ws = (char*)d_ws;
#if !(EN_FOX && EN_NSA)
  {
    size_t n = (size_t)BT * 1024 / 2;
    zero_mixed<<<(unsigned)((n + 255) / 256), 256, 0, stream>>>((unsigned*)((char*)d_ws + OFF_MIXED), n);
  }
#endif
  (void)hipMemsetAsync((char*)d_ws + OFF_BAR, 0, 16384, stream);
  void* args[] = {&p};
  hipError_t e = hipLaunchCooperativeKernel((void*)fwd_megakernel, dim3(grid_blocks), dim3(256), args, 0, stream);
  if (e != hipSuccess) fprintf(stderr, "cooperative launch failed: %s (grid %d)\n", hipGetErrorString(e), grid_blocks);
}
```

```cpp
#include <hip/hip_runtime.h>
#include <hip/hip_cooperative_groups.h>
#include <cstdio>
namespace cg = cooperative_groups;

#ifndef PROBE_REP
#define PROBE_REP 0
#endif
#ifndef EN_FOX
#define EN_FOX 1
#endif
#ifndef EN_NSA
#define EN_NSA 1
#endif

typedef unsigned short u16;
using bf16x8 = __attribute__((ext_vector_type(8))) short;
using f32x16 = __attribute__((ext_vector_type(16))) float;
using u32x4 = __attribute__((ext_vector_type(4))) unsigned;
using u32x2 = __attribute__((ext_vector_type(2))) unsigned;
using f32x4 = __attribute__((ext_vector_type(4))) float;
typedef __attribute__((ext_vector_type(2))) __bf16 bf2_t;
#define DI __device__ __forceinline__
#define EXP2(x) __builtin_amdgcn_exp2f(x)
#define MFMA(a, b, c) __builtin_amdgcn_mfma_f32_32x32x16_bf16((a), (b), (c), 0, 0, 0)

constexpr int T_ = 8192;
constexpr int BT = 16384;
constexpr int NPAD = 3712;
constexpr float LOG2E = 1.4426950408889634f;
constexpr int LDS_BYTES = 67584;

constexpr size_t SZ_WINT = (size_t)NPAD * 1024 * 2;
constexpr size_t OFF_WINT = 0;
constexpr size_t OFF_WOUTT = OFF_WINT + 2 * SZ_WINT;
constexpr size_t OFF_PWT = OFF_WOUTT + 2 * (size_t)1024 * 1024 * 2;
constexpr size_t OFF_W1T = OFF_PWT + 2 * (size_t)256 * 256 * 2;
constexpr size_t OFF_W2T = OFF_W1T + 4 * (size_t)256 * 2048 * 2;
constexpr size_t OFF_CBIAS = OFF_W2T + 4 * (size_t)128 * 256 * 2;
constexpr size_t OFF_ROPE = OFF_CBIAS + 4 * 256 * 4;
constexpr size_t OFF_H = OFF_ROPE + (size_t)8192 * 8 * 2 * 4;
constexpr size_t OFF_OSC = OFF_H;
constexpr size_t OFF_FQ = OFF_H + (size_t)BT * 1024 * 2;
constexpr size_t OFF_FK = OFF_FQ + (size_t)BT * 256 * 2;
constexpr size_t OFF_FVT = OFF_FK + (size_t)BT * 256 * 2;
constexpr size_t OFF_FLOG = OFF_FVT + (size_t)BT * 256 * 2;
constexpr size_t OFF_GATE = OFF_FLOG + (size_t)BT * 4 * 4;
constexpr size_t OFF_GLU = OFF_GATE + (size_t)BT * 1024 * 2;
constexpr size_t OFF_NQ = OFF_GLU + (size_t)BT * 512 * 2;
constexpr size_t OFF_KC = OFF_NQ + (size_t)BT * 512 * 2;
constexpr size_t SZ_KV = (size_t)BT * 128 * 2;
constexpr size_t OFF_VC = OFF_KC + SZ_KV;
constexpr size_t OFF_KS = OFF_VC + SZ_KV;
constexpr size_t OFF_VST = OFF_KS + SZ_KV;
constexpr size_t OFF_KW = OFF_VST + SZ_KV;
constexpr size_t OFF_VWT = OFF_KW + SZ_KV;
constexpr size_t OFF_NGL = OFF_VWT + SZ_KV;
constexpr size_t OFF_KCMP = OFF_NGL + (size_t)BT * 24 * 4;
constexpr size_t OFF_VCMPT = OFF_KCMP + (size_t)4 * 512 * 64 * 2;
constexpr size_t OFF_HID = OFF_VCMPT + (size_t)4 * 512 * 64 * 2;
constexpr size_t OFF_CONVA = OFF_HID + (size_t)32 * 128 * 256 * 2;
constexpr size_t OFF_MIXED = OFF_CONVA + (size_t)BT * 256 * 2;
constexpr size_t OFF_KN2 = OFF_MIXED + (size_t)BT * 1024 * 2;
constexpr size_t OFF_CNT = OFF_KN2 + 256;
constexpr size_t OFF_BAR = OFF_CNT + 256;
constexpr size_t OFF_WTAIL = OFF_BAR + 16384;
constexpr size_t WS_TOTAL = OFF_WTAIL + (size_t)2 * 32 * 1024 * 4;
static_assert(WS_TOTAL <= (size_t)256 * 1024 * 1024, "ws too large");

struct Params {
  const float* x; const float* norm_g; const float* w_in; const float* fox_b; const float* conv_w; const float* conv_b;
  const float* conv_ln_g; const float* conv_ln_b; const float* conv_pw; const float* cmp_pe_k; const float* cmp_pe_v;
  const float* cmp_k_w1; const float* cmp_k_w2; const float* cmp_v_w1; const float* cmp_v_w2; const float* w_out; const float* final_g;
  float* out; char* ws;
};

DI int ltid() { int t = threadIdx.x; asm volatile("" : "+v"(t)); return t; }
DI char* lptr(char* q) { int z = 0; asm volatile("" : "+s"(z)); return q + z; }
#define LDSP(T, a) ((__attribute__((address_space(3))) T*)(a))
DI int tl_of(int ni) { const int t = ltid(); return ((t >> 6) << 4) + 8 * ni + ((t & 31) >> 2); }
DI int h_of() { return (ltid() >> 5) & 1; }
DI u16 f2bf(float x) { __bf16 b = (__bf16)x; return __builtin_bit_cast(u16, b); }
DI unsigned pk2(float x, float y) { bf2_t v; v[0] = (__bf16)x; v[1] = (__bf16)y; return __builtin_bit_cast(unsigned, v); }
DI float bf2f(u16 v) { return __uint_as_float(((unsigned)v) << 16); }
DI float bflo(unsigned v) { return __uint_as_float(v << 16); }
DI float bfhi(unsigned v) { return __uint_as_float(v & 0xffff0000u); }
DI int vperm16(int t) { return (t & ~15) | (t & 3) | ((t & 4) << 1) | ((t & 8) >> 1); }
DI int crow(int reg, int h) { return (reg & 3) + 8 * (reg >> 2) + 4 * h; }
DI float siluf(float x) { return x / (1.f + __expf(-x)); }
DI float sigmf(float x) { return 1.f / (1.f + __expf(-x)); }
DI float geluf(float x) { return 0.5f * x * (1.f + tanhf(0.7978845608028654f * (x + 0.044715f * x * x * x))); }
DI int swz(int row, int chunk) { return row * 128 + ((chunk ^ ((row >> 1) & 7)) << 4); }
DI void zero_acc(f32x16 (&a)[2][2]) {
#pragma unroll
  for (int i = 0; i < 2; ++i)
#pragma unroll
    for (int j = 0; j < 2; ++j)
#pragma unroll
      for (int k = 0; k < 16; ++k) a[i][j][k] = 0.f;
}

DI int swz32(int row, int chunk) { return row * 64 + ((chunk ^ ((row >> 2) & 3)) << 4); }
template <bool SWAP>
DI void gemm_tile(const u16* __restrict__ A, long lda, const u16* __restrict__ B, long ldb, int K, unsigned lds, f32x16 (&acc)[2][2]) {
  const int tid = ltid(), lane = tid & 63, w = tid >> 6, wr = w >> 1, wc = w & 1, r = lane & 31, h = lane >> 5;
  zero_acc(acc);
  const int lrow = tid >> 2, lch = tid & 3;
  const u16* ga = A + (long)lrow * lda + lch * 8;
  const u16* gb = B + (long)lrow * ldb + lch * 8;
  const long a64 = 64 * lda, b64 = 64 * ldb;
  const int n = K >> 5;
  u32x4 s0[4], s1[4], s2[4];
#define GLOAD(S, J) { S[0] = *(const u32x4*)(ga + (J) * 32); S[1] = *(const u32x4*)(ga + a64 + (J) * 32); S[2] = *(const u32x4*)(gb + (J) * 32); S[3] = *(const u32x4*)(gb + b64 + (J) * 32); }
#define SWRITE(S, BUF) { const unsigned bb = lds + (BUF) * 16384; *LDSP(u32x4, bb + swz32(lrow, lch)) = S[0]; *LDSP(u32x4, bb + swz32(lrow + 64, lch)) = S[1]; \
                         *LDSP(u32x4, bb + 8192 + swz32(lrow, lch)) = S[2]; *LDSP(u32x4, bb + 8192 + swz32(lrow + 64, lch)) = S[3]; }
#define COMPUTE(BUF) { const unsigned As = lds + (BUF) * 16384; const unsigned Bs = As + 8192; \
    _Pragma("unroll") for (int ks = 0; ks < 2; ++ks) { bf16x8 af[2], bf[2]; \
      _Pragma("unroll") for (int i = 0; i < 2; ++i) { af[i] = *LDSP(bf16x8, As + swz32(64 * wr + 32 * i + r, 2 * ks + h)); bf[i] = *LDSP(bf16x8, Bs + swz32(64 * wc + 32 * i + r, 2 * ks + h)); } \
      _Pragma("unroll") for (int mi = 0; mi < 2; ++mi) _Pragma("unroll") for (int ni = 0; ni < 2; ++ni) { \
        if (SWAP) acc[mi][ni] = MFMA(bf[ni], af[mi], acc[mi][ni]); else acc[mi][ni] = MFMA(af[mi], bf[ni], acc[mi][ni]); } } }
  GLOAD(s0, 0)
  GLOAD(s1, 1)
  GLOAD(s2, 2)
  __syncthreads();
  SWRITE(s0, 0)
  GLOAD(s0, 3)
  __syncthreads();
  int j = 0, cur = 0;
  while (true) {
    COMPUTE(cur)
    if (j + 1 < n) SWRITE(s1, cur ^ 1)
    if (j + 4 < n) GLOAD(s1, j + 4)
    __syncthreads();
    cur ^= 1; if (++j >= n) break;
    COMPUTE(cur)
    if (j + 1 < n) SWRITE(s2, cur ^ 1)
    if (j + 4 < n) GLOAD(s2, j + 4)
    __syncthreads();
    cur ^= 1; if (++j >= n) break;
    COMPUTE(cur)
    if (j + 1 < n) SWRITE(s0, cur ^ 1)
    if (j + 4 < n) GLOAD(s0, j + 4)
    __syncthreads();
    cur ^= 1; if (++j >= n) break;
  }
#undef GLOAD
#undef SWRITE
#undef COMPUTE
}

DI int win_srccol(int n) {
  if (n < 768) return n;
  if (n < 3072) return n + 4;
  if (n < 3584) return n + 28;
  int i = n - 3584;
  if (i < 4) return 768 + i;
  if (i < 28) return 3076 + (i - 4);
  return -1;
}

DI void transpose_tile(const float* __restrict__ src, int ld, int K, int mapkind, int nsrc, u16* __restrict__ dst, int k0, int n0, unsigned lds) {
  const int tid = ltid(), j = tid & 63, i0 = tid >> 6;
  const int n = n0 + j;
  const int sc = mapkind ? win_srccol(n) : (n < nsrc ? n : -1);
  float v[16];
#pragma unroll
  for (int it = 0; it < 16; ++it) v[it] = (sc >= 0) ? src[(size_t)(k0 + i0 + 4 * it) * ld + sc] : 0.f;
  __syncthreads();
#pragma unroll
  for (int it = 0; it < 16; ++it) *LDSP(float, lds + 4 * ((i0 + 4 * it) * 65 + j)) = v[it];
  __syncthreads();
  const int jn = tid >> 2, kc = (tid & 3) * 16;
  u32x4 o0, o1;
#pragma unroll
  for (int e = 0; e < 4; ++e) {
    o0[e] = pk2(*LDSP(float, lds + 4 * ((kc + 2 * e) * 65 + jn)), *LDSP(float, lds + 4 * ((kc + 2 * e + 1) * 65 + jn)));
    o1[e] = pk2(*LDSP(float, lds + 4 * ((kc + 8 + 2 * e) * 65 + jn)), *LDSP(float, lds + 4 * ((kc + 8 + 2 * e + 1) * 65 + jn)));
  }
  u16* dp = dst + (size_t)(n0 + jn) * K + k0 + kc;
  *(u32x4*)dp = o0;
  *(u32x4*)(dp + 8) = o1;
}

constexpr int P0_PER_LAYER = 928 + 256 + 16 + 256 + 16;
DI void phase0_item(const Params& p, int idx, unsigned lds) {
  const int l = idx / P0_PER_LAYER;
  int r = idx % P0_PER_LAYER;
  char* ws = lptr(p.ws);
  if (r < 928) {
    transpose_tile(p.w_in + (size_t)l * 1024 * 3612, 3612, 1024, 1, 0, (u16*)(ws + OFF_WINT + l * SZ_WINT), (r % 16) * 64, (r / 16) * 64, lds);
    return;
  }
  r -= 928;
  if (r < 256) {
    transpose_tile(p.w_out + (size_t)l * 1024 * 1024, 1024, 1024, 0, 1024, (u16*)(ws + OFF_WOUTT) + (size_t)l * 1024 * 1024, (r % 16) * 64, (r / 16) * 64, lds);
    return;
  }
  r -= 256;
  if (r < 16) {
    transpose_tile(p.conv_pw + (size_t)l * 256 * 256, 256, 256, 0, 256, (u16*)(ws + OFF_PWT) + (size_t)l * 256 * 256, (r % 4) * 64, (r / 4) * 64, lds);
    return;
  }
  r -= 16;
  if (r < 256) {
    const int kv = r >> 7; r &= 127;
    const float* src = (kv ? p.cmp_v_w1 : p.cmp_k_w1) + (size_t)l * 2048 * 256;
    transpose_tile(src, 256, 2048, 0, 256, (u16*)(ws + OFF_W1T) + (size_t)(l * 2 + kv) * 256 * 2048, (r % 32) * 64, (r / 32) * 64, lds);
    return;
  }
  r -= 256;
  {
    const int kv = r >> 3; r &= 7;
    const float* src = (kv ? p.cmp_v_w2 : p.cmp_k_w2) + (size_t)l * 256 * 64;
    transpose_tile(src, 64, 256, 0, 64, (u16*)(ws + OFF_W2T) + (size_t)(l * 2 + kv) * 128 * 256, (r % 4) * 64, (r / 4) * 64, lds);
  }
}

DI void cbias_item(const Params& p, int item, unsigned lds) {
  const int idx = item >> 3, ng = item & 7;
  const int l = idx >> 1, kv = idx & 1;
  const float* pe = (kv ? p.cmp_pe_v : p.cmp_pe_k) + (size_t)l * 2048;
  const float* w1 = (kv ? p.cmp_v_w1 : p.cmp_k_w1) + (size_t)l * 2048 * 256;
  const int tid = ltid(), nn = tid & 31, ksl = tid >> 5;
  const int n = ng * 32 + nn;
  float s0 = 0.f, s1 = 0.f, s2 = 0.f, s3 = 0.f;
  const float* wp = w1 + (size_t)(ksl * 256) * 256 + n;
  const float* pp = pe + ksl * 256;
#pragma unroll 4
  for (int i = 0; i < 256; i += 4) {
    s0 = fmaf(pp[i], wp[(size_t)i * 256], s0);
    s1 = fmaf(pp[i + 1], wp[(size_t)(i + 1) * 256], s1);
    s2 = fmaf(pp[i + 2], wp[(size_t)(i + 2) * 256], s2);
    s3 = fmaf(pp[i + 3], wp[(size_t)(i + 3) * 256], s3);
  }
  __syncthreads();
  *LDSP(float, lds + 4 * tid) = (s0 + s1) + (s2 + s3);
  __syncthreads();
  if (tid < 32) {
    float t = 0.f;
#pragma unroll
    for (int k = 0; k < 8; ++k) t += *LDSP(float, lds + 4 * (k * 32 + tid));
    ((float*)(p.ws + OFF_CBIAS))[idx * 256 + n] = t;
  }
}

DI void rope_item(const Params& p, int idx) {
  const int e = idx * 256 + ltid();
  const int pos = e >> 3, i = e & 7;
  const float inv = powf(500000.0f, -(float)(2 * i) / 16.0f);
  const float ang = (float)pos * inv;
  float2 cs; cs.x = cosf(ang); cs.y = sinf(ang);
  ((float2*)(p.ws + OFF_ROPE))[e] = cs;
}

DI void wtail_item(const Params& p, int item) {
  const int l = item >> 5, j = item & 31;
  float* dst = (float*)(p.ws + OFF_WTAIL) + (size_t)item * 1024;
  const int tid = ltid();
  const int col = (j < 4) ? 768 + j : 3076 + (j - 4);
#pragma unroll
  for (int i = 0; i < 4; ++i) {
    const int k = tid + 256 * i;
    dst[k] = (j < 28) ? p.w_in[((size_t)l * 1024 + k) * 3612 + col] : 0.f;
  }
}

DI void norm_item(const float* __restrict__ src, const float* __restrict__ g, u16* dstb, float* dstf, int item,
                  const float* __restrict__ wt, const float* __restrict__ foxb, float* flog, float* ngl) {
  const int tid_ = ltid(); const int lane = tid_ & 63, w = tid_ >> 6;
  const int row = item * 4 + w;
  const float4* s4 = (const float4*)(src + (size_t)row * 1024);
  float4 v[4];
  float ss = 0.f;
#pragma unroll
  for (int i = 0; i < 4; ++i) { v[i] = s4[lane + 64 * i]; ss += v[i].x * v[i].x + v[i].y * v[i].y + v[i].z * v[i].z + v[i].w * v[i].w; }
#pragma unroll
  for (int o = 32; o > 0; o >>= 1) ss += __shfl_xor(ss, o);
  const float rs = rsqrtf(ss * (1.0f / 1024.0f) + 1e-6f);
#pragma unroll
  for (int i = 0; i < 4; ++i) {
    float4 gg = ((const float4*)g)[lane + 64 * i];
    float4 o = {v[i].x * rs * gg.x, v[i].y * rs * gg.y, v[i].z * rs * gg.z, v[i].w * rs * gg.w};
    v[i] = o;
    if (dstb) {
      u32x2 pk; pk[0] = pk2(o.x, o.y); pk[1] = pk2(o.z, o.w);
      *(u32x2*)(dstb + (size_t)row * 1024 + (lane + 64 * i) * 4) = pk;
    } else {
      ((float4*)(dstf + (size_t)row * 1024))[lane + 64 * i] = o;
    }
  }
  if (wt) {
    float a[32];
#pragma unroll
    for (int j = 0; j < 32; ++j) {
      float acc = 0.f;
      if (j < 28) {
#pragma unroll
        for (int i = 0; i < 4; ++i) {
          const float4 ww = ((const float4*)(wt + (size_t)j * 1024))[lane + 64 * i];
          acc = fmaf(v[i].x, ww.x, acc); acc = fmaf(v[i].y, ww.y, acc); acc = fmaf(v[i].z, ww.z, acc); acc = fmaf(v[i].w, ww.w, acc);
        }
      }
      a[j] = acc;
    }
#pragma unroll
    for (int t = 0; t < 16; ++t) { const bool up = (lane & 32) != 0; const float send = up ? a[t] : a[t + 16]; const float keep = up ? a[t + 16] : a[t]; a[t] = keep + __shfl_xor(send, 32); }
#pragma unroll
    for (int t = 0; t < 8; ++t) { const bool up = (lane & 16) != 0; const float send = up ? a[t] : a[t + 8]; const float keep = up ? a[t + 8] : a[t]; a[t] = keep + __shfl_xor(send, 16); }
#pragma unroll
    for (int t = 0; t < 4; ++t) { const bool up = (lane & 8) != 0; const float send = up ? a[t] : a[t + 4]; const float keep = up ? a[t + 4] : a[t]; a[t] = keep + __shfl_xor(send, 8); }
#pragma unroll
    for (int t = 0; t < 2; ++t) { const bool up = (lane & 4) != 0; const float send = up ? a[t] : a[t + 2]; const float keep = up ? a[t + 2] : a[t]; a[t] = keep + __shfl_xor(send, 4); }
    { const bool up = (lane & 2) != 0; const float send = up ? a[0] : a[1]; const float keep = up ? a[1] : a[0]; a[0] = keep + __shfl_xor(send, 2); }
    a[0] += __shfl_xor(a[0], 1);
    const int col = lane >> 1;
    if ((lane & 1) == 0) {
      const float val = a[0];
      if (col < 4) {
        const float xx = val + foxb[col];
        flog[(size_t)row * 4 + col] = fminf(xx, 0.f) - __logf(1.f + __expf(-fabsf(xx)));
      } else if (col < 28) {
        ngl[(size_t)row * 24 + (col - 4)] = sigmf(val);
      }
    }
  }
}

DI void gemm1_item(const Params& p, int l, int item, unsigned lds) {
  const int mt = item / 29, nt = item % 29;
  const int m0 = mt * 128;
  char* ws = lptr(p.ws);
  const u16* A = (const u16*)(ws + OFF_H) + (size_t)m0 * 1024;
  const u16* B = (const u16*)(ws + OFF_WINT + l * SZ_WINT) + (size_t)nt * 128 * 1024;
  const bool swap = (nt == 4 || nt == 5 || nt == 21 || nt == 23);
  f32x16 acc[2][2];
  if (swap) gemm_tile<true>(A, 1024, B, 1024, 1024, lds, acc);
  else gemm_tile<false>(A, 1024, B, 1024, 1024, lds, acc);
  const int tid = ltid(), lane = tid & 63, w = tid >> 6, wr = w >> 1, wc = w & 1, r = lane & 31, h = lane >> 5;
  const int b = m0 >> 13, t0 = m0 & 8191;
  if (swap) {
    u16* base;
    if (nt == 4 || nt == 5) { const int head = (nt - 4) * 2 + wc; base = (u16*)(ws + OFF_FVT) + (size_t)(b * 4 + head) * 64 * T_; }
    else if (nt == 21) base = (u16*)(ws + OFF_VST) + (size_t)(b * 2 + wc) * 64 * T_;
    else base = (u16*)(ws + OFF_VWT) + (size_t)(b * 2 + wc) * 64 * T_;
#pragma unroll
    for (int mi = 0; mi < 2; ++mi)
#pragma unroll
      for (int ni = 0; ni < 2; ++ni)
#pragma unroll
        for (int reg = 0; reg < 16; ++reg) {
          const int d = 32 * ni + crow(reg, h);
          const int t = vperm16(t0 + 64 * wr + 32 * mi + r);
          base[(size_t)d * T_ + t] = f2bf(acc[mi][ni][reg]);
        }
    return;
  }
  if (nt < 4 || nt == 18 || nt == 19 || nt == 20 || nt == 22 || (nt >= 14 && nt <= 17)) {
    u16* base; long rstride; float scale = 1.f; bool rope = false;
    if (nt < 2) { base = (u16*)(ws + OFF_FQ) + ((size_t)(b * 4 + nt * 2 + wc) * T_ + t0) * 64; rstride = 64; scale = 0.125f; }
    else if (nt < 4) { base = (u16*)(ws + OFF_FK) + ((size_t)(b * 4 + (nt - 2) * 2 + wc) * T_ + t0) * 64; rstride = 64; }
    else if (nt >= 14 && nt <= 17) {
      const int head8 = (nt - 14) * 2 + wc, g = head8 >> 2, hh = head8 & 3;
      base = (u16*)(ws + OFF_NQ) + (((size_t)(b * 2 + g) * T_ + t0) * 4 + hh) * 64; rstride = 256; scale = 0.125f; rope = true;
    } else {
      const size_t off = (nt == 18) ? OFF_KC : (nt == 19) ? OFF_VC : (nt == 20) ? OFF_KS : OFF_KW;
      base = (u16*)(ws + off) + ((size_t)(b * 2 + wc) * T_ + t0) * 64; rstride = 64; rope = (nt == 20 || nt == 22);
    }
    const float2* rt = (const float2*)(ws + OFF_ROPE);
    if (nt == 2 || nt == 3) {
      float mxn = 0.f;
#pragma unroll
      for (int mi = 0; mi < 2; ++mi)
#pragma unroll
        for (int reg = 0; reg < 16; ++reg) {
          const float a0 = bf2f(f2bf(acc[mi][0][reg])), a1 = bf2f(f2bf(acc[mi][1][reg]));
          float ss = a0 * a0 + a1 * a1;
          ss += __shfl_xor(ss, 1); ss += __shfl_xor(ss, 2); ss += __shfl_xor(ss, 4); ss += __shfl_xor(ss, 8); ss += __shfl_xor(ss, 16);
          mxn = fmaxf(mxn, ss);
        }
      mxn = fmaxf(mxn, __shfl_xor(mxn, 32));
      if (lane == 0) atomicMax((unsigned*)(ws + OFF_KN2) + l * 8 + b * 4 + (nt - 2) * 2 + wc, __float_as_uint(mxn));
    }
#pragma unroll
    for (int mi = 0; mi < 2; ++mi)
#pragma unroll
      for (int ni = 0; ni < 2; ++ni)
#pragma unroll
        for (int reg = 0; reg < 16; ++reg) {
          const int row = 64 * wr + 32 * mi + crow(reg, h);
          float v = acc[mi][ni][reg];
          if (ni == 0 && rope) {
            const float pv = __shfl_xor(v, 8);
            if (r < 16) {
              const float2 cs = rt[(t0 + row) * 8 + (r & 7)];
              v = (r & 8) ? (pv * cs.y + v * cs.x) : (v * cs.x - pv * cs.y);
            }
          }
          base[(size_t)row * rstride + 32 * ni + r] = f2bf(v * scale);
        }
    return;
  }
  if (nt == 28) {
    float* flog = (float*)(ws + OFF_FLOG);
    float* ngl = (float*)(ws + OFF_NGL);
    if (wc == 0) {
      const int col = r;
      const float fb = (col < 4) ? p.fox_b[l * 4 + col] : 0.f;
#pragma unroll
      for (int mi = 0; mi < 2; ++mi)
#pragma unroll
        for (int reg = 0; reg < 16; ++reg) {
          const int m = m0 + 64 * wr + 32 * mi + crow(reg, h);
          const float v = acc[mi][0][reg];
          if (col < 4) {
            const float xx = v + fb;
            flog[(size_t)m * 4 + col] = fminf(xx, 0.f) - __logf(1.f + __expf(-fabsf(xx)));
          } else if (col < 28) {
            ngl[(size_t)m * 24 + (col - 4)] = sigmf(v);
          }
        }
    }
    return;
  }
  {
    u16* base; int ld; bool silu = true;
    if (nt == 6 || nt == 7) { base = (u16*)(ws + OFF_GATE) + (nt - 6) * 128; ld = 1024; }
    else if (nt >= 8 && nt <= 11) { base = (u16*)(ws + OFF_GLU) + (nt - 8) * 128; ld = 512; silu = false; }
    else if (nt == 12 || nt == 13) { base = (u16*)(ws + OFF_GATE) + 256 + (nt - 12) * 128; ld = 1024; }
    else { base = (u16*)(ws + OFF_GATE) + 512 + (nt - 24) * 128; ld = 1024; }
#pragma unroll
    for (int mi = 0; mi < 2; ++mi)
#pragma unroll
      for (int ni = 0; ni < 2; ++ni)
#pragma unroll
        for (int reg = 0; reg < 16; ++reg) {
          const int m = m0 + 64 * wr + 32 * mi + crow(reg, h);
          float v = acc[mi][ni][reg];
          if (silu) v = siluf(v);
          base[(size_t)m * ld + 64 * wc + 32 * ni + r] = f2bf(v);
        }
  }
}

DI void tail_item(const Params& p, int l, int mt) {
  char* ws = lptr(p.ws);
  const int tid = ltid(), lane = tid & 63, w = tid >> 6, r = lane & 31, h = lane >> 5;
  const int m0 = mt * 128;
  const u16* ap = (const u16*)(ws + OFF_H) + (size_t)(m0 + 32 * w + r) * 1024 + 8 * h;
  const u16* bp = (const u16*)(ws + OFF_WINT + l * SZ_WINT) + (size_t)(3584 + r) * 1024 + 8 * h;
  f32x16 acc0, acc1;
#pragma unroll
  for (int k = 0; k < 16; ++k) { acc0[k] = 0.f; acc1[k] = 0.f; }
  for (int kb = 0; kb < 8; ++kb) {
    bf16x8 af[8], bf[8];
#pragma unroll
    for (int ks = 0; ks < 8; ++ks) { af[ks] = *(const bf16x8*)(ap + (kb * 8 + ks) * 16); bf[ks] = *(const bf16x8*)(bp + (kb * 8 + ks) * 16); }
#pragma unroll
    for (int ks = 0; ks < 8; ks += 2) { acc0 = MFMA(af[ks], bf[ks], acc0); acc1 = MFMA(af[ks + 1], bf[ks + 1], acc1); }
  }
  float* flog = (float*)(ws + OFF_FLOG);
  float* ngl = (float*)(ws + OFF_NGL);
  const int col = r;
  const float fb = (col < 4) ? p.fox_b[l * 4 + col] : 0.f;
#pragma unroll
  for (int reg = 0; reg < 16; ++reg) {
    const int m = m0 + 32 * w + crow(reg, h);
    const float v = acc0[reg] + acc1[reg];
    if (col < 4) {
      const float xx = v + fb;
      flog[(size_t)m * 4 + col] = fminf(xx, 0.f) - __logf(1.f + __expf(-fabsf(xx)));
    } else if (col < 28) {
      ngl[(size_t)m * 24 + (col - 4)] = sigmf(v);
    }
  }
}

DI void gemm2_item(const Params& p, int l, int item, unsigned lds) {
  const int mt = item >> 3, nt = item & 7;
  const int m0 = mt * 128, n0 = nt * 128;
  char* ws = lptr(p.ws);
  const u16* A = (const u16*)(ws + OFF_MIXED) + (size_t)m0 * 1024;
  const u16* B = (const u16*)(ws + OFF_WOUTT) + (size_t)l * 1024 * 1024 + (size_t)n0 * 1024;
  f32x16 acc[2][2];
  gemm_tile<false>(A, 1024, B, 1024, 1024, lds, acc);
  const int tid = ltid(), lane = tid & 63, w = tid >> 6, wr = w >> 1, wc = w & 1, r = lane & 31, h = lane >> 5;
  const float* res = (l == 0) ? p.x : p.out;
#pragma unroll
  for (int mi = 0; mi < 2; ++mi)
#pragma unroll
    for (int ni = 0; ni < 2; ++ni)
#pragma unroll
      for (int reg = 0; reg < 16; ++reg) {
        const size_t idx = (size_t)(m0 + 64 * wr + 32 * mi + crow(reg, h)) * 1024 + n0 + 64 * wc + 32 * ni + r;
        p.out[idx] = res[idx] + acc[mi][ni][reg];
      }
}

DI void conv_item(const Params& p, int l, int item, unsigned lds) {
  char* ws = lptr(p.ws);
  const int m0 = item * 64, t0 = m0 & 8191;
  const int tid = ltid(), lane = tid & 63, w = tid >> 6;
  const u16* glu = (const u16*)(ws + OFF_GLU);
  const unsigned at = lds + 32768;
  {
    f32x4 wt[31];
    const float* cw = p.conv_w + (size_t)l * 31 * 256 + lane * 4;
#pragma unroll
    for (int k = 0; k < 31; ++k) wt[k] = *(const f32x4*)(cw + k * 256);
    const float4 cb = *(const float4*)(p.conv_b + l * 256 + lane * 4);
    const float4 lg = *(const float4*)(p.conv_ln_g + l * 256 + lane * 4);
    const float4 lb = *(const float4*)(p.conv_ln_b + l * 256 + lane * 4);
    for (int sub = 0; sub < 2; ++sub) {
      const int ts = t0 + 32 * sub;
      __syncthreads();
      {
        const int c8 = (tid & 31) * 8, rsub = tid >> 5;
#pragma unroll
        for (int pb = 0; pb < 8; pb += 4) {
          u32x4 av[4], bv[4];
#pragma unroll
          for (int q = 0; q < 4; ++q) {
            const int i = (pb + q) * 8 + rsub;
            int t = ts - 30 + i; if (t < 0) t = 0; if (t > T_ - 1) t = T_ - 1;
            const size_t m = (size_t)(m0 - t0 + t);
            av[q] = *(const u32x4*)(glu + m * 512 + c8);
            bv[q] = *(const u32x4*)(glu + m * 512 + 256 + c8);
          }
#pragma unroll
          for (int q = 0; q < 4; ++q) {
            const int i = (pb + q) * 8 + rsub;
            const bool ok = (ts - 30 + i) >= 0;
            u32x4 yv;
#pragma unroll
            for (int e = 0; e < 4; ++e) {
              const unsigned y = pk2(bflo(av[q][e]) * sigmf(bflo(bv[q][e])), bfhi(av[q][e]) * sigmf(bfhi(bv[q][e])));
              yv[e] = ok ? y : 0u;
            }
            if (i < 62) *LDSP(u32x4, lds + i * 512 + c8 * 2) = yv;
          }
        }
      }
      __syncthreads();
#pragma unroll 2
      for (int j = 0; j < 8; ++j) {
        const int tt = 8 * w + j;
        float4 o = cb;
#pragma unroll
        for (int k = 0; k < 31; ++k) {
          const u32x2 yy = *LDSP(u32x2, lds + (tt + k) * 512 + lane * 8);
          o.x = fmaf(wt[k][0], bflo(yy[0]), o.x);
          o.y = fmaf(wt[k][1], bfhi(yy[0]), o.y);
          o.z = fmaf(wt[k][2], bflo(yy[1]), o.z);
          o.w = fmaf(wt[k][3], bfhi(yy[1]), o.w);
        }
        float s = o.x + o.y + o.z + o.w;
#pragma unroll
        for (int of = 32; of > 0; of >>= 1) s += __shfl_xor(s, of);
        const float mu = s * (1.f / 256.f);
        const float dx = o.x - mu, dy = o.y - mu, dz = o.z - mu, dw = o.w - mu;
        float vs = dx * dx + dy * dy + dz * dz + dw * dw;
#pragma unroll
        for (int of = 32; of > 0; of >>= 1) vs += __shfl_xor(vs, of);
        const float rs = rsqrtf(vs * (1.f / 256.f) + 1e-6f);
        const float y0 = siluf(dx * rs * lg.x + lb.x), y1 = siluf(dy * rs * lg.y + lb.y);
        const float y2 = siluf(dz * rs * lg.z + lb.z), y3 = siluf(dw * rs * lg.w + lb.w);
        u32x2 pk; pk[0] = pk2(y0, y1); pk[1] = pk2(y2, y3);
        const int row = 32 * sub + tt;
        *LDSP(u32x2, at + row * 512 + (((lane >> 1) ^ (row & 15)) << 4) + 8 * (lane & 1)) = pk;
      }
    }
  }
  __syncthreads();
  const int r = lane & 31, h = lane >> 5;
  const u16* pw = (const u16*)(ws + OFF_PWT) + (size_t)l * 65536 + (size_t)(64 * w + r) * 256 + 8 * h;
  f32x16 acc[2][2];
  zero_acc(acc);
#pragma unroll
  for (int kb = 0; kb < 2; ++kb) {
    bf16x8 bfr[8][2];
#pragma unroll
    for (int ks = 0; ks < 8; ++ks)
#pragma unroll
      for (int ni = 0; ni < 2; ++ni) bfr[ks][ni] = *(const bf16x8*)(pw + (size_t)ni * 32 * 256 + (kb * 8 + ks) * 16);
#pragma unroll
    for (int ks = 0; ks < 8; ++ks) {
      const int kk = kb * 8 + ks;
      bf16x8 af[2];
#pragma unroll
      for (int mi = 0; mi < 2; ++mi) { const int row = 32 * mi + r; af[mi] = *LDSP(bf16x8, at + row * 512 + (((2 * kk + h) ^ (row & 15)) << 4)); }
#pragma unroll
      for (int mi = 0; mi < 2; ++mi)
#pragma unroll
        for (int ni = 0; ni < 2; ++ni) acc[mi][ni] = MFMA(af[mi], bfr[ks][ni], acc[mi][ni]);
    }
  }
  const u16* gate = (const u16*)(ws + OFF_GATE);
  u16* mixed = (u16*)(ws + OFF_MIXED);
#pragma unroll
  for (int mi = 0; mi < 2; ++mi)
#pragma unroll
    for (int ni = 0; ni < 2; ++ni)
#pragma unroll
      for (int reg = 0; reg < 16; ++reg) {
        const size_t idx = (size_t)(m0 + 32 * mi + crow(reg, h)) * 1024 + 256 + 64 * w + 32 * ni + r;
        mixed[idx] = f2bf(acc[mi][ni][reg] * bf2f(gate[idx]));
      }
}

DI void compress_item(const Params& p, int l, int item64, unsigned lds) {
  char* ws = lptr(p.ws);
  const int nh = item64 & 1, item = item64 >> 1;
  const int mtile = item & 3, kv = (item >> 2) & 1, bg = item >> 3;
  const u16* src = (const u16*)(ws + (kv ? OFF_VC : OFF_KC)) + ((size_t)bg * T_ + (size_t)16 * 128 * mtile) * 64;
  const u16* w1t = (const u16*)(ws + OFF_W1T) + (size_t)(l * 2 + kv) * 256 * 2048;
  const u16* w2t = (const u16*)(ws + OFF_W2T) + (size_t)(l * 2 + kv) * 128 * 256;
  const float* bias = (const float*)(ws + OFF_CBIAS) + (l * 2 + kv) * 256;
  u16* hid = (u16*)(ws + OFF_HID) + (size_t)item * 128 * 256;
  const int tid = ltid(), lane = tid & 63, w = tid >> 6, wr = w >> 1, wc = w & 1, r = lane & 31, h = lane >> 5;
  {
    f32x16 acc[2][2];
    gemm_tile<false>(src, 1024, w1t + (size_t)nh * 128 * 2048, 2048, 2048, lds, acc);
#pragma unroll
    for (int ni = 0; ni < 2; ++ni) {
      const int col = nh * 128 + 64 * wc + 32 * ni + r;
      const float bb = bias[col];
#pragma unroll
      for (int mi = 0; mi < 2; ++mi)
#pragma unroll
        for (int reg = 0; reg < 16; ++reg) {
          const int row = 64 * wr + 32 * mi + crow(reg, h);
          hid[(size_t)row * 256 + col] = f2bf(geluf(acc[mi][ni][reg] + bb));
        }
    }
  }
  __threadfence();
  __syncthreads();
  if (tid == 0) {
    const int old = atomicAdd((int*)(ws + OFF_CNT) + l * 32 + item, 1);
    *LDSP(int, lds) = old;
  }
  __syncthreads();
  const int arrived = *LDSP(int, lds);
  if (arrived == 0) return;
  __threadfence();
  f32x16 acc[2][2];
  if (kv == 0) {
    gemm_tile<false>(hid, 256, w2t, 256, 256, lds, acc);
    if (wc == 0) {
      u16* kcmp = (u16*)(ws + OFF_KCMP) + (size_t)bg * 512 * 64;
      const float2* rt = (const float2*)(ws + OFF_ROPE);
#pragma unroll
      for (int mi = 0; mi < 2; ++mi)
#pragma unroll
        for (int ni = 0; ni < 2; ++ni)
#pragma unroll
          for (int reg = 0; reg < 16; ++reg) {
            const int n = 128 * mtile + 64 * wr + 32 * mi + crow(reg, h);
            float v = acc[mi][ni][reg];
            if (ni == 0) {
              const float pv = __shfl_xor(v, 8);
              if (r < 16) {
                int pos = 16 * n + 31; if (pos > 8191) pos = 8191;
                const float2 cs = rt[pos * 8 + (r & 7)];
                v = (r & 8) ? (pv * cs.y + v * cs.x) : (v * cs.x - pv * cs.y);
              }
            }
            kcmp[(size_t)n * 64 + 32 * ni + r] = f2bf(v);
          }
    }
  } else {
    gemm_tile<true>(hid, 256, w2t, 256, 256, lds, acc);
    if (wc == 0) {
      u16* vcmpT = (u16*)(ws + OFF_VCMPT) + (size_t)bg * 64 * 512;
#pragma unroll
      for (int mi = 0; mi < 2; ++mi)
#pragma unroll
        for (int ni = 0; ni < 2; ++ni)
#pragma unroll
          for (int reg = 0; reg < 16; ++reg) {
            const int n = 128 * mtile + 64 * wr + 32 * mi + r;
            const int d = 32 * ni + crow(reg, h);
            vcmpT[(size_t)d * 512 + vperm16(n)] = (n < 511) ? f2bf(acc[mi][ni][reg]) : (u16)0;
          }
    }
  }
  asm volatile("s_waitcnt vmcnt(0)" ::: "memory");
  __syncthreads();
  if (tid == 0) {
    __builtin_amdgcn_fence(__ATOMIC_RELEASE, "agent");
    asm volatile("s_waitcnt vmcnt(0)" ::: "memory");
    __hip_atomic_fetch_add((unsigned*)(ws + OFF_BAR) + 3800 + l * 4 + bg, 1u, __ATOMIC_RELAXED, __HIP_MEMORY_SCOPE_AGENT);
  }
}

struct TileRegs { u32x4 k0, k1, v0, v1; };
DI void tile_gload(TileRegs& tr, const u16* __restrict__ kbase, long kstride, const u16* __restrict__ vbase, long vstride) {
  const int tid = ltid(), row = tid >> 2, c0 = (tid & 3) * 2;
  const u16* kp = kbase + (long)row * kstride + c0 * 8;
  const u16* vp = vbase + (long)row * vstride + c0 * 8;
  tr.k0 = *(const u32x4*)kp; tr.k1 = *(const u32x4*)(kp + 8);
  tr.v0 = *(const u32x4*)vp; tr.v1 = *(const u32x4*)(vp + 8);
}
DI void tile_swrite(const TileRegs& tr, unsigned buf) {
  const int tid = ltid(), row = tid >> 2, c0 = (tid & 3) * 2;
  *LDSP(u32x4, buf + swz(row, c0)) = tr.k0;
  *LDSP(u32x4, buf + swz(row, c0 + 1)) = tr.k1;
  *LDSP(u32x4, buf + 8192 + swz(row, c0)) = tr.v0;
  *LDSP(u32x4, buf + 8192 + swz(row, c0 + 1)) = tr.v1;
}
DI void load_qfrags(bf16x8 (&QB)[2][4], const u16* __restrict__ qrows  ) {
  const int lane = ltid() & 63, r = lane & 31, h = lane >> 5;
#pragma unroll
  for (int ni = 0; ni < 2; ++ni)
#pragma unroll
    for (int ks = 0; ks < 4; ++ks) QB[ni][ks] = *(const bf16x8*)(qrows + (size_t)(32 * ni + r) * 64 + 16 * ks + 8 * h);
}
DI float dpp_xor1(float x) { return __builtin_bit_cast(float, __builtin_amdgcn_mov_dpp(__builtin_bit_cast(int, x), 0xB1, 0xF, 0xF, true)); }
DI float dpp_xor2(float x) { return __builtin_bit_cast(float, __builtin_amdgcn_mov_dpp(__builtin_bit_cast(int, x), 0x4E, 0xF, 0xF, true)); }
DI int dpp_xor1i(int x) { return __builtin_amdgcn_mov_dpp(x, 0xB1, 0xF, 0xF, true); }
DI int dpp_xor2i(int x) { return __builtin_amdgcn_mov_dpp(x, 0x4E, 0xF, 0xF, true); }
DI int dpp_hmi(int x) { return __builtin_amdgcn_mov_dpp(x, 0x141, 0xF, 0xF, true); }
DI float xhalf_max(float x) {
  const unsigned u = __float_as_uint(x);
  const auto rr = __builtin_amdgcn_permlane32_swap(u, u, false, false);
  return fmaxf(__uint_as_float(rr[0]), __uint_as_float(rr[1]));
}
DI float xhalf_sum(float x) {
  const unsigned u = __float_as_uint(x);
  const auto rr = __builtin_amdgcn_permlane32_swap(u, u, false, false);
  return __uint_as_float(rr[0]) + __uint_as_float(rr[1]);
}
template <int MODE, bool BIAS = false>
DI void attn_step1(const bf16x8 (&QB)[2][4], const unsigned Ks, f32x16 (&ot)[2][2], float (&m)[2], float (&l)[2], const int bnd, const bool rowok, const float sc2,
                   const bool first, const float cq = 0.f, const unsigned ck = 0u) {
  const int lane = ltid() & 63, r = lane & 31, h = lane >> 5;
  f32x16 s0, s1;
#pragma unroll
  for (int k = 0; k < 16; ++k) { s0[k] = 0.f; s1[k] = 0.f; }
#pragma unroll
  for (int ks = 0; ks < 4; ++ks) {
    const bf16x8 k0 = *LDSP(bf16x8, Ks + swz(r, 2 * ks + h));
    const bf16x8 k1 = *LDSP(bf16x8, Ks + swz(32 + r, 2 * ks + h));
    s0 = MFMA(k0, QB[0][ks], s0);
    s1 = MFMA(k1, QB[0][ks], s1);
  }
  if (BIAS) {
#pragma unroll
    for (int g4 = 0; g4 < 4; ++g4) {
      const f32x4 ca = *LDSP(f32x4, ck + 4 * (8 * g4 + 4 * h));
      const f32x4 cb = *LDSP(f32x4, ck + 4 * (32 + 8 * g4 + 4 * h));
#pragma unroll
      for (int e = 0; e < 4; ++e) {
        s0[4 * g4 + e] = fmaf(s0[4 * g4 + e], LOG2E, cq - ca[e]);
        s1[4 * g4 + e] = fmaf(s1[4 * g4 + e], LOG2E, cq - cb[e]);
      }
    }
  }
  if (MODE == 1) {
#pragma unroll
    for (int reg = 0; reg < 16; ++reg) {
      const int keyc = (reg & 3) + 8 * (reg >> 2);
      s0[reg] = (keyc <= bnd) ? s0[reg] : -1e30f;
      s1[reg] = (keyc + 32 <= bnd) ? s1[reg] : -1e30f;
    }
  }
  if (MODE == 2) {
#pragma unroll
    for (int reg = 0; reg < 16; ++reg) {
      const int keyc = (reg & 3) + 8 * (reg >> 2);
      s0[reg] = (keyc >= bnd) ? s0[reg] : -1e30f;
      s1[reg] = (keyc + 32 >= bnd) ? s1[reg] : -1e30f;
    }
  }
  if (first) {
    float mx = fmaxf(s0[0], s1[0]);
#pragma unroll
    for (int reg = 1; reg < 16; ++reg) mx = fmaxf(mx, fmaxf(s0[reg], s1[reg]));
    mx = xhalf_max(mx);
    if (MODE == 3) mx = rowok ? mx : -1e30f;
    m[0] = fmaxf(-1e20f, mx);
  }
  float mb = -m[0] * sc2;
  if (MODE == 3) mb = rowok ? mb : -__builtin_inff();
  float rs0 = 0.f, rs1 = 0.f;
#pragma unroll
  for (int reg = 0; reg < 16; ++reg) {
    const float p0 = EXP2(fmaf(s0[reg], sc2, mb)); s0[reg] = p0; rs0 += p0;
    const float p1 = EXP2(fmaf(s1[reg], sc2, mb)); s1[reg] = p1; rs1 += p1;
  }
  l[0] += xhalf_sum(rs0 + rs1);
  const unsigned Vs = Ks + 8192;
#pragma unroll
  for (int kk = 0; kk < 4; ++kk) {
    const int mi = kk >> 1, s = kk & 1;
    u32x4 pk;
#pragma unroll
    for (int i = 0; i < 4; ++i) pk[i] = mi ? pk2(s1[8 * s + 2 * i], s1[8 * s + 2 * i + 1]) : pk2(s0[8 * s + 2 * i], s0[8 * s + 2 * i + 1]);
    const bf16x8 pf = __builtin_bit_cast(bf16x8, pk);
    bf16x8 vf[2];
#pragma unroll
    for (int di = 0; di < 2; ++di) {
      const int d = 32 * di + r;
      const int sw = (d >> 1) & 7;
      vf[di] = *LDSP(bf16x8, Vs + d * 128 + (((4 * mi + 2 * s + h) ^ sw) << 4));
    }
#pragma unroll
    for (int di = 0; di < 2; ++di) ot[di][0] = MFMA(vf[di], pf, ot[di][0]);
  }
}

template <class LoadF, class BodyF>
DI void tile_pipeline(const int n, const unsigned lds, LoadF&& ld, BodyF&& body) {
  TileRegs A, B;
  ld(A, 0);
  __syncthreads();
  tile_swrite(A, lds);
  if (n > 1) ld(A, 1);
  if (n > 2) ld(B, 2);
  __syncthreads();
  int j = 0;
  while (true) {
    body(j, lds);
    if (j + 1 < n) tile_swrite(A, lds + 16384);
    if (j + 3 < n) ld(A, j + 3);
    __syncthreads();
    if (++j >= n) break;
    body(j, lds + 16384);
    if (j + 1 < n) tile_swrite(B, lds);
    if (j + 3 < n) ld(B, j + 3);
    __syncthreads();
    if (++j >= n) break;
  }
}

template <int MI, int NIM>
DI void qk_half(const bf16x8 (&QB)[2][4], const unsigned Ks, f32x16 (&st)[2]) {
  const int lane = ltid() & 63, r = lane & 31, h = lane >> 5;
#pragma unroll
  for (int j = 0; j < 2; ++j)
#pragma unroll
    for (int k = 0; k < 16; ++k) st[j][k] = 0.f;
#pragma unroll
  for (int ks = 0; ks < 4; ++ks) {
    const bf16x8 kf = *LDSP(bf16x8, Ks + swz(32 * MI + r, 2 * ks + h));
#pragma unroll
    for (int ni = 0; ni < 2; ++ni)
      if (NIM & (1 << ni)) st[ni] = MFMA(kf, QB[ni][ks], st[ni]);
  }
}
template <int MI>
DI void mask_hi(f32x16 (&st)[2], const int (&hi)[2]) {
#pragma unroll
  for (int reg = 0; reg < 16; ++reg) {
    const int keyc = 32 * MI + (reg & 3) + 8 * (reg >> 2);
#pragma unroll
    for (int ni = 0; ni < 2; ++ni) st[ni][reg] = (keyc <= hi[ni]) ? st[ni][reg] : -1e30f;
  }
}
template <int MI>
DI void mask_lo(f32x16 (&st)[2], const int (&lo)[2]) {
#pragma unroll
  for (int reg = 0; reg < 16; ++reg) {
    const int keyc = 32 * MI + (reg & 3) + 8 * (reg >> 2);
#pragma unroll
    for (int ni = 0; ni < 2; ++ni) st[ni][reg] = (keyc >= lo[ni]) ? st[ni][reg] : -1e30f;
  }
}
template <int MI, int NIM, bool ROWSEL>
DI void softmax_pv(f32x16 (&st)[2], const unsigned Vs, f32x16 (&ot)[2][2], float (&m)[2], float (&l)[2], const float sc2, const bool (&rowok)[2]) {
  const int lane = ltid() & 63, r = lane & 31, h = lane >> 5;
#pragma unroll
  for (int ni = 0; ni < 2; ++ni) {
    if (!(NIM & (1 << ni))) continue;
    float mx = st[ni][0];
#pragma unroll
    for (int reg = 1; reg < 16; ++reg) mx = fmaxf(mx, st[ni][reg]);
    mx = fmaxf(mx, __shfl_xor(mx, 32));
    if (ROWSEL) mx = rowok[ni] ? mx : -1e30f;
    const float mold = m[ni];
    const float mnew = fmaxf(mold, mx);
    const float alpha = EXP2((mold - mnew) * sc2);
    m[ni] = mnew;
    float mb = -mnew * sc2;
    if (ROWSEL) mb = rowok[ni] ? mb : -__builtin_inff();
    float rs = 0.f;
#pragma unroll
    for (int reg = 0; reg < 16; ++reg) { const float pp = EXP2(fmaf(st[ni][reg], sc2, mb)); st[ni][reg] = pp; rs += pp; }
    rs += __shfl_xor(rs, 32);
    l[ni] = l[ni] * alpha + rs;
    if (__builtin_amdgcn_ballot_w64(mnew > mold) != 0ull) {
#pragma unroll
      for (int di = 0; di < 2; ++di)
#pragma unroll
        for (int reg = 0; reg < 16; ++reg) ot[di][ni][reg] *= alpha;
    }
  }
#pragma unroll
  for (int s = 0; s < 2; ++s) {
    bf16x8 pf[2], vf[2];
#pragma unroll
    for (int ni = 0; ni < 2; ++ni) {
      if (!(NIM & (1 << ni))) continue;
      u32x4 pk;
#pragma unroll
      for (int i = 0; i < 4; ++i) pk[i] = pk2(st[ni][8 * s + 2 * i], st[ni][8 * s + 2 * i + 1]);
      pf[ni] = __builtin_bit_cast(bf16x8, pk);
    }
#pragma unroll
    for (int di = 0; di < 2; ++di) {
      const int d = 32 * di + r;
      const int sw = (d >> 1) & 7;
      const u32x2 lo = *LDSP(u32x2, Vs + d * 128 + (((4 * MI + 2 * s) ^ sw) << 4) + 8 * h);
      const u32x2 hi = *LDSP(u32x2, Vs + d * 128 + (((4 * MI + 2 * s + 1) ^ sw) << 4) + 8 * h);
      u32x4 vv; vv[0] = lo[0]; vv[1] = lo[1]; vv[2] = hi[0]; vv[3] = hi[1];
      vf[di] = __builtin_bit_cast(bf16x8, vv);
    }
#pragma unroll
    for (int di = 0; di < 2; ++di)
#pragma unroll
      for (int ni = 0; ni < 2; ++ni)
        if (NIM & (1 << ni)) ot[di][ni] = MFMA(vf[di], pf[ni], ot[di][ni]);
  }
}
template <int NIM, int MODE>
DI void attn_step(const bf16x8 (&QB)[2][4], const unsigned Ks, f32x16 (&ot)[2][2], float (&m)[2], float (&l)[2], const int (&bnd)[2], const bool (&rowok)[2]) {
  {
    f32x16 st[2];
    qk_half<0, NIM>(QB, Ks, st);
    if (MODE == 1) mask_hi<0>(st, bnd);
    if (MODE == 2) mask_lo<0>(st, bnd);
    softmax_pv<0, NIM, MODE == 3>(st, Ks + 8192, ot, m, l, LOG2E, rowok);
  }
  {
    f32x16 st[2];
    qk_half<1, NIM>(QB, Ks, st);
    if (MODE == 1) mask_hi<1>(st, bnd);
    if (MODE == 2) mask_lo<1>(st, bnd);
    softmax_pv<1, NIM, MODE == 3>(st, Ks + 8192, ot, m, l, LOG2E, rowok);
  }
}

DI void fox_item(const Params& p, int l, int item, unsigned lds) {
  char* ws = lptr(p.ws);
  const int bh = item & 7, qt = 63 - (item >> 3);
  const int b = bh >> 2, hd = bh & 3;
  const int q0 = qt * 128;
  const int tid = ltid(), lane = tid & 63, w = tid >> 6, r = lane & 31, h = lane >> 5;
  const u16* kb = (const u16*)(ws + OFF_FK) + (size_t)bh * T_ * 64;
  const u16* vb = (const u16*)(ws + OFF_FVT) + (size_t)bh * 64 * T_;
  const float* flog = (const float*)(ws + OFF_FLOG) + (size_t)b * T_ * 4 + hd;
  const unsigned rq = lds + 32768, ckb = lds + 32768 + 1024, wsum = lds + 32768 + 1024 + 512;
  __syncthreads();
  bf16x8 QB[2][4];
  {
    const u16* qrows = (const u16*)(ws + OFF_FQ) + ((size_t)bh * T_ + q0 + 32 * w) * 64;
#pragma unroll
    for (int ks = 0; ks < 4; ++ks) { QB[0][ks] = *(const bf16x8*)(qrows + (size_t)r * 64 + 16 * ks + 8 * h); QB[1][ks] = QB[0][ks]; }
  }
  {
    float v = (tid < 128) ? flog[(size_t)(q0 + tid) * 4] * LOG2E : 0.f;
#pragma unroll
    for (int o = 1; o < 64; o <<= 1) { const float u = __shfl_up(v, o); if (lane >= o) v += u; }
    if (tid == 63) *LDSP(float, wsum) = v;
    __syncthreads();
    if (w == 1) v += *LDSP(float, wsum);
    if (tid < 128) *LDSP(float, rq + 4 * tid) = v;
  }
  const int nkt = 2 * qt + 2;
  float qkb;
  {
    const float kn = sqrtf(((const float*)(ws + OFF_KN2))[l * 8 + bh]) * 1.02f + 1e-3f;
    float ss = 0.f;
#pragma unroll
    for (int ks = 0; ks < 4; ++ks)
#pragma unroll
      for (int e = 0; e < 8; ++e) { const float qv = bf2f((u16)QB[0][ks][e]); ss = fmaf(qv, qv, ss); }
    ss = xhalf_sum(ss);
    qkb = sqrtf(ss) * kn * LOG2E;
  }
  TileRegs tr;
  float carry = 0.f;
  float cknext = 0.f;
  tile_gload(tr, kb + (size_t)(nkt - 1) * 64 * 64, 64, vb + (size_t)(nkt - 1) * 64, T_);
  __syncthreads();
  tile_swrite(tr, lds);
  if (w == 0) *LDSP(float, ckb + 4 * lane) = *LDSP(float, rq + 4 * (64 + lane));
  __syncthreads();
  f32x16 ot[2][2]; zero_acc(ot);
  float m[2] = {-1e20f, -1e20f}, ls[2] = {0.f, 0.f};
  const float cq = *LDSP(float, rq + 4 * (32 * w + r));
  int cur = 0;
  for (int kt = nkt - 1; kt >= 0; --kt) {
    const bool more = kt > 0;
    if (more) {
      tile_gload(tr, kb + (size_t)(kt - 1) * 64 * 64, 64, vb + (size_t)(kt - 1) * 64, T_);
      if (w == 0) {
        const int ktn = kt - 1 - 2 * qt;
        if (ktn >= 0) cknext = *LDSP(float, rq + 4 * (64 * ktn + lane));
        else {
          const float v = -flog[(size_t)((kt - 1) * 64 + lane) * 4] * LOG2E;
          float inc = v;
#pragma unroll
          for (int o = 1; o < 64; o <<= 1) { const float u = __shfl_down(inc, o); if (lane + o < 64) inc += u; }
          cknext = carry + inc - v;
          carry += __shfl(inc, 0);
        }
      }
    }
    const int ktp = kt - 2 * qt;
    if (ktp <= 0 || w >= 2) {
      const unsigned Ks = lds + cur * 16384;
      const unsigned ck = ckb + cur * 256;
      const bool masked = (ktp == 1) || (ktp == 0 && w < 2);
      if (masked) attn_step1<1, true>(QB, Ks, ot, m, ls, 32 * w + r - 64 * ktp - 4 * h, true, 1.0f, true, cq, ck);
      else attn_step1<0, true>(QB, Ks, ot, m, ls, 0, true, 1.0f, false, cq, ck);
    }
    if (more) {
      tile_swrite(tr, lds + (cur ^ 1) * 16384);
      if (w == 0) *LDSP(float, ckb + 4 * ((cur ^ 1) * 64 + lane)) = cknext;
    }
    if (kt <= 2 * qt && kt > 0 && (kt & 1) == 0) {
      const float cmin = __shfl(cknext, 63);
      if (w == 0 && lane == 0) *LDSP(float, wsum + 16) = cmin;
      __syncthreads();
      const float cm = *LDSP(float, wsum + 16);
      const bool done = (qkb + cq - cm - m[0] < -40.f);
      if (__syncthreads_and(done ? 1 : 0)) break;
    } else {
      __syncthreads();
    }
    cur ^= 1;
  }
  const u16* gate = (const u16*)(ws + OFF_GATE);
  u16* mixed = (u16*)(ws + OFF_MIXED);
  {
    const float il = 1.f / ls[0];
    const size_t mrow = (size_t)(b * T_ + q0 + 32 * w + r) * 1024 + hd * 64;
#pragma unroll
    for (int di = 0; di < 2; ++di)
#pragma unroll
      for (int g4 = 0; g4 < 4; ++g4) {
        const int d = 32 * di + 8 * g4 + 4 * h;
        const u32x2 gv = *(const u32x2*)(gate + mrow + d);
        u32x2 o;
        o[0] = pk2(ot[di][0][4 * g4] * il * bflo(gv[0]), ot[di][0][4 * g4 + 1] * il * bfhi(gv[0]));
        o[1] = pk2(ot[di][0][4 * g4 + 2] * il * bflo(gv[1]), ot[di][0][4 * g4 + 3] * il * bfhi(gv[1]));
        *(u32x2*)(mixed + mrow + d) = o;
      }
  }
}

DI int tl32() { const int t = ltid(); return ((t >> 6) << 3) + ((t & 31) >> 2); }
DI void nsa_flush32(const Params& p, int mode, f32x16 (&ot)[2][2], const float ls0, int b, int g, int tbase, int br) {
  char* ws = lptr(p.ws);
  const int tid_ = ltid(); const int lane = tid_ & 63, r = lane & 31, h = lane >> 5;
  float* osc = (float*)(ws + OFF_OSC);
  const float* ngl = (const float*)(ws + OFF_NGL);
  const u16* gate = (const u16*)(ws + OFF_GATE);
  u16* mixed = (u16*)(ws + OFF_MIXED);
  const int t = tbase + tl32(), hh = r & 3;
  const size_t m = (size_t)b * T_ + t;
  const float gsig = ngl[m * 24 + (g * 4 + hh) * 3 + br];
  const float sc = (ls0 > 0.f) ? gsig / ls0 : 0.f;
  const size_t cb = m * 512 + (g * 4 + hh) * 64;
#pragma unroll
  for (int di = 0; di < 2; ++di)
#pragma unroll
    for (int g4 = 0; g4 < 4; ++g4) {
      const int d = 32 * di + 8 * g4 + 4 * h;
      float4 v = {ot[di][0][4 * g4] * sc, ot[di][0][4 * g4 + 1] * sc, ot[di][0][4 * g4 + 2] * sc, ot[di][0][4 * g4 + 3] * sc};
      if (mode > 0) { const float4 o = *(const float4*)(osc + cb + d); v.x += o.x; v.y += o.y; v.z += o.z; v.w += o.w; }
      if (mode < 2) *(float4*)(osc + cb + d) = v;
      else {
        const size_t mi2 = m * 1024 + 512 + (g * 4 + hh) * 64 + d;
        const u32x2 gv = *(const u32x2*)(gate + mi2);
        u32x2 o; o[0] = pk2(v.x * bflo(gv[0]), v.y * bfhi(gv[0])); o[1] = pk2(v.z * bflo(gv[1]), v.w * bfhi(gv[1]));
        *(u32x2*)(mixed + mi2) = o;
      }
    }
}

DI void nsa_accum32(const Params& p, f32x16 (&osum)[2], const f32x16 (&ot)[2][2], const float ls0, int b, int g, int tbase, int br, bool first) {
  char* ws = lptr(p.ws);
  const int r = ltid() & 31;
  const float* ngl = (const float*)(ws + OFF_NGL);
  const size_t m = (size_t)b * T_ + tbase + tl32();
  const float gsig = ngl[m * 24 + (g * 4 + (r & 3)) * 3 + br];
  const float sc = (ls0 > 0.f) ? gsig / ls0 : 0.f;
#pragma unroll
  for (int di = 0; di < 2; ++di)
#pragma unroll
    for (int k = 0; k < 16; ++k) osum[di][k] = first ? ot[di][0][k] * sc : fmaf(ot[di][0][k], sc, osum[di][k]);
}
DI void nsa_store32(const Params& p, const f32x16 (&osum)[2], int b, int g, int tbase) {
  char* ws = lptr(p.ws);
  const int lane = ltid() & 63, r = lane & 31, h = lane >> 5;
  const u16* gate = (const u16*)(ws + OFF_GATE);
  u16* mixed = (u16*)(ws + OFF_MIXED);
  const size_t m = (size_t)b * T_ + tbase + tl32();
  const size_t base = m * 1024 + 512 + (g * 4 + (r & 3)) * 64;
#pragma unroll
  for (int di = 0; di < 2; ++di)
#pragma unroll
    for (int g4 = 0; g4 < 4; ++g4) {
      const int d = 32 * di + 8 * g4 + 4 * h;
      const u32x2 gv = *(const u32x2*)(gate + base + d);
      u32x2 o;
      o[0] = pk2(osum[di][4 * g4] * bflo(gv[0]), osum[di][4 * g4 + 1] * bfhi(gv[0]));
      o[1] = pk2(osum[di][4 * g4 + 2] * bflo(gv[1]), osum[di][4 * g4 + 3] * bfhi(gv[1]));
      *(u32x2*)(mixed + base + d) = o;
    }
}

DI void nsa_item32(const Params& p, int l, int item, unsigned lds) {
  char* ws = lptr(p.ws);
  const int bg = item & 3, c32 = 255 - (item >> 2);
  const int b = bg >> 1, g = bg & 1;
  const int tbase = 32 * c32, c = c32 >> 1, toff = tbase & 63;
  const int tid = ltid(), lane = tid & 63, w = tid >> 6, r = lane & 31, h = lane >> 5;
  if (tid == 0 && *LDSP(unsigned, lds + 67540 + 4 * (l * 4 + bg)) == 0u) {
    unsigned* dn = (unsigned*)(ws + OFF_BAR) + 3800 + l * 4 + bg;
    while (__hip_atomic_load(dn, __ATOMIC_RELAXED, __HIP_MEMORY_SCOPE_AGENT) < 8u) __builtin_amdgcn_s_sleep(4);
    __builtin_amdgcn_fence(__ATOMIC_ACQUIRE, "agent");
    asm volatile("s_waitcnt vmcnt(0)" ::: "memory");
    *LDSP(unsigned, lds + 67540 + 4 * (l * 4 + bg)) = 1u;
  }
  const unsigned imp = lds + 32768;
  const unsigned selw = lds + 32768 + 16384;
  __syncthreads();
  bf16x8 QB[2][4];
  {
    const u16* qrows = (const u16*)(ws + OFF_NQ) + (((size_t)bg * T_ + tbase) * 4 + 32 * w) * 64;
#pragma unroll
    for (int ks = 0; ks < 4; ++ks) { QB[0][ks] = *(const bf16x8*)(qrows + (size_t)r * 64 + 16 * ks + 8 * h); QB[1][ks] = QB[0][ks]; }
  }
  for (int i = tid; i < 32 * 128; i += 256) *LDSP(float, imp + 4 * i) = 0.f;
  f32x16 ot[2][2];
  f32x16 osum[2];
  float m[2], ls[2];
  const bool rk[2] = {true, true};
  const u16* kcb = (const u16*)(ws + OFF_KCMP) + (size_t)bg * 512 * 64;
  const u16* vcb = (const u16*)(ws + OFF_VCMPT) + (size_t)bg * 64 * 512;
  const int nbc = (2 * c32) / 64 + 1;
  {
    zero_acc(ot); m[0] = m[1] = -1e20f; ls[0] = ls[1] = 0.f;
    tile_pipeline(nbc, lds,
      [&](TileRegs& t, int nb) __attribute__((always_inline)) { tile_gload(t, kcb + (size_t)nb * 64 * 64, 64, vcb + (size_t)nb * 64, 512); },
      [&](int nb, unsigned Ks) __attribute__((always_inline)) {
        const int hb = ((tbase + tl32() - 31) >> 4) - 64 * nb - 4 * h_of();
        if (64 * nb + 63 <= ((tbase - 31) >> 4)) attn_step1<0>(QB, Ks, ot, m, ls, hb, true, LOG2E, nb == 0);
        else attn_step1<1>(QB, Ks, ot, m, ls, hb, true, LOG2E, nb == 0);
      });
    nsa_accum32(p, osum, ot, ls[0], b, g, tbase, 0, true);
  }
  if (c >= 16) {
    const float il0 = (ls[0] > 0.f) ? 1.f / ls[0] : 0.f;
#define IMP_HALF(MI)                                                                               \
      {                                                                                            \
        f32x16 st[2];                                                                              \
        qk_half<MI, 1>(QB, Ks, st);                                                                \
        const int tlv = tl32(); const int hbv = ((tbase + tlv - 31) >> 4) - 64 * nb - 4 * h_of();  \
        _Pragma("unroll") for (int g4 = 0; g4 < 4; ++g4) {                                         \
          float pg[4];                                                                             \
          _Pragma("unroll") for (int e = 0; e < 4; ++e) {                                          \
            const int keyc = 32 * MI + 8 * g4 + e;                                                 \
            float pp = (keyc <= hbv) ? EXP2((st[0][4 * g4 + e] - m[0]) * LOG2E) * il0 : 0.f;       \
            pp += dpp_xor1(pp);                                                                    \
            pp += dpp_xor2(pp);                                                                    \
            pg[e] = pp;                                                                            \
          }                                                                                        \
          if ((r & 3) == g4) {                                                                     \
            const int j = 16 * nb + 8 * MI + 2 * g4 + h;                                           \
            const float G = (pg[0] + pg[1]) + (pg[2] + pg[3]);                                     \
            __hip_atomic_fetch_add(LDSP(float, imp + 4 * (tlv * 128 + j)), G, __ATOMIC_RELAXED, __HIP_MEMORY_SCOPE_WORKGROUP); \
            if (j + 1 < 128) __hip_atomic_fetch_add(LDSP(float, imp + 4 * (tlv * 128 + j + 1)), pg[3], __ATOMIC_RELAXED, __HIP_MEMORY_SCOPE_WORKGROUP); \
          }                                                                                        \
        }                                                                                          \
      }
    tile_pipeline(nbc, lds,
      [&](TileRegs& t, int nb) __attribute__((always_inline)) { tile_gload(t, kcb + (size_t)nb * 64 * 64, 64, vcb + (size_t)nb * 64, 512); },
      [&](int nb, unsigned Ks) __attribute__((always_inline)) {
        IMP_HALF(0)
        IMP_HALF(1)
      });
#undef IMP_HALF
  }
  {
    const int tok = tid >> 3, sub = tid & 7;
    unsigned word;
    if (c < 16) {
      word = 0xffffu;
    } else {
      unsigned key[16];
      word = 0;
#pragma unroll
      for (int i = 0; i < 16; ++i) {
        const int j = 16 * sub + i;
        const float v = *LDSP(float, imp + 4 * (tok * 128 + j));
        const bool cand = (j >= 1) && (j <= c - 2);
        key[i] = cand ? (__float_as_uint(v) + 1u) : 0u;
        if (j == 0 || j == c || j == c - 1) word |= (1u << i);
      }
      unsigned thr = 0;
      for (int bit = 30; bit >= 0; --bit) {
        const unsigned cd = thr | (1u << bit);
        int cnt = 0;
#pragma unroll
        for (int i = 0; i < 16; ++i) cnt += (key[i] >= cd) ? 1 : 0;
        cnt += dpp_xor1i(cnt);
        cnt += dpp_xor2i(cnt);
        cnt += dpp_hmi(cnt);
        if (cnt >= 13) thr = cd;
      }
      int gt = 0, eq = 0;
#pragma unroll
      for (int i = 0; i < 16; ++i) { gt += (key[i] > thr) ? 1 : 0; eq += (key[i] == thr) ? 1 : 0; }
      int gtt = gt; gtt += dpp_xor1i(gtt); gtt += dpp_xor2i(gtt); gtt += dpp_hmi(gtt);
      int eqb = 0;
#pragma unroll
      for (int k = 0; k < 7; ++k) { const int ek = __shfl(eq, (lane & ~7) + k); if (sub > k) eqb += ek; }
      int need = 13 - gtt - eqb;
#pragma unroll
      for (int i = 0; i < 16; ++i) {
        if (key[i] > thr) word |= (1u << i);
        else if (key[i] == thr && thr != 0u) { if (need > 0) word |= (1u << i); --need; }
      }
    }
    *LDSP(u16, selw + 16 * tok + 2 * sub) = (u16)word;
  }
  __syncthreads();
  {
    const u16* kb = (const u16*)(ws + OFF_KS) + (size_t)bg * T_ * 64;
    const u16* vb = (const u16*)(ws + OFF_VST) + (size_t)bg * 64 * T_;
    zero_acc(ot); m[0] = m[1] = -1e20f; ls[0] = ls[1] = 0.f;
    tile_pipeline(c + 1, lds,
      [&](TileRegs& t, int j) __attribute__((always_inline)) { tile_gload(t, kb + (size_t)j * 64 * 64, 64, vb + (size_t)j * 64, T_); },
      [&](int j, unsigned Ks) __attribute__((always_inline)) {
        const bool selb = ((*LDSP(unsigned, selw + 16 * tl32() + 4 * (j >> 5)) >> (j & 31)) & 1u) != 0u;
        if (j == c) {
          attn_step1<1>(QB, Ks, ot, m, ls, toff + tl32() - 4 * h_of(), true, LOG2E, j == 0);
        } else {
          if (__builtin_amdgcn_ballot_w64(selb) != 0ull) attn_step1<3>(QB, Ks, ot, m, ls, 0, selb, LOG2E, j == 0);
        }
        if (PROBE_REP == 7) attn_step1<3>(QB, Ks, ot, m, ls, 0, false, LOG2E, false);
      });
    nsa_accum32(p, osum, ot, ls[0], b, g, tbase, 1, false);
  }
  {
    const u16* kb = (const u16*)(ws + OFF_KW) + (size_t)bg * T_ * 64;
    const u16* vb = (const u16*)(ws + OFF_VWT) + (size_t)bg * 64 * T_;
    zero_acc(ot); m[0] = m[1] = -1e20f; ls[0] = ls[1] = 0.f;
    const int jlo = (c >= 8) ? c - 8 : 0;
    tile_pipeline(c - jlo + 1, lds,
      [&](TileRegs& t, int i) __attribute__((always_inline)) { const int j = c - i; tile_gload(t, kb + (size_t)j * 64 * 64, 64, vb + (size_t)j * 64, T_); },
      [&](int i, unsigned Ks) __attribute__((always_inline)) {
        const int j = c - i;
        const bool diag = (j == c), far = (j == c - 8);
        if (diag) attn_step1<1>(QB, Ks, ot, m, ls, toff + tl32() - 4 * h_of(), true, LOG2E, true);
        else if (far) attn_step1<2>(QB, Ks, ot, m, ls, toff + tl32() + 1 - 4 * h_of(), true, LOG2E, false);
        else attn_step1<0>(QB, Ks, ot, m, ls, 0, true, LOG2E, false);
      });
    nsa_accum32(p, osum, ot, ls[0], b, g, tbase, 2, false);
    nsa_store32(p, osum, b, g, tbase);
  }
}

#define XB_TMO      128
#define XB_XCNT(j)  (256  + 64 * (j))
#define XB_XSUB(j)  (1280 + 64 * (j))
#define XB_XGEN(j)  (2304 + 64 * (j))
#define XB_TOP      3328
#define XB_TOPGEN   3392
#define XCD_BAR_WORDS 3456
#define XB_SPIN_CAP (1u << 18)
#define LAS __attribute__((address_space(3)))

__device__ __forceinline__ unsigned xb_ld(unsigned* p)              { return __hip_atomic_load(p, __ATOMIC_RELAXED, __HIP_MEMORY_SCOPE_AGENT); }
__device__ __forceinline__ unsigned xb_add(unsigned* p, unsigned v) { return __hip_atomic_fetch_add(p, v, __ATOMIC_RELAXED, __HIP_MEMORY_SCOPE_AGENT); }
__device__ __forceinline__ unsigned xb_xcc_id() { return (unsigned)__builtin_amdgcn_s_getreg((3 << 11) | 20) & 0xFu; }
#define XB_SPIN(cond, bar) do { unsigned _sp = 0; while (cond) { __builtin_amdgcn_s_sleep(1); \
    if ((++_sp & 255u) == 0u) { if (xb_ld(&(bar)[XB_TMO])) break; if (_sp > XB_SPIN_CAP) { atomicAdd(&(bar)[XB_TMO], 1u); break; } } } } while (0)

struct XcdBarrier {
    unsigned* bar; unsigned x;
    volatile LAS unsigned* st;
};

__device__ __forceinline__ XcdBarrier xcd_barrier_post(unsigned* bar, volatile LAS unsigned* st) {
    XcdBarrier b; b.bar = bar; b.x = xb_xcc_id(); b.st = st;
    if (threadIdx.x == 0) (void)xb_add(&bar[XB_XCNT(b.x)], 1u);
    return b;
}
__device__ __forceinline__ void xcd_barrier_complete(unsigned* bar, unsigned x, unsigned& nloc, unsigned& nx) {
    const unsigned G = gridDim.x * gridDim.y * gridDim.z;
    unsigned sum, cnt, mine, sp = 0u;
    for (;;) {
        sum = 0u; cnt = 0u; mine = 0u;
#pragma unroll
        for (unsigned j = 0; j < 16; ++j) { const unsigned c = xb_ld(&bar[XB_XCNT(j)]); sum += c; cnt += (c > 0u) ? 1u : 0u; mine = (j == x) ? c : mine; }
        if (sum == G) break;
        __builtin_amdgcn_s_sleep(1);
        if ((++sp & 255u) == 0u) { if (xb_ld(&bar[XB_TMO])) break; if (sp > XB_SPIN_CAP) { atomicAdd(&bar[XB_TMO], 1u); break; } }
    }
    nloc = mine > 0u ? mine : 1u; nx = cnt > 0u ? cnt : 1u;
}

__device__ __forceinline__ void xcd_barrier(const XcdBarrier& b) {
    asm volatile("s_waitcnt vmcnt(0)" ::: "memory");
    __syncthreads();
    if (threadIdx.x == 0) {
        unsigned* bar = b.bar;
        __builtin_amdgcn_s_waitcnt(0);
        unsigned nloc = b.st[0], nx = b.st[1];
        if (nloc == 0u) { xcd_barrier_complete(bar, b.x, nloc, nx); b.st[0] = nloc; b.st[1] = nx; }
        const unsigned old = xb_add(&bar[XB_XSUB(b.x)], 1u);
        const unsigned gen = old / nloc;
        if (old + 1u == (gen + 1u) * nloc) {
            __builtin_amdgcn_fence(__ATOMIC_RELEASE, "agent");
            asm volatile("s_waitcnt vmcnt(0)" ::: "memory");
            const unsigned og = xb_add(&bar[XB_TOP], 1u);
            const unsigned tg = og / nx;
            if (og + 1u == (tg + 1u) * nx) xb_add(&bar[XB_TOPGEN], 1u);
            else XB_SPIN(xb_ld(&bar[XB_TOPGEN]) == tg, bar);
            __builtin_amdgcn_fence(__ATOMIC_ACQUIRE, "agent");
            xb_add(&bar[XB_XGEN(b.x)], 1u);
            asm volatile("s_waitcnt vmcnt(0)" ::: "memory");
        } else {
            XB_SPIN(xb_ld(&bar[XB_XGEN(b.x)]) == gen, bar);
            __builtin_amdgcn_fence(__ATOMIC_ACQUIRE, "agent");
            asm volatile("s_waitcnt vmcnt(0)" ::: "memory");
        }
    }
    __syncthreads();
}


__global__ void __launch_bounds__(256, 2) fwd_megakernel(Params p) {
  cg::grid_group grid = cg::this_grid();
  __shared__ __attribute__((aligned(16))) char lds_arr[LDS_BYTES];
  const unsigned lds = (unsigned)(size_t)lds_arr;
  if (threadIdx.x < 16) *LDSP(unsigned, lds + 67520 + 4 * threadIdx.x) = 0u;
  __syncthreads();
  const XcdBarrier xb = xcd_barrier_post((unsigned*)(p.ws + OFF_BAR), (volatile LAS unsigned*)(lds + 67520));
#define GSYNC() xcd_barrier(xb)
  if (gridDim.x == 0x7fffffffu) grid.sync();
  const int G = gridDim.x, bid = blockIdx.x;
  for (int whole = 0; whole < (PROBE_REP == 6 ? 2 : 1); ++whole) {
  if (whole) GSYNC();
  for (int rep0 = 0; rep0 < (PROBE_REP == 4 ? 2 : 1); ++rep0) {
  for (int i = bid; i < 2 * P0_PER_LAYER; i += G) phase0_item(p, i, lds);
  for (int i = G - 1 - bid; i < 32; i += G) cbias_item(p, i, lds);
  if (bid == 0 && threadIdx.x < 128) ((unsigned*)(p.ws + OFF_KN2))[threadIdx.x] = 0u;
  for (int i = bid; i < 256; i += G) rope_item(p, i);
  for (int i = bid; i < BT / 4; i += G) norm_item(p.x, p.norm_g, (u16*)(p.ws + OFF_H), nullptr, i, nullptr, nullptr, nullptr, nullptr);
  }
  GSYNC();
  for (int l = 0; l < 2; ++l) {
    for (int rep = 0; rep < (PROBE_REP == 1 ? 2 : 1); ++rep) {
    if (rep) GSYNC();
    if (G == 512) {
      const int xcd = bid & 7, lb = bid >> 3, y = xcd >> 1;
      for (int k = lb; k < 448; k += 64) {
        int mt, nt;
        if ((xcd & 1) == 0) {
          if (k < 256) { mt = k >> 2; nt = 7 * y + (k & 3); } else { const int k2 = k - 256; mt = 64 + k2 / 3; nt = 7 * y + k2 % 3; }
        } else {
          if (k < 192) { mt = k / 3; nt = 7 * y + 4 + k % 3; } else { const int k2 = k - 192; mt = 64 + (k2 >> 2); nt = 7 * y + 3 + (k2 & 3); }
        }
        gemm1_item(p, l, mt * 29 + nt, lds);
      }
    } else {
      for (int i = bid; i < 128 * 28; i += G) gemm1_item(p, l, (i / 28) * 29 + (i % 28), lds);
    }
    for (int i = bid; i < 128; i += G) tail_item(p, l, i);
    }
    GSYNC();
    {
      int i = bid;
      unsigned* qctr = (unsigned*)(p.ws + OFF_BAR) + 3600 + 64 * l;
      while (i < 64 + 512 + 256 + 1024) {
        if (i < 64) {
          compress_item(p, l, i, lds);
        } else if (i < 576) {
          fox_item(p, l, i - 64, lds);
        } else if (i < 832) {
          conv_item(p, l, i - 576, lds);
        } else {
          nsa_item32(p, l, i - 832, lds);
        }
        __syncthreads();
        if (threadIdx.x == 0) *LDSP(unsigned, lds + 67536) = (unsigned)G + __hip_atomic_fetch_add(qctr, 1u, __ATOMIC_RELAXED, __HIP_MEMORY_SCOPE_AGENT);
        __syncthreads();
        i = (int)*LDSP(unsigned, lds + 67536);
      }
    }
    GSYNC();
    if (G == 512) {
      const int xcd = bid & 7, lb = bid >> 3;
      for (int k = lb; k < 128; k += 64) gemm2_item(p, l, xcd * 128 + k, lds);
    } else {
      for (int i = bid; i < 1024; i += G) gemm2_item(p, l, i, lds);
    }
    GSYNC();
    if (l == 0) for (int i = bid; i < BT / 4; i += G) norm_item(p.out, p.norm_g + 1024, (u16*)(p.ws + OFF_H), nullptr, i, nullptr, nullptr, nullptr, nullptr);
    else for (int i = bid; i < BT / 4; i += G) norm_item(p.out, p.final_g, nullptr, p.out, i, nullptr, nullptr, nullptr, nullptr);
    if (l == 0) GSYNC();
  }
  }
}

__global__ void zero_mixed(unsigned* m, size_t n) {
  size_t i = (size_t)blockIdx.x * blockDim.x + threadIdx.x;
  if (i < n) m[i] = 0;
}

extern "C" void kernel_launch(void* const* d_in, const int* in_sizes, int n_in, void* d_out,
                              int out_size, void* d_ws, size_t ws_size, hipStream_t stream) {
  static int grid_blocks = 0;
  if (!grid_blocks) {
    int dev = 0, cus = 0, per_cu = 0;
    (void)hipGetDevice(&dev);
    (void)hipDeviceGetAttribute(&cus, hipDeviceAttributeMultiprocessorCount, dev);
    (void)hipOccupancyMaxActiveBlocksPerMultiprocessor(&per_cu, fwd_megakernel, 256, 0);
    if (per_cu > 2) per_cu = 2;
    if (per_cu < 1) per_cu = 1;
    grid_blocks = cus * per_cu;
  }
  Params p{};
  p.x = (const float*)d_in[0]; p.norm_g = (const float*)d_in[1]; p.w_in = (const float*)d_in[2]; p.fox_b = (const float*)d_in[3];
  p.conv_w = (const float*)d_in[4]; p.conv_b = (const float*)d_in[5]; p.conv_ln_g = (const float*)d_in[6]; p.conv_ln_b = (const float*)d_in[7];
  p.conv_pw = (const float*)d_in[8]; p.cmp_pe_k = (const float*)d_in[9]; p.cmp_pe_v = (const float*)d_in[10];
  p.cmp_k_w1 = (const float*)d_in[11]; p.cmp_k_w2 = (const float*)d_in[12]; p.cmp_v_w1 = (const float*)d_in[13]; p.cmp_v_w2 = (const float*)d_in[14];
  p.w_out = (const float*)d_in[15]; p.final_g = (const float*)d_in[16];
  p.out = (float*)d_out; p.ws = (char*)d_ws;
#if !(EN_FOX && EN_NSA)
  {
    size_t n = (size_t)BT * 1024 / 2;
    zero_mixed<<<(unsigned)((n + 255) / 256), 256, 0, stream>>>((unsigned*)((char*)d_ws + OFF_MIXED), n);
  }
#endif
  (void)hipMemsetAsync((char*)d_ws + OFF_BAR, 0, 16384, stream);
  void* args[] = {&p};
  hipError_t e = hipLaunchCooperativeKernel((void*)fwd_megakernel, dim3(grid_blocks), dim3(256), args, 0, stream);
  if (e != hipSuccess) fprintf(stderr, "cooperative launch failed: %s (grid %d)\n", hipGetErrorString(e), grid_blocks);
}
```

```cpp
#include <hip/hip_runtime.h>
#include <hip/hip_cooperative_groups.h>
#include <cstdio>
namespace cg = cooperative_groups;

#ifndef PROBE_REP
#define PROBE_REP 0
#endif
#ifndef EN_FOX
#define EN_FOX 1
#endif
#ifndef EN_NSA
#define EN_NSA 1
#endif

typedef unsigned short u16;
using bf16x8 = __attribute__((ext_vector_type(8))) short;
using f32x16 = __attribute__((ext_vector_type(16))) float;
using u32x4 = __attribute__((ext_vector_type(4))) unsigned;
using u32x2 = __attribute__((ext_vector_type(2))) unsigned;
using f32x4 = __attribute__((ext_vector_type(4))) float;
typedef __attribute__((ext_vector_type(2))) __bf16 bf2_t;
#define DI __device__ __forceinline__
#define EXP2(x) __builtin_amdgcn_exp2f(x)
#define MFMA(a, b, c) __builtin_amdgcn_mfma_f32_32x32x16_bf16((a), (b), (c), 0, 0, 0)

constexpr int T_ = 8192;
constexpr int BT = 16384;
constexpr int NPAD = 3712;
constexpr float LOG2E = 1.4426950408889634f;
constexpr int LDS_BYTES = 67584;

constexpr size_t SZ_WINT = (size_t)NPAD * 1024 * 2;
constexpr size_t OFF_WINT = 0;
constexpr size_t OFF_WOUTT = OFF_WINT + 2 * SZ_WINT;
constexpr size_t OFF_PWT = OFF_WOUTT + 2 * (size_t)1024 * 1024 * 2;
constexpr size_t OFF_W1T = OFF_PWT + 2 * (size_t)256 * 256 * 2;
constexpr size_t OFF_W2T = OFF_W1T + 4 * (size_t)256 * 2048 * 2;
constexpr size_t OFF_CBIAS = OFF_W2T + 4 * (size_t)128 * 256 * 2;
constexpr size_t OFF_ROPE = OFF_CBIAS + 4 * 256 * 4;
constexpr size_t OFF_H = OFF_ROPE + (size_t)8192 * 8 * 2 * 4;
constexpr size_t OFF_OSC = OFF_H;
constexpr size_t OFF_FQ = OFF_H + (size_t)BT * 1024 * 2;
constexpr size_t OFF_FK = OFF_FQ + (size_t)BT * 256 * 2;
constexpr size_t OFF_FVT = OFF_FK + (size_t)BT * 256 * 2;
constexpr size_t OFF_FLOG = OFF_FVT + (size_t)BT * 256 * 2;
constexpr size_t OFF_GATE = OFF_FLOG + (size_t)BT * 4 * 4;
constexpr size_t OFF_GLU = OFF_GATE + (size_t)BT * 1024 * 2;
constexpr size_t OFF_NQ = OFF_GLU + (size_t)BT * 512 * 2;
constexpr size_t OFF_KC = OFF_NQ + (size_t)BT * 512 * 2;
constexpr size_t SZ_KV = (size_t)BT * 128 * 2;
constexpr size_t OFF_VC = OFF_KC + SZ_KV;
constexpr size_t OFF_KS = OFF_VC + SZ_KV;
constexpr size_t OFF_VST = OFF_KS + SZ_KV;
constexpr size_t OFF_KW = OFF_VST + SZ_KV;
constexpr size_t OFF_VWT = OFF_KW + SZ_KV;
constexpr size_t OFF_NGL = OFF_VWT + SZ_KV;
constexpr size_t OFF_KCMP = OFF_NGL + (size_t)BT * 24 * 4;
constexpr size_t OFF_VCMPT = OFF_KCMP + (size_t)4 * 512 * 64 * 2;
constexpr size_t OFF_HID = OFF_VCMPT + (size_t)4 * 512 * 64 * 2;
constexpr size_t OFF_CONVA = OFF_HID + (size_t)32 * 128 * 256 * 2;
constexpr size_t OFF_MIXED = OFF_CONVA + (size_t)BT * 256 * 2;
constexpr size_t OFF_KN2 = OFF_MIXED + (size_t)BT * 1024 * 2;
constexpr size_t OFF_CNT = OFF_KN2 + 256;
constexpr size_t OFF_BAR = OFF_CNT + 256;
constexpr size_t OFF_WTAIL = OFF_BAR + 16384;
constexpr size_t WS_TOTAL = OFF_WTAIL + (size_t)2 * 32 * 1024 * 4;
static_assert(WS_TOTAL <= (size_t)256 * 1024 * 1024, "ws too large");

struct Params {
  const float* x; const float* norm_g; const float* w_in; const float* fox_b; const float* conv_w; const float* conv_b;
  const float* conv_ln_g; const float* conv_ln_b; const float* conv_pw; const float* cmp_pe_k; const float* cmp_pe_v;
  const float* cmp_k_w1; const float* cmp_k_w2; const float* cmp_v_w1; const float* cmp_v_w2; const float* w_out; const float* final_g;
  float* out; char* ws;
};

DI int ltid() { int t = threadIdx.x; asm volatile("" : "+v"(t)); return t; }
DI char* lptr(char* q) { int z = 0; asm volatile("" : "+s"(z)); return q + z; }
#define LDSP(T, a) ((__attribute__((address_space(3))) T*)(a))
DI int tl_of(int ni) { const int t = ltid(); return ((t >> 6) << 4) + 8 * ni + ((t & 31) >> 2); }
DI int h_of() { return (ltid() >> 5) & 1; }
DI u16 f2bf(float x) { __bf16 b = (__bf16)x; return __builtin_bit_cast(u16, b); }
DI unsigned pk2(float x, float y) { bf2_t v; v[0] = (__bf16)x; v[1] = (__bf16)y; return __builtin_bit_cast(unsigned, v); }
DI float bf2f(u16 v) { return __uint_as_float(((unsigned)v) << 16); }
DI float bflo(unsigned v) { return __uint_as_float(v << 16); }
DI float bfhi(unsigned v) { return __uint_as_float(v & 0xffff0000u); }
DI int vperm16(int t) { return (t & ~15) | (t & 3) | ((t & 4) << 1) | ((t & 8) >> 1); }
DI int crow(int reg, int h) { return (reg & 3) + 8 * (reg >> 2) + 4 * h; }
DI float siluf(float x) { return x / (1.f + __expf(-x)); }
DI float sigmf(float x) { return 1.f / (1.f + __expf(-x)); }
DI float geluf(float x) { return 0.5f * x * (1.f + tanhf(0.7978845608028654f * (x + 0.044715f * x * x * x))); }
DI int swz(int row, int chunk) { return row * 128 + ((chunk ^ ((row >> 1) & 7)) << 4); }
DI void zero_acc(f32x16 (&a)[2][2]) {
#pragma unroll
  for (int i = 0; i < 2; ++i)
#pragma unroll
    for (int j = 0; j < 2; ++j)
#pragma unroll
      for (int k = 0; k < 16; ++k) a[i][j][k] = 0.f;
}

DI int swz32(int row, int chunk) { return row * 64 + ((chunk ^ ((row >> 2) & 3)) << 4); }
template <bool SWAP>
DI void gemm_tile(const u16* __restrict__ A, long lda, const u16* __restrict__ B, long ldb, int K, unsigned lds, f32x16 (&acc)[2][2]) {
  const int tid = ltid(), lane = tid & 63, w = tid >> 6, wr = w >> 1, wc = w & 1, r = lane & 31, h = lane >> 5;
  zero_acc(acc);
  const int lrow = tid >> 2, lch = tid & 3;
  const u16* ga = A + (long)lrow * lda + lch * 8;
  const u16* gb = B + (long)lrow * ldb + lch * 8;
  const long a64 = 64 * lda, b64 = 64 * ldb;
  const int n2 = K >> 6;
  u32x4 a0[4], a1[4], b0[4], b1[4];
#define GLOAD(S, J) { S[0] = *(const u32x4*)(ga + (J) * 32); S[1] = *(const u32x4*)(ga + a64 + (J) * 32); S[2] = *(const u32x4*)(gb + (J) * 32); S[3] = *(const u32x4*)(gb + b64 + (J) * 32); }
#define SWRITE(S, OFF) { const unsigned bb = lds + (OFF); *LDSP(u32x4, bb + swz32(lrow, lch)) = S[0]; *LDSP(u32x4, bb + swz32(lrow + 64, lch)) = S[1]; \
                         *LDSP(u32x4, bb + 8192 + swz32(lrow, lch)) = S[2]; *LDSP(u32x4, bb + 8192 + swz32(lrow + 64, lch)) = S[3]; }
#define COMPUTE(OFF) { const unsigned As = lds + (OFF); const unsigned Bs = As + 8192; \
    _Pragma("unroll") for (int ks = 0; ks < 2; ++ks) { bf16x8 af[2], bf[2]; \
      _Pragma("unroll") for (int i = 0; i < 2; ++i) { af[i] = *LDSP(bf16x8, As + swz32(64 * wr + 32 * i + r, 2 * ks + h)); bf[i] = *LDSP(bf16x8, Bs + swz32(64 * wc + 32 * i + r, 2 * ks + h)); } \
      _Pragma("unroll") for (int mi = 0; mi < 2; ++mi) _Pragma("unroll") for (int ni = 0; ni < 2; ++ni) { \
        if (SWAP) acc[mi][ni] = MFMA(bf[ni], af[mi], acc[mi][ni]); else acc[mi][ni] = MFMA(af[mi], bf[ni], acc[mi][ni]); } } }
  GLOAD(a0, 0)
  GLOAD(a1, 1)
  if (n2 > 1) { GLOAD(b0, 2) GLOAD(b1, 3) }
  __syncthreads();
  SWRITE(a0, 0)
  SWRITE(a1, 16384)
  if (n2 > 2) { GLOAD(a0, 4) GLOAD(a1, 5) }
  __syncthreads();
  int t = 0;
  while (true) {
    COMPUTE(0)
    COMPUTE(16384)
    if (t + 1 < n2) { SWRITE(b0, 32768) SWRITE(b1, 49152) }
    if (t + 3 < n2) { GLOAD(b0, 2 * (t + 3)) GLOAD(b1, 2 * (t + 3) + 1) }
    __syncthreads();
    if (++t >= n2) break;
    COMPUTE(32768)
    COMPUTE(49152)
    if (t + 1 < n2) { SWRITE(a0, 0) SWRITE(a1, 16384) }
    if (t + 3 < n2) { GLOAD(a0, 2 * (t + 3)) GLOAD(a1, 2 * (t + 3) + 1) }
    __syncthreads();
    if (++t >= n2) break;
  }
#undef GLOAD
#undef SWRITE
#undef COMPUTE
}

DI int win_srccol(int n) {
  if (n < 768) return n;
  if (n < 3072) return n + 4;
  if (n < 3584) return n + 28;
  int i = n - 3584;
  if (i < 4) return 768 + i;
  if (i < 28) return 3076 + (i - 4);
  return -1;
}

DI void transpose_tile(const float* __restrict__ src, int ld, int K, int mapkind, int nsrc, u16* __restrict__ dst, int k0, int n0, unsigned lds) {
  const int tid = ltid(), j = tid & 63, i0 = tid >> 6;
  const int n = n0 + j;
  const int sc = mapkind ? win_srccol(n) : (n < nsrc ? n : -1);
  float v[16];
#pragma unroll
  for (int it = 0; it < 16; ++it) v[it] = (sc >= 0) ? src[(size_t)(k0 + i0 + 4 * it) * ld + sc] : 0.f;
  __syncthreads();
#pragma unroll
  for (int it = 0; it < 16; ++it) *LDSP(float, lds + 4 * ((i0 + 4 * it) * 65 + j)) = v[it];
  __syncthreads();
  const int jn = tid >> 2, kc = (tid & 3) * 16;
  u32x4 o0, o1;
#pragma unroll
  for (int e = 0; e < 4; ++e) {
    o0[e] = pk2(*LDSP(float, lds + 4 * ((kc + 2 * e) * 65 + jn)), *LDSP(float, lds + 4 * ((kc + 2 * e + 1) * 65 + jn)));
    o1[e] = pk2(*LDSP(float, lds + 4 * ((kc + 8 + 2 * e) * 65 + jn)), *LDSP(float, lds + 4 * ((kc + 8 + 2 * e + 1) * 65 + jn)));
  }
  u16* dp = dst + (size_t)(n0 + jn) * K + k0 + kc;
  *(u32x4*)dp = o0;
  *(u32x4*)(dp + 8) = o1;
}

constexpr int P0_PER_LAYER = 928 + 256 + 16 + 256 + 16;
DI void phase0_item(const Params& p, int idx, unsigned lds) {
  const int l = idx / P0_PER_LAYER;
  int r = idx % P0_PER_LAYER;
  char* ws = lptr(p.ws);
  if (r < 928) {
    transpose_tile(p.w_in + (size_t)l * 1024 * 3612, 3612, 1024, 1, 0, (u16*)(ws + OFF_WINT + l * SZ_WINT), (r % 16) * 64, (r / 16) * 64, lds);
    return;
  }
  r -= 928;
  if (r < 256) {
    transpose_tile(p.w_out + (size_t)l * 1024 * 1024, 1024, 1024, 0, 1024, (u16*)(ws + OFF_WOUTT) + (size_t)l * 1024 * 1024, (r % 16) * 64, (r / 16) * 64, lds);
    return;
  }
  r -= 256;
  if (r < 16) {
    transpose_tile(p.conv_pw + (size_t)l * 256 * 256, 256, 256, 0, 256, (u16*)(ws + OFF_PWT) + (size_t)l * 256 * 256, (r % 4) * 64, (r / 4) * 64, lds);
    return;
  }
  r -= 16;
  if (r < 256) {
    const int kv = r >> 7; r &= 127;
    const float* src = (kv ? p.cmp_v_w1 : p.cmp_k_w1) + (size_t)l * 2048 * 256;
    transpose_tile(src, 256, 2048, 0, 256, (u16*)(ws + OFF_W1T) + (size_t)(l * 2 + kv) * 256 * 2048, (r % 32) * 64, (r / 32) * 64, lds);
    return;
  }
  r -= 256;
  {
    const int kv = r >> 3; r &= 7;
    const float* src = (kv ? p.cmp_v_w2 : p.cmp_k_w2) + (size_t)l * 256 * 64;
    transpose_tile(src, 64, 256, 0, 64, (u16*)(ws + OFF_W2T) + (size_t)(l * 2 + kv) * 128 * 256, (r % 4) * 64, (r / 4) * 64, lds);
  }
}

DI void cbias_item(const Params& p, int item, unsigned lds) {
  const int idx = item >> 3, ng = item & 7;
  const int l = idx >> 1, kv = idx & 1;
  const float* pe = (kv ? p.cmp_pe_v : p.cmp_pe_k) + (size_t)l * 2048;
  const float* w1 = (kv ? p.cmp_v_w1 : p.cmp_k_w1) + (size_t)l * 2048 * 256;
  const int tid = ltid(), nn = tid & 31, ksl = tid >> 5;
  const int n = ng * 32 + nn;
  float s0 = 0.f, s1 = 0.f, s2 = 0.f, s3 = 0.f;
  const float* wp = w1 + (size_t)(ksl * 256) * 256 + n;
  const float* pp = pe + ksl * 256;
#pragma unroll 4
  for (int i = 0; i < 256; i += 4) {
    s0 = fmaf(pp[i], wp[(size_t)i * 256], s0);
    s1 = fmaf(pp[i + 1], wp[(size_t)(i + 1) * 256], s1);
    s2 = fmaf(pp[i + 2], wp[(size_t)(i + 2) * 256], s2);
    s3 = fmaf(pp[i + 3], wp[(size_t)(i + 3) * 256], s3);
  }
  __syncthreads();
  *LDSP(float, lds + 4 * tid) = (s0 + s1) + (s2 + s3);
  __syncthreads();
  if (tid < 32) {
    float t = 0.f;
#pragma unroll
    for (int k = 0; k < 8; ++k) t += *LDSP(float, lds + 4 * (k * 32 + tid));
    ((float*)(p.ws + OFF_CBIAS))[idx * 256 + n] = t;
  }
}

DI void rope_item(const Params& p, int idx) {
  const int e = idx * 256 + ltid();
  const int pos = e >> 3, i = e & 7;
  const float inv = powf(500000.0f, -(float)(2 * i) / 16.0f);
  const float ang = (float)pos * inv;
  float2 cs; cs.x = cosf(ang); cs.y = sinf(ang);
  ((float2*)(p.ws + OFF_ROPE))[e] = cs;
}

DI void wtail_item(const Params& p, int item) {
  const int l = item >> 5, j = item & 31;
  float* dst = (float*)(p.ws + OFF_WTAIL) + (size_t)item * 1024;
  const int tid = ltid();
  const int col = (j < 4) ? 768 + j : 3076 + (j - 4);
#pragma unroll
  for (int i = 0; i < 4; ++i) {
    const int k = tid + 256 * i;
    dst[k] = (j < 28) ? p.w_in[((size_t)l * 1024 + k) * 3612 + col] : 0.f;
  }
}

DI void norm_item(const float* __restrict__ src, const float* __restrict__ g, u16* dstb, float* dstf, int item,
                  const float* __restrict__ wt, const float* __restrict__ foxb, float* flog, float* ngl) {
  const int tid_ = ltid(); const int lane = tid_ & 63, w = tid_ >> 6;
  const int row = item * 4 + w;
  const float4* s4 = (const float4*)(src + (size_t)row * 1024);
  float4 v[4];
  float ss = 0.f;
#pragma unroll
  for (int i = 0; i < 4; ++i) { v[i] = s4[lane + 64 * i]; ss += v[i].x * v[i].x + v[i].y * v[i].y + v[i].z * v[i].z + v[i].w * v[i].w; }
#pragma unroll
  for (int o = 32; o > 0; o >>= 1) ss += __shfl_xor(ss, o);
  const float rs = rsqrtf(ss * (1.0f / 1024.0f) + 1e-6f);
#pragma unroll
  for (int i = 0; i < 4; ++i) {
    float4 gg = ((const float4*)g)[lane + 64 * i];
    float4 o = {v[i].x * rs * gg.x, v[i].y * rs * gg.y, v[i].z * rs * gg.z, v[i].w * rs * gg.w};
    v[i] = o;
    if (dstb) {
      u32x2 pk; pk[0] = pk2(o.x, o.y); pk[1] = pk2(o.z, o.w);
      *(u32x2*)(dstb + (size_t)row * 1024 + (lane + 64 * i) * 4) = pk;
    } else {
      ((float4*)(dstf + (size_t)row * 1024))[lane + 64 * i] = o;
    }
  }
  if (wt) {
    float a[32];
#pragma unroll
    for (int j = 0; j < 32; ++j) {
      float acc = 0.f;
      if (j < 28) {
#pragma unroll
        for (int i = 0; i < 4; ++i) {
          const float4 ww = ((const float4*)(wt + (size_t)j * 1024))[lane + 64 * i];
          acc = fmaf(v[i].x, ww.x, acc); acc = fmaf(v[i].y, ww.y, acc); acc = fmaf(v[i].z, ww.z, acc); acc = fmaf(v[i].w, ww.w, acc);
        }
      }
      a[j] = acc;
    }
#pragma unroll
    for (int t = 0; t < 16; ++t) { const bool up = (lane & 32) != 0; const float send = up ? a[t] : a[t + 16]; const float keep = up ? a[t + 16] : a[t]; a[t] = keep + __shfl_xor(send, 32); }
#pragma unroll
    for (int t = 0; t < 8; ++t) { const bool up = (lane & 16) != 0; const float send = up ? a[t] : a[t + 8]; const float keep = up ? a[t + 8] : a[t]; a[t] = keep + __shfl_xor(send, 16); }
#pragma unroll
    for (int t = 0; t < 4; ++t) { const bool up = (lane & 8) != 0; const float send = up ? a[t] : a[t + 4]; const float keep = up ? a[t + 4] : a[t]; a[t] = keep + __shfl_xor(send, 8); }
#pragma unroll
    for (int t = 0; t < 2; ++t) { const bool up = (lane & 4) != 0; const float send = up ? a[t] : a[t + 2]; const float keep = up ? a[t + 2] : a[t]; a[t] = keep + __shfl_xor(send, 4); }
    { const bool up = (lane & 2) != 0; const float send = up ? a[0] : a[1]; const float keep = up ? a[1] : a[0]; a[0] = keep + __shfl_xor(send, 2); }
    a[0] += __shfl_xor(a[0], 1);
    const int col = lane >> 1;
    if ((lane & 1) == 0) {
      const float val = a[0];
      if (col < 4) {
        const float xx = val + foxb[col];
        flog[(size_t)row * 4 + col] = fminf(xx, 0.f) - __logf(1.f + __expf(-fabsf(xx)));
      } else if (col < 28) {
        ngl[(size_t)row * 24 + (col - 4)] = sigmf(val);
      }
    }
  }
}

DI void gemm1_item(const Params& p, int l, int item, unsigned lds) {
  const int mt = item / 29, nt = item % 29;
  const int m0 = mt * 128;
  char* ws = lptr(p.ws);
  const u16* A = (const u16*)(ws + OFF_H) + (size_t)m0 * 1024;
  const u16* B = (const u16*)(ws + OFF_WINT + l * SZ_WINT) + (size_t)nt * 128 * 1024;
  const bool swap = (nt == 4 || nt == 5 || nt == 21 || nt == 23);
  f32x16 acc[2][2];
  if (swap) gemm_tile<true>(A, 1024, B, 1024, 1024, lds, acc);
  else gemm_tile<false>(A, 1024, B, 1024, 1024, lds, acc);
  const int tid = ltid(), lane = tid & 63, w = tid >> 6, wr = w >> 1, wc = w & 1, r = lane & 31, h = lane >> 5;
  const int b = m0 >> 13, t0 = m0 & 8191;
  if (swap) {
    u16* base;
    if (nt == 4 || nt == 5) { const int head = (nt - 4) * 2 + wc; base = (u16*)(ws + OFF_FVT) + (size_t)(b * 4 + head) * 64 * T_; }
    else if (nt == 21) base = (u16*)(ws + OFF_VST) + (size_t)(b * 2 + wc) * 64 * T_;
    else base = (u16*)(ws + OFF_VWT) + (size_t)(b * 2 + wc) * 64 * T_;
#pragma unroll
    for (int mi = 0; mi < 2; ++mi)
#pragma unroll
      for (int ni = 0; ni < 2; ++ni)
#pragma unroll
        for (int reg = 0; reg < 16; ++reg) {
          const int d = 32 * ni + crow(reg, h);
          const int t = vperm16(t0 + 64 * wr + 32 * mi + r);
          base[(size_t)d * T_ + t] = f2bf(acc[mi][ni][reg]);
        }
    return;
  }
  if (nt < 4 || nt == 18 || nt == 19 || nt == 20 || nt == 22 || (nt >= 14 && nt <= 17)) {
    u16* base; long rstride; float scale = 1.f; bool rope = false;
    if (nt < 2) { base = (u16*)(ws + OFF_FQ) + ((size_t)(b * 4 + nt * 2 + wc) * T_ + t0) * 64; rstride = 64; scale = 0.125f; }
    else if (nt < 4) { base = (u16*)(ws + OFF_FK) + ((size_t)(b * 4 + (nt - 2) * 2 + wc) * T_ + t0) * 64; rstride = 64; }
    else if (nt >= 14 && nt <= 17) {
      const int head8 = (nt - 14) * 2 + wc, g = head8 >> 2, hh = head8 & 3;
      base = (u16*)(ws + OFF_NQ) + (((size_t)(b * 2 + g) * T_ + t0) * 4 + hh) * 64; rstride = 256; scale = 0.125f; rope = true;
    } else {
      const size_t off = (nt == 18) ? OFF_KC : (nt == 19) ? OFF_VC : (nt == 20) ? OFF_KS : OFF_KW;
      base = (u16*)(ws + off) + ((size_t)(b * 2 + wc) * T_ + t0) * 64; rstride = 64; rope = (nt == 20 || nt == 22);
    }
    const float2* rt = (const float2*)(ws + OFF_ROPE);
    if (nt == 2 || nt == 3) {
      float mxn = 0.f;
#pragma unroll
      for (int mi = 0; mi < 2; ++mi)
#pragma unroll
        for (int reg = 0; reg < 16; ++reg) {
          const float a0 = bf2f(f2bf(acc[mi][0][reg])), a1 = bf2f(f2bf(acc[mi][1][reg]));
          float ss = a0 * a0 + a1 * a1;
          ss += __shfl_xor(ss, 1); ss += __shfl_xor(ss, 2); ss += __shfl_xor(ss, 4); ss += __shfl_xor(ss, 8); ss += __shfl_xor(ss, 16);
          mxn = fmaxf(mxn, ss);
        }
      mxn = fmaxf(mxn, __shfl_xor(mxn, 32));
      if (lane == 0) atomicMax((unsigned*)(ws + OFF_KN2) + l * 8 + b * 4 + (nt - 2) * 2 + wc, __float_as_uint(mxn));
    }
#pragma unroll
    for (int mi = 0; mi < 2; ++mi)
#pragma unroll
      for (int ni = 0; ni < 2; ++ni)
#pragma unroll
        for (int reg = 0; reg < 16; ++reg) {
          const int row = 64 * wr + 32 * mi + crow(reg, h);
          float v = acc[mi][ni][reg];
          if (ni == 0 && rope) {
            const float pv = __shfl_xor(v, 8);
            if (r < 16) {
              const float2 cs = rt[(t0 + row) * 8 + (r & 7)];
              v = (r & 8) ? (pv * cs.y + v * cs.x) : (v * cs.x - pv * cs.y);
            }
          }
          base[(size_t)row * rstride + 32 * ni + r] = f2bf(v * scale);
        }
    return;
  }
  if (nt == 28) {
    float* flog = (float*)(ws + OFF_FLOG);
    float* ngl = (float*)(ws + OFF_NGL);
    if (wc == 0) {
      const int col = r;
      const float fb = (col < 4) ? p.fox_b[l * 4 + col] : 0.f;
#pragma unroll
      for (int mi = 0; mi < 2; ++mi)
#pragma unroll
        for (int reg = 0; reg < 16; ++reg) {
          const int m = m0 + 64 * wr + 32 * mi + crow(reg, h);
          const float v = acc[mi][0][reg];
          if (col < 4) {
            const float xx = v + fb;
            flog[(size_t)m * 4 + col] = fminf(xx, 0.f) - __logf(1.f + __expf(-fabsf(xx)));
          } else if (col < 28) {
            ngl[(size_t)m * 24 + (col - 4)] = sigmf(v);
          }
        }
    }
    return;
  }
  {
    u16* base; int ld; bool silu = true;
    if (nt == 6 || nt == 7) { base = (u16*)(ws + OFF_GATE) + (nt - 6) * 128; ld = 1024; }
    else if (nt >= 8 && nt <= 11) { base = (u16*)(ws + OFF_GLU) + (nt - 8) * 128; ld = 512; silu = false; }
    else if (nt == 12 || nt == 13) { base = (u16*)(ws + OFF_GATE) + 256 + (nt - 12) * 128; ld = 1024; }
    else { base = (u16*)(ws + OFF_GATE) + 512 + (nt - 24) * 128; ld = 1024; }
#pragma unroll
    for (int mi = 0; mi < 2; ++mi)
#pragma unroll
      for (int ni = 0; ni < 2; ++ni)
#pragma unroll
        for (int reg = 0; reg < 16; ++reg) {
          const int m = m0 + 64 * wr + 32 * mi + crow(reg, h);
          float v = acc[mi][ni][reg];
          if (silu) v = siluf(v);
          base[(size_t)m * ld + 64 * wc + 32 * ni + r] = f2bf(v);
        }
  }
}

DI void tail_item(const Params& p, int l, int mt) {
  char* ws = lptr(p.ws);
  const int tid = ltid(), lane = tid & 63, w = tid >> 6, r = lane & 31, h = lane >> 5;
  const int m0 = mt * 128;
  const u16* ap = (const u16*)(ws + OFF_H) + (size_t)(m0 + 32 * w + r) * 1024 + 8 * h;
  const u16* bp = (const u16*)(ws + OFF_WINT + l * SZ_WINT) + (size_t)(3584 + r) * 1024 + 8 * h;
  f32x16 acc0, acc1;
#pragma unroll
  for (int k = 0; k < 16; ++k) { acc0[k] = 0.f; acc1[k] = 0.f; }
  for (int kb = 0; kb < 8; ++kb) {
    bf16x8 af[8], bf[8];
#pragma unroll
    for (int ks = 0; ks < 8; ++ks) { af[ks] = *(const bf16x8*)(ap + (kb * 8 + ks) * 16); bf[ks] = *(const bf16x8*)(bp + (kb * 8 + ks) * 16); }
#pragma unroll
    for (int ks = 0; ks < 8; ks += 2) { acc0 = MFMA(af[ks], bf[ks], acc0); acc1 = MFMA(af[ks + 1], bf[ks + 1], acc1); }
  }
  float* flog = (float*)(ws + OFF_FLOG);
  float* ngl = (float*)(ws + OFF_NGL);
  const int col = r;
  const float fb = (col < 4) ? p.fox_b[l * 4 + col] : 0.f;
#pragma unroll
  for (int reg = 0; reg < 16; ++reg) {
    const int m = m0 + 32 * w + crow(reg, h);
    const float v = acc0[reg] + acc1[reg];
    if (col < 4) {
      const float xx = v + fb;
      flog[(size_t)m * 4 + col] = fminf(xx, 0.f) - __logf(1.f + __expf(-fabsf(xx)));
    } else if (col < 28) {
      ngl[(size_t)m * 24 + (col - 4)] = sigmf(v);
    }
  }
}

DI void gemm2_item(const Params& p, int l, int item, unsigned lds) {
  const int mt = item >> 3, nt = item & 7;
  const int m0 = mt * 128, n0 = nt * 128;
  char* ws = lptr(p.ws);
  const u16* A = (const u16*)(ws + OFF_MIXED) + (size_t)m0 * 1024;
  const u16* B = (const u16*)(ws + OFF_WOUTT) + (size_t)l * 1024 * 1024 + (size_t)n0 * 1024;
  f32x16 acc[2][2];
  gemm_tile<false>(A, 1024, B, 1024, 1024, lds, acc);
  const int tid = ltid(), lane = tid & 63, w = tid >> 6, wr = w >> 1, wc = w & 1, r = lane & 31, h = lane >> 5;
  const float* res = (l == 0) ? p.x : p.out;
#pragma unroll
  for (int mi = 0; mi < 2; ++mi)
#pragma unroll
    for (int ni = 0; ni < 2; ++ni)
#pragma unroll
      for (int reg = 0; reg < 16; ++reg) {
        const size_t idx = (size_t)(m0 + 64 * wr + 32 * mi + crow(reg, h)) * 1024 + n0 + 64 * wc + 32 * ni + r;
        p.out[idx] = res[idx] + acc[mi][ni][reg];
      }
}

DI void conv_item(const Params& p, int l, int item, unsigned lds) {
  char* ws = lptr(p.ws);
  const int m0 = item * 64, t0 = m0 & 8191;
  const int tid = ltid(), lane = tid & 63, w = tid >> 6;
  const u16* glu = (const u16*)(ws + OFF_GLU);
  const unsigned at = lds + 32768;
  {
    f32x4 wt[31];
    const float* cw = p.conv_w + (size_t)l * 31 * 256 + lane * 4;
#pragma unroll
    for (int k = 0; k < 31; ++k) wt[k] = *(const f32x4*)(cw + k * 256);
    const float4 cb = *(const float4*)(p.conv_b + l * 256 + lane * 4);
    const float4 lg = *(const float4*)(p.conv_ln_g + l * 256 + lane * 4);
    const float4 lb = *(const float4*)(p.conv_ln_b + l * 256 + lane * 4);
    for (int sub = 0; sub < 2; ++sub) {
      const int ts = t0 + 32 * sub;
      __syncthreads();
      {
        const int c8 = (tid & 31) * 8, rsub = tid >> 5;
#pragma unroll
        for (int pb = 0; pb < 8; pb += 4) {
          u32x4 av[4], bv[4];
#pragma unroll
          for (int q = 0; q < 4; ++q) {
            const int i = (pb + q) * 8 + rsub;
            int t = ts - 30 + i; if (t < 0) t = 0; if (t > T_ - 1) t = T_ - 1;
            const size_t m = (size_t)(m0 - t0 + t);
            av[q] = *(const u32x4*)(glu + m * 512 + c8);
            bv[q] = *(const u32x4*)(glu + m * 512 + 256 + c8);
          }
#pragma unroll
          for (int q = 0; q < 4; ++q) {
            const int i = (pb + q) * 8 + rsub;
            const bool ok = (ts - 30 + i) >= 0;
            u32x4 yv;
#pragma unroll
            for (int e = 0; e < 4; ++e) {
              const unsigned y = pk2(bflo(av[q][e]) * sigmf(bflo(bv[q][e])), bfhi(av[q][e]) * sigmf(bfhi(bv[q][e])));
              yv[e] = ok ? y : 0u;
            }
            if (i < 62) *LDSP(u32x4, lds + i * 512 + c8 * 2) = yv;
          }
        }
      }
      __syncthreads();
#pragma unroll 2
      for (int j = 0; j < 8; ++j) {
        const int tt = 8 * w + j;
        float4 o = cb;
#pragma unroll
        for (int k = 0; k < 31; ++k) {
          const u32x2 yy = *LDSP(u32x2, lds + (tt + k) * 512 + lane * 8);
          o.x = fmaf(wt[k][0], bflo(yy[0]), o.x);
          o.y = fmaf(wt[k][1], bfhi(yy[0]), o.y);
          o.z = fmaf(wt[k][2], bflo(yy[1]), o.z);
          o.w = fmaf(wt[k][3], bfhi(yy[1]), o.w);
        }
        float s = o.x + o.y + o.z + o.w;
#pragma unroll
        for (int of = 32; of > 0; of >>= 1) s += __shfl_xor(s, of);
        const float mu = s * (1.f / 256.f);
        const float dx = o.x - mu, dy = o.y - mu, dz = o.z - mu, dw = o.w - mu;
        float vs = dx * dx + dy * dy + dz * dz + dw * dw;
#pragma unroll
        for (int of = 32; of > 0; of >>= 1) vs += __shfl_xor(vs, of);
        const float rs = rsqrtf(vs * (1.f / 256.f) + 1e-6f);
        const float y0 = siluf(dx * rs * lg.x + lb.x), y1 = siluf(dy * rs * lg.y + lb.y);
        const float y2 = siluf(dz * rs * lg.z + lb.z), y3 = siluf(dw * rs * lg.w + lb.w);
        u32x2 pk; pk[0] = pk2(y0, y1); pk[1] = pk2(y2, y3);
        const int row = 32 * sub + tt;
        *LDSP(u32x2, at + row * 512 + (((lane >> 1) ^ (row & 15)) << 4) + 8 * (lane & 1)) = pk;
      }
    }
  }
  __syncthreads();
  const int r = lane & 31, h = lane >> 5;
  const u16* pw = (const u16*)(ws + OFF_PWT) + (size_t)l * 65536 + (size_t)(64 * w + r) * 256 + 8 * h;
  f32x16 acc[2][2];
  zero_acc(acc);
#pragma unroll
  for (int kb = 0; kb < 2; ++kb) {
    bf16x8 bfr[8][2];
#pragma unroll
    for (int ks = 0; ks < 8; ++ks)
#pragma unroll
      for (int ni = 0; ni < 2; ++ni) bfr[ks][ni] = *(const bf16x8*)(pw + (size_t)ni * 32 * 256 + (kb * 8 + ks) * 16);
#pragma unroll
    for (int ks = 0; ks < 8; ++ks) {
      const int kk = kb * 8 + ks;
      bf16x8 af[2];
#pragma unroll
      for (int mi = 0; mi < 2; ++mi) { const int row = 32 * mi + r; af[mi] = *LDSP(bf16x8, at + row * 512 + (((2 * kk + h) ^ (row & 15)) << 4)); }
#pragma unroll
      for (int mi = 0; mi < 2; ++mi)
#pragma unroll
        for (int ni = 0; ni < 2; ++ni) acc[mi][ni] = MFMA(af[mi], bfr[ks][ni], acc[mi][ni]);
    }
  }
  const u16* gate = (const u16*)(ws + OFF_GATE);
  u16* mixed = (u16*)(ws + OFF_MIXED);
#pragma unroll
  for (int mi = 0; mi < 2; ++mi)
#pragma unroll
    for (int ni = 0; ni < 2; ++ni)
#pragma unroll
      for (int reg = 0; reg < 16; ++reg) {
        const size_t idx = (size_t)(m0 + 32 * mi + crow(reg, h)) * 1024 + 256 + 64 * w + 32 * ni + r;
        mixed[idx] = f2bf(acc[mi][ni][reg] * bf2f(gate[idx]));
      }
}

DI void compress_item(const Params& p, int l, int item64, unsigned lds) {
  char* ws = lptr(p.ws);
  const int nh = item64 & 1, item = item64 >> 1;
  const int mtile = item & 3, kv = (item >> 2) & 1, bg = item >> 3;
  const u16* src = (const u16*)(ws + (kv ? OFF_VC : OFF_KC)) + ((size_t)bg * T_ + (size_t)16 * 128 * mtile) * 64;
  const u16* w1t = (const u16*)(ws + OFF_W1T) + (size_t)(l * 2 + kv) * 256 * 2048;
  const u16* w2t = (const u16*)(ws + OFF_W2T) + (size_t)(l * 2 + kv) * 128 * 256;
  const float* bias = (const float*)(ws + OFF_CBIAS) + (l * 2 + kv) * 256;
  u16* hid = (u16*)(ws + OFF_HID) + (size_t)item * 128 * 256;
  const int tid = ltid(), lane = tid & 63, w = tid >> 6, wr = w >> 1, wc = w & 1, r = lane & 31, h = lane >> 5;
  {
    f32x16 acc[2][2];
    gemm_tile<false>(src, 1024, w1t + (size_t)nh * 128 * 2048, 2048, 2048, lds, acc);
#pragma unroll
    for (int ni = 0; ni < 2; ++ni) {
      const int col = nh * 128 + 64 * wc + 32 * ni + r;
      const float bb = bias[col];
#pragma unroll
      for (int mi = 0; mi < 2; ++mi)
#pragma unroll
        for (int reg = 0; reg < 16; ++reg) {
          const int row = 64 * wr + 32 * mi + crow(reg, h);
          hid[(size_t)row * 256 + col] = f2bf(geluf(acc[mi][ni][reg] + bb));
        }
    }
  }
  __threadfence();
  __syncthreads();
  if (tid == 0) {
    const int old = atomicAdd((int*)(ws + OFF_CNT) + l * 32 + item, 1);
    *LDSP(int, lds) = old;
  }
  __syncthreads();
  const int arrived = *LDSP(int, lds);
  if (arrived == 0) return;
  __threadfence();
  f32x16 acc[2][2];
  if (kv == 0) {
    gemm_tile<false>(hid, 256, w2t, 256, 256, lds, acc);
    if (wc == 0) {
      u16* kcmp = (u16*)(ws + OFF_KCMP) + (size_t)bg * 512 * 64;
      const float2* rt = (const float2*)(ws + OFF_ROPE);
#pragma unroll
      for (int mi = 0; mi < 2; ++mi)
#pragma unroll
        for (int ni = 0; ni < 2; ++ni)
#pragma unroll
          for (int reg = 0; reg < 16; ++reg) {
            const int n = 128 * mtile + 64 * wr + 32 * mi + crow(reg, h);
            float v = acc[mi][ni][reg];
            if (ni == 0) {
              const float pv = __shfl_xor(v, 8);
              if (r < 16) {
                int pos = 16 * n + 31; if (pos > 8191) pos = 8191;
                const float2 cs = rt[pos * 8 + (r & 7)];
                v = (r & 8) ? (pv * cs.y + v * cs.x) : (v * cs.x - pv * cs.y);
              }
            }
            kcmp[(size_t)n * 64 + 32 * ni + r] = f2bf(v);
          }
    }
  } else {
    gemm_tile<true>(hid, 256, w2t, 256, 256, lds, acc);
    if (wc == 0) {
      u16* vcmpT = (u16*)(ws + OFF_VCMPT) + (size_t)bg * 64 * 512;
#pragma unroll
      for (int mi = 0; mi < 2; ++mi)
#pragma unroll
        for (int ni = 0; ni < 2; ++ni)
#pragma unroll
          for (int reg = 0; reg < 16; ++reg) {
            const int n = 128 * mtile + 64 * wr + 32 * mi + r;
            const int d = 32 * ni + crow(reg, h);
            vcmpT[(size_t)d * 512 + vperm16(n)] = (n < 511) ? f2bf(acc[mi][ni][reg]) : (u16)0;
          }
    }
  }
  asm volatile("s_waitcnt vmcnt(0)" ::: "memory");
  __syncthreads();
  if (tid == 0) {
    __builtin_amdgcn_fence(__ATOMIC_RELEASE, "agent");
    asm volatile("s_waitcnt vmcnt(0)" ::: "memory");
    __hip_atomic_fetch_add((unsigned*)(ws + OFF_BAR) + 3800 + l * 4 + bg, 1u, __ATOMIC_RELAXED, __HIP_MEMORY_SCOPE_AGENT);
  }
}

struct TileRegs { u32x4 k0, k1, v0, v1; };
DI void tile_gload(TileRegs& tr, const u16* __restrict__ kbase, long kstride, const u16* __restrict__ vbase, long vstride) {
  const int tid = ltid(), row = tid >> 2, c0 = (tid & 3) * 2;
  const u16* kp = kbase + (long)row * kstride + c0 * 8;
  const u16* vp = vbase + (long)row * vstride + c0 * 8;
  tr.k0 = *(const u32x4*)kp; tr.k1 = *(const u32x4*)(kp + 8);
  tr.v0 = *(const u32x4*)vp; tr.v1 = *(const u32x4*)(vp + 8);
}
DI void tile_swrite(const TileRegs& tr, unsigned buf) {
  const int tid = ltid(), row = tid >> 2, c0 = (tid & 3) * 2;
  *LDSP(u32x4, buf + swz(row, c0)) = tr.k0;
  *LDSP(u32x4, buf + swz(row, c0 + 1)) = tr.k1;
  *LDSP(u32x4, buf + 8192 + swz(row, c0)) = tr.v0;
  *LDSP(u32x4, buf + 8192 + swz(row, c0 + 1)) = tr.v1;
}
DI void load_qfrags(bf16x8 (&QB)[2][4], const u16* __restrict__ qrows  ) {
  const int lane = ltid() & 63, r = lane & 31, h = lane >> 5;
#pragma unroll
  for (int ni = 0; ni < 2; ++ni)
#pragma unroll
    for (int ks = 0; ks < 4; ++ks) QB[ni][ks] = *(const bf16x8*)(qrows + (size_t)(32 * ni + r) * 64 + 16 * ks + 8 * h);
}
DI float dpp_xor1(float x) { return __builtin_bit_cast(float, __builtin_amdgcn_mov_dpp(__builtin_bit_cast(int, x), 0xB1, 0xF, 0xF, true)); }
DI float dpp_xor2(float x) { return __builtin_bit_cast(float, __builtin_amdgcn_mov_dpp(__builtin_bit_cast(int, x), 0x4E, 0xF, 0xF, true)); }
DI int dpp_xor1i(int x) { return __builtin_amdgcn_mov_dpp(x, 0xB1, 0xF, 0xF, true); }
DI int dpp_xor2i(int x) { return __builtin_amdgcn_mov_dpp(x, 0x4E, 0xF, 0xF, true); }
DI int dpp_hmi(int x) { return __builtin_amdgcn_mov_dpp(x, 0x141, 0xF, 0xF, true); }
DI float xhalf_max(float x) {
  const unsigned u = __float_as_uint(x);
  const auto rr = __builtin_amdgcn_permlane32_swap(u, u, false, false);
  return fmaxf(__uint_as_float(rr[0]), __uint_as_float(rr[1]));
}
DI float xhalf_sum(float x) {
  const unsigned u = __float_as_uint(x);
  const auto rr = __builtin_amdgcn_permlane32_swap(u, u, false, false);
  return __uint_as_float(rr[0]) + __uint_as_float(rr[1]);
}
template <int MODE, bool BIAS = false>
DI void attn_step1(const bf16x8 (&QB)[2][4], const unsigned Ks, f32x16 (&ot)[2][2], float (&m)[2], float (&l)[2], const int bnd, const bool rowok, const float sc2,
                   const bool first, const float cq = 0.f, const unsigned ck = 0u) {
  const int lane = ltid() & 63, r = lane & 31, h = lane >> 5;
  f32x16 s0, s1;
#pragma unroll
  for (int k = 0; k < 16; ++k) { s0[k] = 0.f; s1[k] = 0.f; }
#pragma unroll
  for (int ks = 0; ks < 4; ++ks) {
    const bf16x8 k0 = *LDSP(bf16x8, Ks + swz(r, 2 * ks + h));
    const bf16x8 k1 = *LDSP(bf16x8, Ks + swz(32 + r, 2 * ks + h));
    s0 = MFMA(k0, QB[0][ks], s0);
    s1 = MFMA(k1, QB[0][ks], s1);
  }
  if (BIAS) {
#pragma unroll
    for (int g4 = 0; g4 < 4; ++g4) {
      const f32x4 ca = *LDSP(f32x4, ck + 4 * (8 * g4 + 4 * h));
      const f32x4 cb = *LDSP(f32x4, ck + 4 * (32 + 8 * g4 + 4 * h));
#pragma unroll
      for (int e = 0; e < 4; ++e) {
        s0[4 * g4 + e] = fmaf(s0[4 * g4 + e], LOG2E, cq - ca[e]);
        s1[4 * g4 + e] = fmaf(s1[4 * g4 + e], LOG2E, cq - cb[e]);
      }
    }
  }
  if (MODE == 1) {
#pragma unroll
    for (int reg = 0; reg < 16; ++reg) {
      const int keyc = (reg & 3) + 8 * (reg >> 2);
      s0[reg] = (keyc <= bnd) ? s0[reg] : -1e30f;
      s1[reg] = (keyc + 32 <= bnd) ? s1[reg] : -1e30f;
    }
  }
  if (MODE == 2) {
#pragma unroll
    for (int reg = 0; reg < 16; ++reg) {
      const int keyc = (reg & 3) + 8 * (reg >> 2);
      s0[reg] = (keyc >= bnd) ? s0[reg] : -1e30f;
      s1[reg] = (keyc + 32 >= bnd) ? s1[reg] : -1e30f;
    }
  }
  if (first) {
    float mx = fmaxf(s0[0], s1[0]);
#pragma unroll
    for (int reg = 1; reg < 16; ++reg) mx = fmaxf(mx, fmaxf(s0[reg], s1[reg]));
    mx = xhalf_max(mx);
    if (MODE == 3) mx = rowok ? mx : -1e30f;
    m[0] = fmaxf(-1e20f, mx);
  }
  float mb = -m[0] * sc2;
  if (MODE == 3) mb = rowok ? mb : -__builtin_inff();
  float rs0 = 0.f, rs1 = 0.f;
#pragma unroll
  for (int reg = 0; reg < 16; ++reg) {
    const float p0 = EXP2(fmaf(s0[reg], sc2, mb)); s0[reg] = p0; rs0 += p0;
    const float p1 = EXP2(fmaf(s1[reg], sc2, mb)); s1[reg] = p1; rs1 += p1;
  }
  l[0] += xhalf_sum(rs0 + rs1);
  const unsigned Vs = Ks + 8192;
#pragma unroll
  for (int kk = 0; kk < 4; ++kk) {
    const int mi = kk >> 1, s = kk & 1;
    u32x4 pk;
#pragma unroll
    for (int i = 0; i < 4; ++i) pk[i] = mi ? pk2(s1[8 * s + 2 * i], s1[8 * s + 2 * i + 1]) : pk2(s0[8 * s + 2 * i], s0[8 * s + 2 * i + 1]);
    const bf16x8 pf = __builtin_bit_cast(bf16x8, pk);
    bf16x8 vf[2];
#pragma unroll
    for (int di = 0; di < 2; ++di) {
      const int d = 32 * di + r;
      const int sw = (d >> 1) & 7;
      vf[di] = *LDSP(bf16x8, Vs + d * 128 + (((4 * mi + 2 * s + h) ^ sw) << 4));
    }
#pragma unroll
    for (int di = 0; di < 2; ++di) ot[di][0] = MFMA(vf[di], pf, ot[di][0]);
  }
}

template <class LoadF, class BodyF>
DI void tile_pipeline(const int n, const unsigned lds, LoadF&& ld, BodyF&& body) {
  TileRegs A, B;
  ld(A, 0);
  __syncthreads();
  tile_swrite(A, lds);
  if (n > 1) ld(A, 1);
  if (n > 2) ld(B, 2);
  __syncthreads();
  int j = 0;
  while (true) {
    body(j, lds);
    if (j + 1 < n) tile_swrite(A, lds + 16384);
    if (j + 3 < n) ld(A, j + 3);
    __syncthreads();
    if (++j >= n) break;
    body(j, lds + 16384);
    if (j + 1 < n) tile_swrite(B, lds);
    if (j + 3 < n) ld(B, j + 3);
    __syncthreads();
    if (++j >= n) break;
  }
}

template <int MI, int NIM>
DI void qk_half(const bf16x8 (&QB)[2][4], const unsigned Ks, f32x16 (&st)[2]) {
  const int lane = ltid() & 63, r = lane & 31, h = lane >> 5;
#pragma unroll
  for (int j = 0; j < 2; ++j)
#pragma unroll
    for (int k = 0; k < 16; ++k) st[j][k] = 0.f;
#pragma unroll
  for (int ks = 0; ks < 4; ++ks) {
    const bf16x8 kf = *LDSP(bf16x8, Ks + swz(32 * MI + r, 2 * ks + h));
#pragma unroll
    for (int ni = 0; ni < 2; ++ni)
      if (NIM & (1 << ni)) st[ni] = MFMA(kf, QB[ni][ks], st[ni]);
  }
}
template <int MI>
DI void mask_hi(f32x16 (&st)[2], const int (&hi)[2]) {
#pragma unroll
  for (int reg = 0; reg < 16; ++reg) {
    const int keyc = 32 * MI + (reg & 3) + 8 * (reg >> 2);
#pragma unroll
    for (int ni = 0; ni < 2; ++ni) st[ni][reg] = (keyc <= hi[ni]) ? st[ni][reg] : -1e30f;
  }
}
template <int MI>
DI void mask_lo(f32x16 (&st)[2], const int (&lo)[2]) {
#pragma unroll
  for (int reg = 0; reg < 16; ++reg) {
    const int keyc = 32 * MI + (reg & 3) + 8 * (reg >> 2);
#pragma unroll
    for (int ni = 0; ni < 2; ++ni) st[ni][reg] = (keyc >= lo[ni]) ? st[ni][reg] : -1e30f;
  }
}
template <int MI, int NIM, bool ROWSEL>
DI void softmax_pv(f32x16 (&st)[2], const unsigned Vs, f32x16 (&ot)[2][2], float (&m)[2], float (&l)[2], const float sc2, const bool (&rowok)[2]) {
  const int lane = ltid() & 63, r = lane & 31, h = lane >> 5;
#pragma unroll
  for (int ni = 0; ni < 2; ++ni) {
    if (!(NIM & (1 << ni))) continue;
    float mx = st[ni][0];
#pragma unroll
    for (int reg = 1; reg < 16; ++reg) mx = fmaxf(mx, st[ni][reg]);
    mx = fmaxf(mx, __shfl_xor(mx, 32));
    if (ROWSEL) mx = rowok[ni] ? mx : -1e30f;
    const float mold = m[ni];
    const float mnew = fmaxf(mold, mx);
    const float alpha = EXP2((mold - mnew) * sc2);
    m[ni] = mnew;
    float mb = -mnew * sc2;
    if (ROWSEL) mb = rowok[ni] ? mb : -__builtin_inff();
    float rs = 0.f;
#pragma unroll
    for (int reg = 0; reg < 16; ++reg) { const float pp = EXP2(fmaf(st[ni][reg], sc2, mb)); st[ni][reg] = pp; rs += pp; }
    rs += __shfl_xor(rs, 32);
    l[ni] = l[ni] * alpha + rs;
    if (__builtin_amdgcn_ballot_w64(mnew > mold) != 0ull) {
#pragma unroll
      for (int di = 0; di < 2; ++di)
#pragma unroll
        for (int reg = 0; reg < 16; ++reg) ot[di][ni][reg] *= alpha;
    }
  }
#pragma unroll
  for (int s = 0; s < 2; ++s) {
    bf16x8 pf[2], vf[2];
#pragma unroll
    for (int ni = 0; ni < 2; ++ni) {
      if (!(NIM & (1 << ni))) continue;
      u32x4 pk;
#pragma unroll
      for (int i = 0; i < 4; ++i) pk[i] = pk2(st[ni][8 * s + 2 * i], st[ni][8 * s + 2 * i + 1]);
      pf[ni] = __builtin_bit_cast(bf16x8, pk);
    }
#pragma unroll
    for (int di = 0; di < 2; ++di) {
      const int d = 32 * di + r;
      const int sw = (d >> 1) & 7;
      const u32x2 lo = *LDSP(u32x2, Vs + d * 128 + (((4 * MI + 2 * s) ^ sw) << 4) + 8 * h);
      const u32x2 hi = *LDSP(u32x2, Vs + d * 128 + (((4 * MI + 2 * s + 1) ^ sw) << 4) + 8 * h);
      u32x4 vv; vv[0] = lo[0]; vv[1] = lo[1]; vv[2] = hi[0]; vv[3] = hi[1];
      vf[di] = __builtin_bit_cast(bf16x8, vv);
    }
#pragma unroll
    for (int di = 0; di < 2; ++di)
#pragma unroll
      for (int ni = 0; ni < 2; ++ni)
        if (NIM & (1 << ni)) ot[di][ni] = MFMA(vf[di], pf[ni], ot[di][ni]);
  }
}
template <int NIM, int MODE>
DI void attn_step(const bf16x8 (&QB)[2][4], const unsigned Ks, f32x16 (&ot)[2][2], float (&m)[2], float (&l)[2], const int (&bnd)[2], const bool (&rowok)[2]) {
  {
    f32x16 st[2];
    qk_half<0, NIM>(QB, Ks, st);
    if (MODE == 1) mask_hi<0>(st, bnd);
    if (MODE == 2) mask_lo<0>(st, bnd);
    softmax_pv<0, NIM, MODE == 3>(st, Ks + 8192, ot, m, l, LOG2E, rowok);
  }
  {
    f32x16 st[2];
    qk_half<1, NIM>(QB, Ks, st);
    if (MODE == 1) mask_hi<1>(st, bnd);
    if (MODE == 2) mask_lo<1>(st, bnd);
    softmax_pv<1, NIM, MODE == 3>(st, Ks + 8192, ot, m, l, LOG2E, rowok);
  }
}

DI void fox_item(const Params& p, int l, int item, unsigned lds) {
  char* ws = lptr(p.ws);
  const int bh = item & 7, qt = 63 - (item >> 3);
  const int b = bh >> 2, hd = bh & 3;
  const int q0 = qt * 128;
  const int tid = ltid(), lane = tid & 63, w = tid >> 6, r = lane & 31, h = lane >> 5;
  const u16* kb = (const u16*)(ws + OFF_FK) + (size_t)bh * T_ * 64;
  const u16* vb = (const u16*)(ws + OFF_FVT) + (size_t)bh * 64 * T_;
  const float* flog = (const float*)(ws + OFF_FLOG) + (size_t)b * T_ * 4 + hd;
  const unsigned rq = lds + 32768, ckb = lds + 32768 + 1024, wsum = lds + 32768 + 1024 + 512;
  __syncthreads();
  bf16x8 QB[2][4];
  {
    const u16* qrows = (const u16*)(ws + OFF_FQ) + ((size_t)bh * T_ + q0 + 32 * w) * 64;
#pragma unroll
    for (int ks = 0; ks < 4; ++ks) { QB[0][ks] = *(const bf16x8*)(qrows + (size_t)r * 64 + 16 * ks + 8 * h); QB[1][ks] = QB[0][ks]; }
  }
  {
    float v = (tid < 128) ? flog[(size_t)(q0 + tid) * 4] * LOG2E : 0.f;
#pragma unroll
    for (int o = 1; o < 64; o <<= 1) { const float u = __shfl_up(v, o); if (lane >= o) v += u; }
    if (tid == 63) *LDSP(float, wsum) = v;
    __syncthreads();
    if (w == 1) v += *LDSP(float, wsum);
    if (tid < 128) *LDSP(float, rq + 4 * tid) = v;
  }
  const int nkt = 2 * qt + 2;
  float qkb;
  {
    const float kn = sqrtf(((const float*)(ws + OFF_KN2))[l * 8 + bh]) * 1.02f + 1e-3f;
    float ss = 0.f;
#pragma unroll
    for (int ks = 0; ks < 4; ++ks)
#pragma unroll
      for (int e = 0; e < 8; ++e) { const float qv = bf2f((u16)QB[0][ks][e]); ss = fmaf(qv, qv, ss); }
    ss = xhalf_sum(ss);
    qkb = sqrtf(ss) * kn * LOG2E;
  }
  TileRegs tr;
  float carry = 0.f;
  float cknext = 0.f;
  tile_gload(tr, kb + (size_t)(nkt - 1) * 64 * 64, 64, vb + (size_t)(nkt - 1) * 64, T_);
  __syncthreads();
  tile_swrite(tr, lds);
  if (w == 0) *LDSP(float, ckb + 4 * lane) = *LDSP(float, rq + 4 * (64 + lane));
  __syncthreads();
  f32x16 ot[2][2]; zero_acc(ot);
  float m[2] = {-1e20f, -1e20f}, ls[2] = {0.f, 0.f};
  const float cq = *LDSP(float, rq + 4 * (32 * w + r));
  int cur = 0;
  for (int kt = nkt - 1; kt >= 0; --kt) {
    const bool more = kt > 0;
    if (more) {
      tile_gload(tr, kb + (size_t)(kt - 1) * 64 * 64, 64, vb + (size_t)(kt - 1) * 64, T_);
      if (w == 0) {
        const int ktn = kt - 1 - 2 * qt;
        if (ktn >= 0) cknext = *LDSP(float, rq + 4 * (64 * ktn + lane));
        else {
          const float v = -flog[(size_t)((kt - 1) * 64 + lane) * 4] * LOG2E;
          float inc = v;
#pragma unroll
          for (int o = 1; o < 64; o <<= 1) { const float u = __shfl_down(inc, o); if (lane + o < 64) inc += u; }
          cknext = carry + inc - v;
          carry += __shfl(inc, 0);
        }
      }
    }
    const int ktp = kt - 2 * qt;
    if (ktp <= 0 || w >= 2) {
      const unsigned Ks = lds + cur * 16384;
      const unsigned ck = ckb + cur * 256;
      const bool masked = (ktp == 1) || (ktp == 0 && w < 2);
      if (masked) attn_step1<1, true>(QB, Ks, ot, m, ls, 32 * w + r - 64 * ktp - 4 * h, true, 1.0f, true, cq, ck);
      else attn_step1<0, true>(QB, Ks, ot, m, ls, 0, true, 1.0f, false, cq, ck);
    }
    if (more) {
      tile_swrite(tr, lds + (cur ^ 1) * 16384);
      if (w == 0) *LDSP(float, ckb + 4 * ((cur ^ 1) * 64 + lane)) = cknext;
    }
    if (kt <= 2 * qt && kt > 0 && (kt & 1) == 0) {
      const float cmin = __shfl(cknext, 63);
      if (w == 0 && lane == 0) *LDSP(float, wsum + 16) = cmin;
      __syncthreads();
      const float cm = *LDSP(float, wsum + 16);
      const bool done = (qkb + cq - cm - m[0] < -40.f);
      if (__syncthreads_and(done ? 1 : 0)) break;
    } else {
      __syncthreads();
    }
    cur ^= 1;
  }
  const u16* gate = (const u16*)(ws + OFF_GATE);
  u16* mixed = (u16*)(ws + OFF_MIXED);
  {
    const float il = 1.f / ls[0];
    const size_t mrow = (size_t)(b * T_ + q0 + 32 * w + r) * 1024 + hd * 64;
#pragma unroll
    for (int di = 0; di < 2; ++di)
#pragma unroll
      for (int g4 = 0; g4 < 4; ++g4) {
        const int d = 32 * di + 8 * g4 + 4 * h;
        const u32x2 gv = *(const u32x2*)(gate + mrow + d);
        u32x2 o;
        o[0] = pk2(ot[di][0][4 * g4] * il * bflo(gv[0]), ot[di][0][4 * g4 + 1] * il * bfhi(gv[0]));
        o[1] = pk2(ot[di][0][4 * g4 + 2] * il * bflo(gv[1]), ot[di][0][4 * g4 + 3] * il * bfhi(gv[1]));
        *(u32x2*)(mixed + mrow + d) = o;
      }
  }
}

DI int tl32() { const int t = ltid(); return ((t >> 6) << 3) + ((t & 31) >> 2); }
DI void nsa_flush32(const Params& p, int mode, f32x16 (&ot)[2][2], const float ls0, int b, int g, int tbase, int br) {
  char* ws = lptr(p.ws);
  const int tid_ = ltid(); const int lane = tid_ & 63, r = lane & 31, h = lane >> 5;
  float* osc = (float*)(ws + OFF_OSC);
  const float* ngl = (const float*)(ws + OFF_NGL);
  const u16* gate = (const u16*)(ws + OFF_GATE);
  u16* mixed = (u16*)(ws + OFF_MIXED);
  const int t = tbase + tl32(), hh = r & 3;
  const size_t m = (size_t)b * T_ + t;
  const float gsig = ngl[m * 24 + (g * 4 + hh) * 3 + br];
  const float sc = (ls0 > 0.f) ? gsig / ls0 : 0.f;
  const size_t cb = m * 512 + (g * 4 + hh) * 64;
#pragma unroll
  for (int di = 0; di < 2; ++di)
#pragma unroll
    for (int g4 = 0; g4 < 4; ++g4) {
      const int d = 32 * di + 8 * g4 + 4 * h;
      float4 v = {ot[di][0][4 * g4] * sc, ot[di][0][4 * g4 + 1] * sc, ot[di][0][4 * g4 + 2] * sc, ot[di][0][4 * g4 + 3] * sc};
      if (mode > 0) { const float4 o = *(const float4*)(osc + cb + d); v.x += o.x; v.y += o.y; v.z += o.z; v.w += o.w; }
      if (mode < 2) *(float4*)(osc + cb + d) = v;
      else {
        const size_t mi2 = m * 1024 + 512 + (g * 4 + hh) * 64 + d;
        const u32x2 gv = *(const u32x2*)(gate + mi2);
        u32x2 o; o[0] = pk2(v.x * bflo(gv[0]), v.y * bfhi(gv[0])); o[1] = pk2(v.z * bflo(gv[1]), v.w * bfhi(gv[1]));
        *(u32x2*)(mixed + mi2) = o;
      }
    }
}

DI void nsa_accum32(const Params& p, f32x16 (&osum)[2], const f32x16 (&ot)[2][2], const float ls0, int b, int g, int tbase, int br, bool first) {
  char* ws = lptr(p.ws);
  const int r = ltid() & 31;
  const float* ngl = (const float*)(ws + OFF_NGL);
  const size_t m = (size_t)b * T_ + tbase + tl32();
  const float gsig = ngl[m * 24 + (g * 4 + (r & 3)) * 3 + br];
  const float sc = (ls0 > 0.f) ? gsig / ls0 : 0.f;
#pragma unroll
  for (int di = 0; di < 2; ++di)
#pragma unroll
    for (int k = 0; k < 16; ++k) osum[di][k] = first ? ot[di][0][k] * sc : fmaf(ot[di][0][k], sc, osum[di][k]);
}
DI void nsa_store32(const Params& p, const f32x16 (&osum)[2], int b, int g, int tbase) {
  char* ws = lptr(p.ws);
  const int lane = ltid() & 63, r = lane & 31, h = lane >> 5;
  const u16* gate = (const u16*)(ws + OFF_GATE);
  u16* mixed = (u16*)(ws + OFF_MIXED);
  const size_t m = (size_t)b * T_ + tbase + tl32();
  const size_t base = m * 1024 + 512 + (g * 4 + (r & 3)) * 64;
#pragma unroll
  for (int di = 0; di < 2; ++di)
#pragma unroll
    for (int g4 = 0; g4 < 4; ++g4) {
      const int d = 32 * di + 8 * g4 + 4 * h;
      const u32x2 gv = *(const u32x2*)(gate + base + d);
      u32x2 o;
      o[0] = pk2(osum[di][4 * g4] * bflo(gv[0]), osum[di][4 * g4 + 1] * bfhi(gv[0]));
      o[1] = pk2(osum[di][4 * g4 + 2] * bflo(gv[1]), osum[di][4 * g4 + 3] * bfhi(gv[1]));
      *(u32x2*)(mixed + base + d) = o;
    }
}

DI void nsa_item32(const Params& p, int l, int item, unsigned lds) {
  char* ws = lptr(p.ws);
  const int bg = item & 3, c32 = 255 - (item >> 2);
  const int b = bg >> 1, g = bg & 1;
  const int tbase = 32 * c32, c = c32 >> 1, toff = tbase & 63;
  const int tid = ltid(), lane = tid & 63, w = tid >> 6, r = lane & 31, h = lane >> 5;
  if (tid == 0 && *LDSP(unsigned, lds + 67540 + 4 * (l * 4 + bg)) == 0u) {
    unsigned* dn = (unsigned*)(ws + OFF_BAR) + 3800 + l * 4 + bg;
    while (__hip_atomic_load(dn, __ATOMIC_RELAXED, __HIP_MEMORY_SCOPE_AGENT) < 8u) __builtin_amdgcn_s_sleep(4);
    __builtin_amdgcn_fence(__ATOMIC_ACQUIRE, "agent");
    asm volatile("s_waitcnt vmcnt(0)" ::: "memory");
    *LDSP(unsigned, lds + 67540 + 4 * (l * 4 + bg)) = 1u;
  }
  const unsigned imp = lds + 32768;
  const unsigned selw = lds + 32768 + 16384;
  __syncthreads();
  bf16x8 QB[2][4];
  {
    const u16* qrows = (const u16*)(ws + OFF_NQ) + (((size_t)bg * T_ + tbase) * 4 + 32 * w) * 64;
#pragma unroll
    for (int ks = 0; ks < 4; ++ks) { QB[0][ks] = *(const bf16x8*)(qrows + (size_t)r * 64 + 16 * ks + 8 * h); QB[1][ks] = QB[0][ks]; }
  }
  for (int i = tid; i < 32 * 128; i += 256) *LDSP(float, imp + 4 * i) = 0.f;
  f32x16 ot[2][2];
  f32x16 osum[2];
  float m[2], ls[2];
  const bool rk[2] = {true, true};
  const u16* kcb = (const u16*)(ws + OFF_KCMP) + (size_t)bg * 512 * 64;
  const u16* vcb = (const u16*)(ws + OFF_VCMPT) + (size_t)bg * 64 * 512;
  const int nbc = (2 * c32) / 64 + 1;
  {
    zero_acc(ot); m[0] = m[1] = -1e20f; ls[0] = ls[1] = 0.f;
    tile_pipeline(nbc, lds,
      [&](TileRegs& t, int nb) __attribute__((always_inline)) { tile_gload(t, kcb + (size_t)nb * 64 * 64, 64, vcb + (size_t)nb * 64, 512); },
      [&](int nb, unsigned Ks) __attribute__((always_inline)) {
        const int hb = ((tbase + tl32() - 31) >> 4) - 64 * nb - 4 * h_of();
        if (64 * nb + 63 <= ((tbase - 31) >> 4)) attn_step1<0>(QB, Ks, ot, m, ls, hb, true, LOG2E, nb == 0);
        else attn_step1<1>(QB, Ks, ot, m, ls, hb, true, LOG2E, nb == 0);
      });
    nsa_accum32(p, osum, ot, ls[0], b, g, tbase, 0, true);
  }
  if (c >= 16) {
    const float il0 = (ls[0] > 0.f) ? 1.f / ls[0] : 0.f;
#define IMP_HALF(MI)                                                                               \
      {                                                                                            \
        f32x16 st[2];                                                                              \
        qk_half<MI, 1>(QB, Ks, st);                                                                \
        const int tlv = tl32(); const int hbv = ((tbase + tlv - 31) >> 4) - 64 * nb - 4 * h_of();  \
        _Pragma("unroll") for (int g4 = 0; g4 < 4; ++g4) {                                         \
          float pg[4];                                                                             \
          _Pragma("unroll") for (int e = 0; e < 4; ++e) {                                          \
            const int keyc = 32 * MI + 8 * g4 + e;                                                 \
            float pp = (keyc <= hbv) ? EXP2((st[0][4 * g4 + e] - m[0]) * LOG2E) * il0 : 0.f;       \
            pp += dpp_xor1(pp);                                                                    \
            pp += dpp_xor2(pp);                                                                    \
            pg[e] = pp;                                                                            \
          }                                                                                        \
          if ((r & 3) == g4) {                                                                     \
            const int j = 16 * nb + 8 * MI + 2 * g4 + h;                                           \
            const float G = (pg[0] + pg[1]) + (pg[2] + pg[3]);                                     \
            __hip_atomic_fetch_add(LDSP(float, imp + 4 * (tlv * 128 + j)), G, __ATOMIC_RELAXED, __HIP_MEMORY_SCOPE_WORKGROUP); \
            if (j + 1 < 128) __hip_atomic_fetch_add(LDSP(float, imp + 4 * (tlv * 128 + j + 1)), pg[3], __ATOMIC_RELAXED, __HIP_MEMORY_SCOPE_WORKGROUP); \
          }                                                                                        \
        }                                                                                          \
      }
    tile_pipeline(nbc, lds,
      [&](TileRegs& t, int nb) __attribute__((always_inline)) { tile_gload(t, kcb + (size_t)nb * 64 * 64, 64, vcb + (size_t)nb * 64, 512); },
      [&](int nb, unsigned Ks) __attribute__((always_inline)) {
        IMP_HALF(0)
        IMP_HALF(1)
      });
#undef IMP_HALF
  }
  {
    const int tok = tid >> 3, sub = tid & 7;
    unsigned word;
    if (c < 16) {
      word = 0xffffu;
    } else {
      unsigned key[16];
      word = 0;
#pragma unroll
      for (int i = 0; i < 16; ++i) {
        const int j = 16 * sub + i;
        const float v = *LDSP(float, imp + 4 * (tok * 128 + j));
        const bool cand = (j >= 1) && (j <= c - 2);
        key[i] = cand ? (__float_as_uint(v) + 1u) : 0u;
        if (j == 0 || j == c || j == c - 1) word |= (1u << i);
      }
      unsigned thr = 0;
      for (int bit = 30; bit >= 0; --bit) {
        const unsigned cd = thr | (1u << bit);
        int cnt = 0;
#pragma unroll
        for (int i = 0; i < 16; ++i) cnt += (key[i] >= cd) ? 1 : 0;
        cnt += dpp_xor1i(cnt);
        cnt += dpp_xor2i(cnt);
        cnt += dpp_hmi(cnt);
        if (cnt >= 13) thr = cd;
      }
      int gt = 0, eq = 0;
#pragma unroll
      for (int i = 0; i < 16; ++i) { gt += (key[i] > thr) ? 1 : 0; eq += (key[i] == thr) ? 1 : 0; }
      int gtt = gt; gtt += dpp_xor1i(gtt); gtt += dpp_xor2i(gtt); gtt += dpp_hmi(gtt);
      int eqb = 0;
#pragma unroll
      for (int k = 0; k < 7; ++k) { const int ek = __shfl(eq, (lane & ~7) + k); if (sub > k) eqb += ek; }
      int need = 13 - gtt - eqb;
#pragma unroll
      for (int i = 0; i < 16; ++i) {
        if (key[i] > thr) word |= (1u << i);
        else if (key[i] == thr && thr != 0u) { if (need > 0) word |= (1u << i); --need; }
      }
    }
    *LDSP(u16, selw + 16 * tok + 2 * sub) = (u16)word;
  }
  __syncthreads();
  {
    const u16* kb = (const u16*)(ws + OFF_KS) + (size_t)bg * T_ * 64;
    const u16* vb = (const u16*)(ws + OFF_VST) + (size_t)bg * 64 * T_;
    zero_acc(ot); m[0] = m[1] = -1e20f; ls[0] = ls[1] = 0.f;
    tile_pipeline(c + 1, lds,
      [&](TileRegs& t, int j) __attribute__((always_inline)) { tile_gload(t, kb + (size_t)j * 64 * 64, 64, vb + (size_t)j * 64, T_); },
      [&](int j, unsigned Ks) __attribute__((always_inline)) {
        const bool selb = ((*LDSP(unsigned, selw + 16 * tl32() + 4 * (j >> 5)) >> (j & 31)) & 1u) != 0u;
        if (j == c) {
          attn_step1<1>(QB, Ks, ot, m, ls, toff + tl32() - 4 * h_of(), true, LOG2E, j == 0);
        } else {
          if (__builtin_amdgcn_ballot_w64(selb) != 0ull) attn_step1<3>(QB, Ks, ot, m, ls, 0, selb, LOG2E, j == 0);
        }
        if (PROBE_REP == 7) attn_step1<3>(QB, Ks, ot, m, ls, 0, false, LOG2E, false);
      });
    nsa_accum32(p, osum, ot, ls[0], b, g, tbase, 1, false);
  }
  {
    const u16* kb = (const u16*)(ws + OFF_KW) + (size_t)bg * T_ * 64;
    const u16* vb = (const u16*)(ws + OFF_VWT) + (size_t)bg * 64 * T_;
    zero_acc(ot); m[0] = m[1] = -1e20f; ls[0] = ls[1] = 0.f;
    const int jlo = (c >= 8) ? c - 8 : 0;
    tile_pipeline(c - jlo + 1, lds,
      [&](TileRegs& t, int i) __attribute__((always_inline)) { const int j = c - i; tile_gload(t, kb + (size_t)j * 64 * 64, 64, vb + (size_t)j * 64, T_); },
      [&](int i, unsigned Ks) __attribute__((always_inline)) {
        const int j = c - i;
        const bool diag = (j == c), far = (j == c - 8);
        if (diag) attn_step1<1>(QB, Ks, ot, m, ls, toff + tl32() - 4 * h_of(), true, LOG2E, true);
        else if (far) attn_step1<2>(QB, Ks, ot, m, ls, toff + tl32() + 1 - 4 * h_of(), true, LOG2E, false);
        else attn_step1<0>(QB, Ks, ot, m, ls, 0, true, LOG2E, false);
      });
    nsa_accum32(p, osum, ot, ls[0], b, g, tbase, 2, false);
    nsa_store32(p, osum, b, g, tbase);
  }
}

#define XB_TMO      128
#define XB_XCNT(j)  (256  + 64 * (j))
#define XB_XSUB(j)  (1280 + 64 * (j))
#define XB_XGEN(j)  (2304 + 64 * (j))
#define XB_TOP      3328
#define XB_TOPGEN   3392
#define XCD_BAR_WORDS 3456
#define XB_SPIN_CAP (1u << 18)
#define LAS __attribute__((address_space(3)))

__device__ __forceinline__ unsigned xb_ld(unsigned* p)              { return __hip_atomic_load(p, __ATOMIC_RELAXED, __HIP_MEMORY_SCOPE_AGENT); }
__device__ __forceinline__ unsigned xb_add(unsigned* p, unsigned v) { return __hip_atomic_fetch_add(p, v, __ATOMIC_RELAXED, __HIP_MEMORY_SCOPE_AGENT); }
__device__ __forceinline__ unsigned xb_xcc_id() { return (unsigned)__builtin_amdgcn_s_getreg((3 << 11) | 20) & 0xFu; }
#define XB_SPIN(cond, bar) do { unsigned _sp = 0; while (cond) { __builtin_amdgcn_s_sleep(1); \
    if ((++_sp & 255u) == 0u) { if (xb_ld(&(bar)[XB_TMO])) break; if (_sp > XB_SPIN_CAP) { atomicAdd(&(bar)[XB_TMO], 1u); break; } } } } while (0)

struct XcdBarrier {
    unsigned* bar; unsigned x;
    volatile LAS unsigned* st;
};

__device__ __forceinline__ XcdBarrier xcd_barrier_post(unsigned* bar, volatile LAS unsigned* st) {
    XcdBarrier b; b.bar = bar; b.x = xb_xcc_id(); b.st = st;
    if (threadIdx.x == 0) (void)xb_add(&bar[XB_XCNT(b.x)], 1u);
    return b;
}
__device__ __forceinline__ void xcd_barrier_complete(unsigned* bar, unsigned x, unsigned& nloc, unsigned& nx) {
    const unsigned G = gridDim.x * gridDim.y * gridDim.z;
    unsigned sum, cnt, mine, sp = 0u;
    for (;;) {
        sum = 0u; cnt = 0u; mine = 0u;
#pragma unroll
        for (unsigned j = 0; j < 16; ++j) { const unsigned c = xb_ld(&bar[XB_XCNT(j)]); sum += c; cnt += (c > 0u) ? 1u : 0u; mine = (j == x) ? c : mine; }
        if (sum == G) break;
        __builtin_amdgcn_s_sleep(1);
        if ((++sp & 255u) == 0u) { if (xb_ld(&bar[XB_TMO])) break; if (sp > XB_SPIN_CAP) { atomicAdd(&bar[XB_TMO], 1u); break; } }
    }
    nloc = mine > 0u ? mine : 1u; nx = cnt > 0u ? cnt : 1u;
}

__device__ __forceinline__ void xcd_barrier(const XcdBarrier& b) {
    asm volatile("s_waitcnt vmcnt(0)" ::: "memory");
    __syncthreads();
    if (threadIdx.x == 0) {
        unsigned* bar = b.bar;
        __builtin_amdgcn_s_waitcnt(0);
        unsigned nloc = b.st[0], nx = b.st[1];
        if (nloc == 0u) { xcd_barrier_complete(bar, b.x, nloc, nx); b.st[0] = nloc; b.st[1] = nx; }
        const unsigned old = xb_add(&bar[XB_XSUB(b.x)], 1u);
        const unsigned gen = old / nloc;
        if (old + 1u == (gen + 1u) * nloc) {
            __builtin_amdgcn_fence(__ATOMIC_RELEASE, "agent");
            asm volatile("s_waitcnt vmcnt(0)" ::: "memory");
            const unsigned og = xb_add(&bar[XB_TOP], 1u);
            const unsigned tg = og / nx;
            if (og + 1u == (tg + 1u) * nx) xb_add(&bar[XB_TOPGEN], 1u);
            else XB_SPIN(xb_ld(&bar[XB_TOPGEN]) == tg, bar);
            __builtin_amdgcn_fence(__ATOMIC_ACQUIRE, "agent");
            xb_add(&bar[XB_XGEN(b.x)], 1u);
            asm volatile("s_waitcnt vmcnt(0)" ::: "memory");
        } else {
            XB_SPIN(xb_ld(&bar[XB_XGEN(b.x)]) == gen, bar);
            __builtin_amdgcn_fence(__ATOMIC_ACQUIRE, "agent");
            asm volatile("s_waitcnt vmcnt(0)" ::: "memory");
        }
    }
    __syncthreads();
}


__global__ void __launch_bounds__(256, 2) fwd_megakernel(Params p) {
  cg::grid_group grid = cg::this_grid();
  __shared__ __attribute__((aligned(16))) char lds_arr[LDS_BYTES];
  const unsigned lds = (unsigned)(size_t)lds_arr;
  if (threadIdx.x < 16) *LDSP(unsigned, lds + 67520 + 4 * threadIdx.x) = 0u;
  __syncthreads();
  const XcdBarrier xb = xcd_barrier_post((unsigned*)(p.ws + OFF_BAR), (volatile LAS unsigned*)(lds + 67520));
#define GSYNC() xcd_barrier(xb)
  if (gridDim.x == 0x7fffffffu) grid.sync();
  const int G = gridDim.x, bid = blockIdx.x;
  for (int whole = 0; whole < (PROBE_REP == 6 ? 2 : 1); ++whole) {
  if (whole) GSYNC();
  for (int rep0 = 0; rep0 < (PROBE_REP == 4 ? 2 : 1); ++rep0) {
  for (int i = bid; i < 2 * P0_PER_LAYER; i += G) phase0_item(p, i, lds);
  for (int i = G - 1 - bid; i < 32; i += G) cbias_item(p, i, lds);
  if (bid == 0 && threadIdx.x < 128) ((unsigned*)(p.ws + OFF_KN2))[threadIdx.x] = 0u;
  for (int i = bid; i < 256; i += G) rope_item(p, i);
  for (int i = bid; i < BT / 4; i += G) norm_item(p.x, p.norm_g, (u16*)(p.ws + OFF_H), nullptr, i, nullptr, nullptr, nullptr, nullptr);
  }
  GSYNC();
  for (int l = 0; l < 2; ++l) {
    for (int rep = 0; rep < (PROBE_REP == 1 ? 2 : 1); ++rep) {
    if (rep) GSYNC();
    if (G == 512) {
      const int xcd = bid & 7, lb = bid >> 3, y = xcd >> 1;
      for (int k = lb; k < 448; k += 64) {
        int mt, nt;
        if ((xcd & 1) == 0) {
          if (k < 256) { mt = k >> 2; nt = 7 * y + (k & 3); } else { const int k2 = k - 256; mt = 64 + k2 / 3; nt = 7 * y + k2 % 3; }
        } else {
          if (k < 192) { mt = k / 3; nt = 7 * y + 4 + k % 3; } else { const int k2 = k - 192; mt = 64 + (k2 >> 2); nt = 7 * y + 3 + (k2 & 3); }
        }
        gemm1_item(p, l, mt * 29 + nt, lds);
      }
    } else {
      for (int i = bid; i < 128 * 28; i += G) gemm1_item(p, l, (i / 28) * 29 + (i % 28), lds);
    }
    for (int i = bid; i < 128; i += G) tail_item(p, l, i);
    }
    GSYNC();
    {
      int i = bid;
      unsigned* qctr = (unsigned*)(p.ws + OFF_BAR) + 3600 + 64 * l;
      while (i < 64 + 512 + 256 + 1024) {
        if (i < 64) {
          compress_item(p, l, i, lds);
        } else if (i < 576) {
          fox_item(p, l, i - 64, lds);
        } else if (i < 832) {
          conv_item(p, l, i - 576, lds);
        } else {
          nsa_item32(p, l, i - 832, lds);
        }
        __syncthreads();
        if (threadIdx.x == 0) *LDSP(unsigned, lds + 67536) = (unsigned)G + __hip_atomic_fetch_add(qctr, 1u, __ATOMIC_RELAXED, __HIP_MEMORY_SCOPE_AGENT);
        __syncthreads();
        i = (int)*LDSP(unsigned, lds + 67536);
      }
    }
    GSYNC();
    if (G == 512) {
      const int xcd = bid & 7, lb = bid >> 3;
      for (int k = lb; k < 128; k += 64) gemm2_item(p, l, xcd * 128 + k, lds);
    } else {
      for (int i = bid; i < 1024; i += G) gemm2_item(p, l, i, lds);
    }
    GSYNC();
    if (l == 0) for (int i = bid; i < BT / 4; i += G) norm_item(p.out, p.norm_g + 1024, (u16*)(p.ws + OFF_H), nullptr, i, nullptr, nullptr, nullptr, nullptr);
    else for (int i = bid; i < BT / 4; i += G) norm_item(p.out, p.final_g, nullptr, p.out, i, nullptr, nullptr, nullptr, nullptr);
    if (l == 0) GSYNC();
  }
  }
}

__global__ void zero_mixed(unsigned* m, size_t n) {
  size_t i = (size_t)blockIdx.x * blockDim.x + threadIdx.x;
  if (i < n) m[i] = 0;
}

extern "C" void kernel_launch(void* const* d_in, const int* in_sizes, int n_in, void* d_out,
                              int out_size, void* d_ws, size_t ws_size, hipStream_t stream) {
  static int grid_blocks = 0;
  if (!grid_blocks) {
    int dev = 0, cus = 0, per_cu = 0;
    (void)hipGetDevice(&dev);
    (void)hipDeviceGetAttribute(&cus, hipDeviceAttributeMultiprocessorCount, dev);
    (void)hipOccupancyMaxActiveBlocksPerMultiprocessor(&per_cu, fwd_megakernel, 256, 0);
    if (per_cu > 2) per_cu = 2;
    if (per_cu < 1) per_cu = 1;
    grid_blocks = cus * per_cu;
  }
  Params p{};
  p.x = (const float*)d_in[0]; p.norm_g = (const float*)d_in[1]; p.w_in = (const float*)d_in[2]; p.fox_b = (const float*)d_in[3];
  p.conv_w = (const float*)d_in[4]; p.conv_b = (const float*)d_in[5]; p.conv_ln_g = (const float*)d_in[6]; p.conv_ln_b = (const float*)d_in[7];
  p.conv_pw = (const float*)d_in[8]; p.cmp_pe_k = (const float*)d_in[9]; p.cmp_pe_v = (const float*)d_in[10];
  p.cmp_k_w1 = (const float*)d_in[11]; p.cmp_k_w2 = (const float*)d_in[12]; p.cmp_v_w1 = (const float*)d_in[13]; p.cmp_v_w2 = (const float*)d_in[14];
  p.w_out = (const float*)d_in[15]; p.final_g = (const float*)d_in[16];
  p.out = (float*)d_out; p.ws = (char*)d_ws;
#if !(EN_FOX && EN_NSA)
  {
    size_t n = (size_t)BT * 1024 / 2;
    zero_mixed<<<(unsigned)((n + 255) / 256), 256, 0, stream>>>((unsigned*)((char*)d_ws + OFF_MIXED), n);
  }
#endif
  (void)hipMemsetAsync((char*)d_ws + OFF_BAR, 0, 16384, stream);
  void* args[] = {&p};
  hipError_t e = hipLaunchCooperativeKernel((void*)fwd_megakernel, dim3(grid_blocks), dim3(256), args, 0, stream);
  if (e != hipSuccess) fprintf(stderr, "cooperative launch failed: %s (grid %d)\n", hipGetErrorString(e), grid_blocks);
}
```

```cpp
#include <hip/hip_runtime.h>
#include <hip/hip_cooperative_groups.h>
#include <cstdio>
namespace cg = cooperative_groups;

#ifndef PROBE_REP
#define PROBE_REP 0
#endif
#ifndef EN_FOX
#define EN_FOX 1
#endif
#ifndef EN_NSA
#define EN_NSA 1
#endif

typedef unsigned short u16;
using bf16x8 = __attribute__((ext_vector_type(8))) short;
using f32x16 = __attribute__((ext_vector_type(16))) float;
using u32x4 = __attribute__((ext_vector_type(4))) unsigned;
using u32x2 = __attribute__((ext_vector_type(2))) unsigned;
using f32x4 = __attribute__((ext_vector_type(4))) float;
typedef __attribute__((ext_vector_type(2))) __bf16 bf2_t;
#define DI __device__ __forceinline__
#define EXP2(x) __builtin_amdgcn_exp2f(x)
#define MFMA(a, b, c) __builtin_amdgcn_mfma_f32_32x32x16_bf16((a), (b), (c), 0, 0, 0)

constexpr int T_ = 8192;
constexpr int BT = 16384;
constexpr int NPAD = 3712;
constexpr float LOG2E = 1.4426950408889634f;
constexpr int LDS_BYTES = 67584;

constexpr size_t SZ_WINT = (size_t)NPAD * 1024 * 2;
constexpr size_t OFF_WINT = 0;
constexpr size_t OFF_WOUTT = OFF_WINT + 2 * SZ_WINT;
constexpr size_t OFF_PWT = OFF_WOUTT + 2 * (size_t)1024 * 1024 * 2;
constexpr size_t OFF_W1T = OFF_PWT + 2 * (size_t)256 * 256 * 2;
constexpr size_t OFF_W2T = OFF_W1T + 4 * (size_t)256 * 2048 * 2;
constexpr size_t OFF_CBIAS = OFF_W2T + 4 * (size_t)128 * 256 * 2;
constexpr size_t OFF_ROPE = OFF_CBIAS + 4 * 256 * 4;
constexpr size_t OFF_H = OFF_ROPE + (size_t)8192 * 8 * 2 * 4;
constexpr size_t OFF_OSC = OFF_H;
constexpr size_t OFF_FQ = OFF_H + (size_t)BT * 1024 * 2;
constexpr size_t OFF_FK = OFF_FQ + (size_t)BT * 256 * 2;
constexpr size_t OFF_FVT = OFF_FK + (size_t)BT * 256 * 2;
constexpr size_t OFF_FLOG = OFF_FVT + (size_t)BT * 256 * 2;
constexpr size_t OFF_GATE = OFF_FLOG + (size_t)BT * 4 * 4;
constexpr size_t OFF_GLU = OFF_GATE + (size_t)BT * 1024 * 2;
constexpr size_t OFF_NQ = OFF_GLU + (size_t)BT * 512 * 2;
constexpr size_t OFF_KC = OFF_NQ + (size_t)BT * 512 * 2;
constexpr size_t SZ_KV = (size_t)BT * 128 * 2;
constexpr size_t OFF_VC = OFF_KC + SZ_KV;
constexpr size_t OFF_KS = OFF_VC + SZ_KV;
constexpr size_t OFF_VST = OFF_KS + SZ_KV;
constexpr size_t OFF_KW = OFF_VST + SZ_KV;
constexpr size_t OFF_VWT = OFF_KW + SZ_KV;
constexpr size_t OFF_NGL = OFF_VWT + SZ_KV;
constexpr size_t OFF_KCMP = OFF_NGL + (size_t)BT * 24 * 4;
constexpr size_t OFF_VCMPT = OFF_KCMP + (size_t)4 * 512 * 64 * 2;
constexpr size_t OFF_HID = OFF_VCMPT + (size_t)4 * 512 * 64 * 2;
constexpr size_t OFF_CONVA = OFF_HID + (size_t)32 * 128 * 256 * 2;
constexpr size_t OFF_MIXED = OFF_CONVA + (size_t)BT * 256 * 2;
constexpr size_t OFF_KN2 = OFF_MIXED + (size_t)BT * 1024 * 2;
constexpr size_t OFF_CNT = OFF_KN2 + 256;
constexpr size_t OFF_BAR = OFF_CNT + 256;
constexpr size_t OFF_WTAIL = OFF_BAR + 16384;
constexpr size_t WS_TOTAL = OFF_WTAIL + (size_t)2 * 32 * 1024 * 4;
static_assert(WS_TOTAL <= (size_t)256 * 1024 * 1024, "ws too large");

struct Params {
  const float* x; const float* norm_g; const float* w_in; const float* fox_b; const float* conv_w; const float* conv_b;
  const float* conv_ln_g; const float* conv_ln_b; const float* conv_pw; const float* cmp_pe_k; const float* cmp_pe_v;
  const float* cmp_k_w1; const float* cmp_k_w2; const float* cmp_v_w1; const float* cmp_v_w2; const float* w_out; const float* final_g;
  float* out; char* ws;
};

DI int ltid() { int t = threadIdx.x; asm volatile("" : "+v"(t)); return t; }
DI char* lptr(char* q) { int z = 0; asm volatile("" : "+s"(z)); return q + z; }
#define LDSP(T, a) ((__attribute__((address_space(3))) T*)(a))
DI int tl_of(int ni) { const int t = ltid(); return ((t >> 6) << 4) + 8 * ni + ((t & 31) >> 2); }
DI int h_of() { return (ltid() >> 5) & 1; }
DI u16 f2bf(float x) { __bf16 b = (__bf16)x; return __builtin_bit_cast(u16, b); }
DI unsigned pk2(float x, float y) { bf2_t v; v[0] = (__bf16)x; v[1] = (__bf16)y; return __builtin_bit_cast(unsigned, v); }
DI float bf2f(u16 v) { return __uint_as_float(((unsigned)v) << 16); }
DI float bflo(unsigned v) { return __uint_as_float(v << 16); }
DI float bfhi(unsigned v) { return __uint_as_float(v & 0xffff0000u); }
DI int vperm16(int t) { return (t & ~15) | (t & 3) | ((t & 4) << 1) | ((t & 8) >> 1); }
DI int crow(int reg, int h) { return (reg & 3) + 8 * (reg >> 2) + 4 * h; }
DI float siluf(float x) { return x / (1.f + __expf(-x)); }
DI float sigmf(float x) { return 1.f / (1.f + __expf(-x)); }
DI float geluf(float x) { return 0.5f * x * (1.f + tanhf(0.7978845608028654f * (x + 0.044715f * x * x * x))); }
DI int swz(int row, int chunk) { return row * 128 + ((chunk ^ ((row >> 1) & 7)) << 4); }
DI void zero_acc(f32x16 (&a)[2][2]) {
#pragma unroll
  for (int i = 0; i < 2; ++i)
#pragma unroll
    for (int j = 0; j < 2; ++j)
#pragma unroll
      for (int k = 0; k < 16; ++k) a[i][j][k] = 0.f;
}

DI int swz32(int row, int chunk) { return row * 64 + ((chunk ^ ((row >> 2) & 3)) << 4); }
template <bool SWAP>
DI void gemm_tile(const u16* __restrict__ A, long lda, const u16* __restrict__ B, long ldb, int K, unsigned lds, f32x16 (&acc)[2][2]) {
  const int tid = ltid(), lane = tid & 63, w = tid >> 6, wr = w >> 1, wc = w & 1, r = lane & 31, h = lane >> 5;
  zero_acc(acc);
  const int lrow = tid >> 2, lch = tid & 3;
  const u16* ga = A + (long)lrow * lda + lch * 8;
  const u16* gb = B + (long)lrow * ldb + lch * 8;
  const long a64 = 64 * lda, b64 = 64 * ldb;
  const int n2 = K >> 6;
  u32x4 a0[4], a1[4], b0[4], b1[4];
#define GLOAD(S, J) { S[0] = *(const u32x4*)(ga + (J) * 32); S[1] = *(const u32x4*)(ga + a64 + (J) * 32); S[2] = *(const u32x4*)(gb + (J) * 32); S[3] = *(const u32x4*)(gb + b64 + (J) * 32); }
#define SWRITE(S, OFF) { const unsigned bb = lds + (OFF); *LDSP(u32x4, bb + swz32(lrow, lch)) = S[0]; *LDSP(u32x4, bb + swz32(lrow + 64, lch)) = S[1]; \
                         *LDSP(u32x4, bb + 8192 + swz32(lrow, lch)) = S[2]; *LDSP(u32x4, bb + 8192 + swz32(lrow + 64, lch)) = S[3]; }
#define COMPUTE(OFF) { const unsigned As = lds + (OFF); const unsigned Bs = As + 8192; \
    _Pragma("unroll") for (int ks = 0; ks < 2; ++ks) { bf16x8 af[2], bf[2]; \
      _Pragma("unroll") for (int i = 0; i < 2; ++i) { af[i] = *LDSP(bf16x8, As + swz32(64 * wr + 32 * i + r, 2 * ks + h)); bf[i] = *LDSP(bf16x8, Bs + swz32(64 * wc + 32 * i + r, 2 * ks + h)); } \
      _Pragma("unroll") for (int mi = 0; mi < 2; ++mi) _Pragma("unroll") for (int ni = 0; ni < 2; ++ni) { \
        if (SWAP) acc[mi][ni] = MFMA(bf[ni], af[mi], acc[mi][ni]); else acc[mi][ni] = MFMA(af[mi], bf[ni], acc[mi][ni]); } } }
  GLOAD(a0, 0)
  GLOAD(a1, 1)
  if (n2 > 1) { GLOAD(b0, 2) GLOAD(b1, 3) }
  __syncthreads();
  SWRITE(a0, 0)
  SWRITE(a1, 16384)
  if (n2 > 2) { GLOAD(a0, 4) GLOAD(a1, 5) }
  __syncthreads();
  int t = 0;
  while (true) {
    COMPUTE(0)
    COMPUTE(16384)
    if (t + 1 < n2) { SWRITE(b0, 32768) SWRITE(b1, 49152) }
    if (t + 3 < n2) { GLOAD(b0, 2 * (t + 3)) GLOAD(b1, 2 * (t + 3) + 1) }
    __syncthreads();
    if (++t >= n2) break;
    COMPUTE(32768)
    COMPUTE(49152)
    if (t + 1 < n2) { SWRITE(a0, 0) SWRITE(a1, 16384) }
    if (t + 3 < n2) { GLOAD(a0, 2 * (t + 3)) GLOAD(a1, 2 * (t + 3) + 1) }
    __syncthreads();
    if (++t >= n2) break;
  }
#undef GLOAD
#undef SWRITE
#undef COMPUTE
}

DI int win_srccol(int n) {
  if (n < 768) return n;
  if (n < 3072) return n + 4;
  if (n < 3584) return n + 28;
  int i = n - 3584;
  if (i < 4) return 768 + i;
  if (i < 28) return 3076 + (i - 4);
  return -1;
}

DI void transpose_tile(const float* __restrict__ src, int ld, int K, int mapkind, int nsrc, u16* __restrict__ dst, int k0, int n0, unsigned lds) {
  const int tid = ltid(), j = tid & 63, i0 = tid >> 6;
  const int n = n0 + j;
  const int sc = mapkind ? win_srccol(n) : (n < nsrc ? n : -1);
  float v[16];
#pragma unroll
  for (int it = 0; it < 16; ++it) v[it] = (sc >= 0) ? src[(size_t)(k0 + i0 + 4 * it) * ld + sc] : 0.f;
  __syncthreads();
#pragma unroll
  for (int it = 0; it < 16; ++it) *LDSP(float, lds + 4 * ((i0 + 4 * it) * 65 + j)) = v[it];
  __syncthreads();
  const int jn = tid >> 2, kc = (tid & 3) * 16;
  u32x4 o0, o1;
#pragma unroll
  for (int e = 0; e < 4; ++e) {
    o0[e] = pk2(*LDSP(float, lds + 4 * ((kc + 2 * e) * 65 + jn)), *LDSP(float, lds + 4 * ((kc + 2 * e + 1) * 65 + jn)));
    o1[e] = pk2(*LDSP(float, lds + 4 * ((kc + 8 + 2 * e) * 65 + jn)), *LDSP(float, lds + 4 * ((kc + 8 + 2 * e + 1) * 65 + jn)));
  }
  u16* dp = dst + (size_t)(n0 + jn) * K + k0 + kc;
  *(u32x4*)dp = o0;
  *(u32x4*)(dp + 8) = o1;
}

constexpr int P0_PER_LAYER = 928 + 256 + 16 + 256 + 16;
DI void phase0_item(const Params& p, int idx, unsigned lds) {
  const int l = idx / P0_PER_LAYER;
  int r = idx % P0_PER_LAYER;
  char* ws = lptr(p.ws);
  if (r < 928) {
    transpose_tile(p.w_in + (size_t)l * 1024 * 3612, 3612, 1024, 1, 0, (u16*)(ws + OFF_WINT + l * SZ_WINT), (r % 16) * 64, (r / 16) * 64, lds);
    return;
  }
  r -= 928;
  if (r < 256) {
    transpose_tile(p.w_out + (size_t)l * 1024 * 1024, 1024, 1024, 0, 1024, (u16*)(ws + OFF_WOUTT) + (size_t)l * 1024 * 1024, (r % 16) * 64, (r / 16) * 64, lds);
    return;
  }
  r -= 256;
  if (r < 16) {
    transpose_tile(p.conv_pw + (size_t)l * 256 * 256, 256, 256, 0, 256, (u16*)(ws + OFF_PWT) + (size_t)l * 256 * 256, (r % 4) * 64, (r / 4) * 64, lds);
    return;
  }
  r -= 16;
  if (r < 256) {
    const int kv = r >> 7; r &= 127;
    const float* src = (kv ? p.cmp_v_w1 : p.cmp_k_w1) + (size_t)l * 2048 * 256;
    transpose_tile(src, 256, 2048, 0, 256, (u16*)(ws + OFF_W1T) + (size_t)(l * 2 + kv) * 256 * 2048, (r % 32) * 64, (r / 32) * 64, lds);
    return;
  }
  r -= 256;
  {
    const int kv = r >> 3; r &= 7;
    const float* src = (kv ? p.cmp_v_w2 : p.cmp_k_w2) + (size_t)l * 256 * 64;
    transpose_tile(src, 64, 256, 0, 64, (u16*)(ws + OFF_W2T) + (size_t)(l * 2 + kv) * 128 * 256, (r % 4) * 64, (r / 4) * 64, lds);
  }
}

DI void cbias_item(const Params& p, int item, unsigned lds) {
  const int idx = item >> 3, ng = item & 7;
  const int l = idx >> 1, kv = idx & 1;
  const float* pe = (kv ? p.cmp_pe_v : p.cmp_pe_k) + (size_t)l * 2048;
  const float* w1 = (kv ? p.cmp_v_w1 : p.cmp_k_w1) + (size_t)l * 2048 * 256;
  const int tid = ltid(), nn = tid & 31, ksl = tid >> 5;
  const int n = ng * 32 + nn;
  float s0 = 0.f, s1 = 0.f, s2 = 0.f, s3 = 0.f;
  const float* wp = w1 + (size_t)(ksl * 256) * 256 + n;
  const float* pp = pe + ksl * 256;
#pragma unroll 4
  for (int i = 0; i < 256; i += 4) {
    s0 = fmaf(pp[i], wp[(size_t)i * 256], s0);
    s1 = fmaf(pp[i + 1], wp[(size_t)(i + 1) * 256], s1);
    s2 = fmaf(pp[i + 2], wp[(size_t)(i + 2) * 256], s2);
    s3 = fmaf(pp[i + 3], wp[(size_t)(i + 3) * 256], s3);
  }
  __syncthreads();
  *LDSP(float, lds + 4 * tid) = (s0 + s1) + (s2 + s3);
  __syncthreads();
  if (tid < 32) {
    float t = 0.f;
#pragma unroll
    for (int k = 0; k < 8; ++k) t += *LDSP(float, lds + 4 * (k * 32 + tid));
    ((float*)(p.ws + OFF_CBIAS))[idx * 256 + n] = t;
  }
}

DI void rope_item(const Params& p, int idx) {
  const int e = idx * 256 + ltid();
  const int pos = e >> 3, i = e & 7;
  const float inv = powf(500000.0f, -(float)(2 * i) / 16.0f);
  const float ang = (float)pos * inv;
  float2 cs; cs.x = cosf(ang); cs.y = sinf(ang);
  ((float2*)(p.ws + OFF_ROPE))[e] = cs;
}

DI void wtail_item(const Params& p, int item) {
  const int l = item >> 5, j = item & 31;
  float* dst = (float*)(p.ws + OFF_WTAIL) + (size_t)item * 1024;
  const int tid = ltid();
  const int col = (j < 4) ? 768 + j : 3076 + (j - 4);
#pragma unroll
  for (int i = 0; i < 4; ++i) {
    const int k = tid + 256 * i;
    dst[k] = (j < 28) ? p.w_in[((size_t)l * 1024 + k) * 3612 + col] : 0.f;
  }
}

DI void norm_item(const float* __restrict__ src, const float* __restrict__ g, u16* dstb, float* dstf, int item,
                  const float* __restrict__ wt, const float* __restrict__ foxb, float* flog, float* ngl) {
  const int tid_ = ltid(); const int lane = tid_ & 63, w = tid_ >> 6;
  const int row = item * 4 + w;
  const float4* s4 = (const float4*)(src + (size_t)row * 1024);
  float4 v[4];
  float ss = 0.f;
#pragma unroll
  for (int i = 0; i < 4; ++i) { v[i] = s4[lane + 64 * i]; ss += v[i].x * v[i].x + v[i].y * v[i].y + v[i].z * v[i].z + v[i].w * v[i].w; }
#pragma unroll
  for (int o = 32; o > 0; o >>= 1) ss += __shfl_xor(ss, o);
  const float rs = rsqrtf(ss * (1.0f / 1024.0f) + 1e-6f);
#pragma unroll
  for (int i = 0; i < 4; ++i) {
    float4 gg = ((const float4*)g)[lane + 64 * i];
    float4 o = {v[i].x * rs * gg.x, v[i].y * rs * gg.y, v[i].z * rs * gg.z, v[i].w * rs * gg.w};
    v[i] = o;
    if (dstb) {
      u32x2 pk; pk[0] = pk2(o.x, o.y); pk[1] = pk2(o.z, o.w);
      *(u32x2*)(dstb + (size_t)row * 1024 + (lane + 64 * i) * 4) = pk;
    } else {
      ((float4*)(dstf + (size_t)row * 1024))[lane + 64 * i] = o;
    }
  }
  if (wt) {
    float a[32];
#pragma unroll
    for (int j = 0; j < 32; ++j) {
      float acc = 0.f;
      if (j < 28) {
#pragma unroll
        for (int i = 0; i < 4; ++i) {
          const float4 ww = ((const float4*)(wt + (size_t)j * 1024))[lane + 64 * i];
          acc = fmaf(v[i].x, ww.x, acc); acc = fmaf(v[i].y, ww.y, acc); acc = fmaf(v[i].z, ww.z, acc); acc = fmaf(v[i].w, ww.w, acc);
        }
      }
      a[j] = acc;
    }
#pragma unroll
    for (int t = 0; t < 16; ++t) { const bool up = (lane & 32) != 0; const float send = up ? a[t] : a[t + 16]; const float keep = up ? a[t + 16] : a[t]; a[t] = keep + __shfl_xor(send, 32); }
#pragma unroll
    for (int t = 0; t < 8; ++t) { const bool up = (lane & 16) != 0; const float send = up ? a[t] : a[t + 8]; const float keep = up ? a[t + 8] : a[t]; a[t] = keep + __shfl_xor(send, 16); }
#pragma unroll
    for (int t = 0; t < 4; ++t) { const bool up = (lane & 8) != 0; const float send = up ? a[t] : a[t + 4]; const float keep = up ? a[t + 4] : a[t]; a[t] = keep + __shfl_xor(send, 8); }
#pragma unroll
    for (int t = 0; t < 2; ++t) { const bool up = (lane & 4) != 0; const float send = up ? a[t] : a[t + 2]; const float keep = up ? a[t + 2] : a[t]; a[t] = keep + __shfl_xor(send, 4); }
    { const bool up = (lane & 2) != 0; const float send = up ? a[0] : a[1]; const float keep = up ? a[1] : a[0]; a[0] = keep + __shfl_xor(send, 2); }
    a[0] += __shfl_xor(a[0], 1);
    const int col = lane >> 1;
    if ((lane & 1) == 0) {
      const float val = a[0];
      if (col < 4) {
        const float xx = val + foxb[col];
        flog[(size_t)row * 4 + col] = fminf(xx, 0.f) - __logf(1.f + __expf(-fabsf(xx)));
      } else if (col < 28) {
        ngl[(size_t)row * 24 + (col - 4)] = sigmf(val);
      }
    }
  }
}

DI void gemm1_item(const Params& p, int l, int item, unsigned lds) {
  const int mt = item / 29, nt = item % 29;
  const int m0 = mt * 128;
  char* ws = lptr(p.ws);
  const u16* A = (const u16*)(ws + OFF_H) + (size_t)m0 * 1024;
  const u16* B = (const u16*)(ws + OFF_WINT + l * SZ_WINT) + (size_t)nt * 128 * 1024;
  const bool swap = (nt == 4 || nt == 5 || nt == 21 || nt == 23);
  f32x16 acc[2][2];
  if (swap) gemm_tile<true>(A, 1024, B, 1024, 1024, lds, acc);
  else gemm_tile<false>(A, 1024, B, 1024, 1024, lds, acc);
  const int tid = ltid(), lane = tid & 63, w = tid >> 6, wr = w >> 1, wc = w & 1, r = lane & 31, h = lane >> 5;
  const int b = m0 >> 13, t0 = m0 & 8191;
  if (swap) {
    u16* base;
    if (nt == 4 || nt == 5) { const int head = (nt - 4) * 2 + wc; base = (u16*)(ws + OFF_FVT) + (size_t)(b * 4 + head) * 64 * T_; }
    else if (nt == 21) base = (u16*)(ws + OFF_VST) + (size_t)(b * 2 + wc) * 64 * T_;
    else base = (u16*)(ws + OFF_VWT) + (size_t)(b * 2 + wc) * 64 * T_;
#pragma unroll
    for (int mi = 0; mi < 2; ++mi)
#pragma unroll
      for (int ni = 0; ni < 2; ++ni)
#pragma unroll
        for (int reg = 0; reg < 16; ++reg) {
          const int d = 32 * ni + crow(reg, h);
          const int t = vperm16(t0 + 64 * wr + 32 * mi + r);
          base[(size_t)d * T_ + t] = f2bf(acc[mi][ni][reg]);
        }
    return;
  }
  if (nt < 4 || nt == 18 || nt == 19 || nt == 20 || nt == 22 || (nt >= 14 && nt <= 17)) {
    u16* base; long rstride; float scale = 1.f; bool rope = false;
    if (nt < 2) { base = (u16*)(ws + OFF_FQ) + ((size_t)(b * 4 + nt * 2 + wc) * T_ + t0) * 64; rstride = 64; scale = 0.125f; }
    else if (nt < 4) { base = (u16*)(ws + OFF_FK) + ((size_t)(b * 4 + (nt - 2) * 2 + wc) * T_ + t0) * 64; rstride = 64; }
    else if (nt >= 14 && nt <= 17) {
      const int head8 = (nt - 14) * 2 + wc, g = head8 >> 2, hh = head8 & 3;
      base = (u16*)(ws + OFF_NQ) + (((size_t)(b * 2 + g) * T_ + t0) * 4 + hh) * 64; rstride = 256; scale = 0.125f; rope = true;
    } else {
      const size_t off = (nt == 18) ? OFF_KC : (nt == 19) ? OFF_VC : (nt == 20) ? OFF_KS : OFF_KW;
      base = (u16*)(ws + off) + ((size_t)(b * 2 + wc) * T_ + t0) * 64; rstride = 64; rope = (nt == 20 || nt == 22);
    }
    const float2* rt = (const float2*)(ws + OFF_ROPE);
    if (nt == 2 || nt == 3) {
      float mxn = 0.f;
#pragma unroll
      for (int mi = 0; mi < 2; ++mi)
#pragma unroll
        for (int reg = 0; reg < 16; ++reg) {
          const float a0 = bf2f(f2bf(acc[mi][0][reg])), a1 = bf2f(f2bf(acc[mi][1][reg]));
          float ss = a0 * a0 + a1 * a1;
          ss += __shfl_xor(ss, 1); ss += __shfl_xor(ss, 2); ss += __shfl_xor(ss, 4); ss += __shfl_xor(ss, 8); ss += __shfl_xor(ss, 16);
          mxn = fmaxf(mxn, ss);
        }
      mxn = fmaxf(mxn, __shfl_xor(mxn, 32));
      if (lane == 0) atomicMax((unsigned*)(ws + OFF_KN2) + l * 8 + b * 4 + (nt - 2) * 2 + wc, __float_as_uint(mxn));
    }
#pragma unroll
    for (int mi = 0; mi < 2; ++mi)
#pragma unroll
      for (int ni = 0; ni < 2; ++ni)
#pragma unroll
        for (int reg = 0; reg < 16; ++reg) {
          const int row = 64 * wr + 32 * mi + crow(reg, h);
          float v = acc[mi][ni][reg];
          if (ni == 0 && rope) {
            const float pv = __shfl_xor(v, 8);
            if (r < 16) {
              const float2 cs = rt[(t0 + row) * 8 + (r & 7)];
              v = (r & 8) ? (pv * cs.y + v * cs.x) : (v * cs.x - pv * cs.y);
            }
          }
          base[(size_t)row * rstride + 32 * ni + r] = f2bf(v * scale);
        }
    return;
  }
  if (nt == 28) {
    float* flog = (float*)(ws + OFF_FLOG);
    float* ngl = (float*)(ws + OFF_NGL);
    if (wc == 0) {
      const int col = r;
      const float fb = (col < 4) ? p.fox_b[l * 4 + col] : 0.f;
#pragma unroll
      for (int mi = 0; mi < 2; ++mi)
#pragma unroll
        for (int reg = 0; reg < 16; ++reg) {
          const int m = m0 + 64 * wr + 32 * mi + crow(reg, h);
          const float v = acc[mi][0][reg];
          if (col < 4) {
            const float xx = v + fb;
            flog[(size_t)m * 4 + col] = fminf(xx, 0.f) - __logf(1.f + __expf(-fabsf(xx)));
          } else if (col < 28) {
            ngl[(size_t)m * 24 + (col - 4)] = sigmf(v);
          }
        }
    }
    return;
  }
  {
    u16* base; int ld; bool silu = true;
    if (nt == 6 || nt == 7) { base = (u16*)(ws + OFF_GATE) + (nt - 6) * 128; ld = 1024; }
    else if (nt >= 8 && nt <= 11) { base = (u16*)(ws + OFF_GLU) + (nt - 8) * 128; ld = 512; silu = false; }
    else if (nt == 12 || nt == 13) { base = (u16*)(ws + OFF_GATE) + 256 + (nt - 12) * 128; ld = 1024; }
    else { base = (u16*)(ws + OFF_GATE) + 512 + (nt - 24) * 128; ld = 1024; }
#pragma unroll
    for (int mi = 0; mi < 2; ++mi)
#pragma unroll
      for (int ni = 0; ni < 2; ++ni)
#pragma unroll
        for (int reg = 0; reg < 16; ++reg) {
          const int m = m0 + 64 * wr + 32 * mi + crow(reg, h);
          float v = acc[mi][ni][reg];
          if (silu) v = siluf(v);
          base[(size_t)m * ld + 64 * wc + 32 * ni + r] = f2bf(v);
        }
  }
}

DI void tail_item(const Params& p, int l, int mt) {
  char* ws = lptr(p.ws);
  const int tid = ltid(), lane = tid & 63, w = tid >> 6, r = lane & 31, h = lane >> 5;
  const int m0 = mt * 128;
  const u16* ap = (const u16*)(ws + OFF_H) + (size_t)(m0 + 32 * w + r) * 1024 + 8 * h;
  const u16* bp = (const u16*)(ws + OFF_WINT + l * SZ_WINT) + (size_t)(3584 + r) * 1024 + 8 * h;
  f32x16 acc0, acc1;
#pragma unroll
  for (int k = 0; k < 16; ++k) { acc0[k] = 0.f; acc1[k] = 0.f; }
  for (int kb = 0; kb < 8; ++kb) {
    bf16x8 af[8], bf[8];
#pragma unroll
    for (int ks = 0; ks < 8; ++ks) { af[ks] = *(const bf16x8*)(ap + (kb * 8 + ks) * 16); bf[ks] = *(const bf16x8*)(bp + (kb * 8 + ks) * 16); }
#pragma unroll
    for (int ks = 0; ks < 8; ks += 2) { acc0 = MFMA(af[ks], bf[ks], acc0); acc1 = MFMA(af[ks + 1], bf[ks + 1], acc1); }
  }
  float* flog = (float*)(ws + OFF_FLOG);
  float* ngl = (float*)(ws + OFF_NGL);
  const int col = r;
  const float fb = (col < 4) ? p.fox_b[l * 4 + col] : 0.f;
#pragma unroll
  for (int reg = 0; reg < 16; ++reg) {
    const int m = m0 + 32 * w + crow(reg, h);
    const float v = acc0[reg] + acc1[reg];
    if (col < 4) {
      const float xx = v + fb;
      flog[(size_t)m * 4 + col] = fminf(xx, 0.f) - __logf(1.f + __expf(-fabsf(xx)));
    } else if (col < 28) {
      ngl[(size_t)m * 24 + (col - 4)] = sigmf(v);
    }
  }
}

DI void gemm2_item(const Params& p, int l, int item, unsigned lds) {
  const int mt = item >> 3, nt = item & 7;
  const int m0 = mt * 128, n0 = nt * 128;
  char* ws = lptr(p.ws);
  const u16* A = (const u16*)(ws + OFF_MIXED) + (size_t)m0 * 1024;
  const u16* B = (const u16*)(ws + OFF_WOUTT) + (size_t)l * 1024 * 1024 + (size_t)n0 * 1024;
  f32x16 acc[2][2];
  gemm_tile<false>(A, 1024, B, 1024, 1024, lds, acc);
  const int tid = ltid(), lane = tid & 63, w = tid >> 6, wr = w >> 1, wc = w & 1, r = lane & 31, h = lane >> 5;
  const float* res = (l == 0) ? p.x : p.out;
#pragma unroll
  for (int mi = 0; mi < 2; ++mi)
#pragma unroll
    for (int ni = 0; ni < 2; ++ni)
#pragma unroll
      for (int reg = 0; reg < 16; ++reg) {
        const size_t idx = (size_t)(m0 + 64 * wr + 32 * mi + crow(reg, h)) * 1024 + n0 + 64 * wc + 32 * ni + r;
        p.out[idx] = res[idx] + acc[mi][ni][reg];
      }
}

DI void conv_item(const Params& p, int l, int item, unsigned lds) {
  char* ws = lptr(p.ws);
  const int m0 = item * 64, t0 = m0 & 8191;
  const int tid = ltid(), lane = tid & 63, w = tid >> 6;
  const u16* glu = (const u16*)(ws + OFF_GLU);
  const unsigned at = lds + 32768;
  {
    f32x4 wt[31];
    const float* cw = p.conv_w + (size_t)l * 31 * 256 + lane * 4;
#pragma unroll
    for (int k = 0; k < 31; ++k) wt[k] = *(const f32x4*)(cw + k * 256);
    const float4 cb = *(const float4*)(p.conv_b + l * 256 + lane * 4);
    const float4 lg = *(const float4*)(p.conv_ln_g + l * 256 + lane * 4);
    const float4 lb = *(const float4*)(p.conv_ln_b + l * 256 + lane * 4);
    for (int sub = 0; sub < 2; ++sub) {
      const int ts = t0 + 32 * sub;
      __syncthreads();
      {
        const int c8 = (tid & 31) * 8, rsub = tid >> 5;
#pragma unroll
        for (int pb = 0; pb < 8; pb += 4) {
          u32x4 av[4], bv[4];
#pragma unroll
          for (int q = 0; q < 4; ++q) {
            const int i = (pb + q) * 8 + rsub;
            int t = ts - 30 + i; if (t < 0) t = 0; if (t > T_ - 1) t = T_ - 1;
            const size_t m = (size_t)(m0 - t0 + t);
            av[q] = *(const u32x4*)(glu + m * 512 + c8);
            bv[q] = *(const u32x4*)(glu + m * 512 + 256 + c8);
          }
#pragma unroll
          for (int q = 0; q < 4; ++q) {
            const int i = (pb + q) * 8 + rsub;
            const bool ok = (ts - 30 + i) >= 0;
            u32x4 yv;
#pragma unroll
            for (int e = 0; e < 4; ++e) {
              const unsigned y = pk2(bflo(av[q][e]) * sigmf(bflo(bv[q][e])), bfhi(av[q][e]) * sigmf(bfhi(bv[q][e])));
              yv[e] = ok ? y : 0u;
            }
            if (i < 62) *LDSP(u32x4, lds + i * 512 + c8 * 2) = yv;
          }
        }
      }
      __syncthreads();
#pragma unroll 2
      for (int j = 0; j < 8; ++j) {
        const int tt = 8 * w + j;
        float4 o = cb;
#pragma unroll
        for (int k = 0; k < 31; ++k) {
          const u32x2 yy = *LDSP(u32x2, lds + (tt + k) * 512 + lane * 8);
          o.x = fmaf(wt[k][0], bflo(yy[0]), o.x);
          o.y = fmaf(wt[k][1], bfhi(yy[0]), o.y);
          o.z = fmaf(wt[k][2], bflo(yy[1]), o.z);
          o.w = fmaf(wt[k][3], bfhi(yy[1]), o.w);
        }
        float s = o.x + o.y + o.z + o.w;
#pragma unroll
        for (int of = 32; of > 0; of >>= 1) s += __shfl_xor(s, of);
        const float mu = s * (1.f / 256.f);
        const float dx = o.x - mu, dy = o.y - mu, dz = o.z - mu, dw = o.w - mu;
        float vs = dx * dx + dy * dy + dz * dz + dw * dw;
#pragma unroll
        for (int of = 32; of > 0; of >>= 1) vs += __shfl_xor(vs, of);
        const float rs = rsqrtf(vs * (1.f / 256.f) + 1e-6f);
        const float y0 = siluf(dx * rs * lg.x + lb.x), y1 = siluf(dy * rs * lg.y + lb.y);
        const float y2 = siluf(dz * rs * lg.z + lb.z), y3 = siluf(dw * rs * lg.w + lb.w);
        u32x2 pk; pk[0] = pk2(y0, y1); pk[1] = pk2(y2, y3);
        const int row = 32 * sub + tt;
        *LDSP(u32x2, at + row * 512 + (((lane >> 1) ^ (row & 15)) << 4) + 8 * (lane & 1)) = pk;
      }
    }
  }
  __syncthreads();
  const int r = lane & 31, h = lane >> 5;
  const u16* pw = (const u16*)(ws + OFF_PWT) + (size_t)l * 65536 + (size_t)(64 * w + r) * 256 + 8 * h;
  f32x16 acc[2][2];
  zero_acc(acc);
#pragma unroll
  for (int kb = 0; kb < 2; ++kb) {
    bf16x8 bfr[8][2];
#pragma unroll
    for (int ks = 0; ks < 8; ++ks)
#pragma unroll
      for (int ni = 0; ni < 2; ++ni) bfr[ks][ni] = *(const bf16x8*)(pw + (size_t)ni * 32 * 256 + (kb * 8 + ks) * 16);
#pragma unroll
    for (int ks = 0; ks < 8; ++ks) {
      const int kk = kb * 8 + ks;
      bf16x8 af[2];
#pragma unroll
      for (int mi = 0; mi < 2; ++mi) { const int row = 32 * mi + r; af[mi] = *LDSP(bf16x8, at + row * 512 + (((2 * kk + h) ^ (row & 15)) << 4)); }
#pragma unroll
      for (int mi = 0; mi < 2; ++mi)
#pragma unroll
        for (int ni = 0; ni < 2; ++ni) acc[mi][ni] = MFMA(af[mi], bfr[ks][ni], acc[mi][ni]);
    }
  }
  const u16* gate = (const u16*)(ws + OFF_GATE);
  u16* mixed = (u16*)(ws + OFF_MIXED);
#pragma unroll
  for (int mi = 0; mi < 2; ++mi)
#pragma unroll
    for (int ni = 0; ni < 2; ++ni)
#pragma unroll
      for (int reg = 0; reg < 16; ++reg) {
        const size_t idx = (size_t)(m0 + 32 * mi + crow(reg, h)) * 1024 + 256 + 64 * w + 32 * ni + r;
        mixed[idx] = f2bf(acc[mi][ni][reg] * bf2f(gate[idx]));
      }
}

DI void compress_item(const Params& p, int l, int item64, unsigned lds) {
  char* ws = lptr(p.ws);
  const int nh = item64 & 1, item = item64 >> 1;
  const int mtile = item & 3, kv = (item >> 2) & 1, bg = item >> 3;
  const u16* src = (const u16*)(ws + (kv ? OFF_VC : OFF_KC)) + ((size_t)bg * T_ + (size_t)16 * 128 * mtile) * 64;
  const u16* w1t = (const u16*)(ws + OFF_W1T) + (size_t)(l * 2 + kv) * 256 * 2048;
  const u16* w2t = (const u16*)(ws + OFF_W2T) + (size_t)(l * 2 + kv) * 128 * 256;
  const float* bias = (const float*)(ws + OFF_CBIAS) + (l * 2 + kv) * 256;
  u16* hid = (u16*)(ws + OFF_HID) + (size_t)item * 128 * 256;
  const int tid = ltid(), lane = tid & 63, w = tid >> 6, wr = w >> 1, wc = w & 1, r = lane & 31, h = lane >> 5;
  {
    f32x16 acc[2][2];
    gemm_tile<false>(src, 1024, w1t + (size_t)nh * 128 * 2048, 2048, 2048, lds, acc);
#pragma unroll
    for (int ni = 0; ni < 2; ++ni) {
      const int col = nh * 128 + 64 * wc + 32 * ni + r;
      const float bb = bias[col];
#pragma unroll
      for (int mi = 0; mi < 2; ++mi)
#pragma unroll
        for (int reg = 0; reg < 16; ++reg) {
          const int row = 64 * wr + 32 * mi + crow(reg, h);
          hid[(size_t)row * 256 + col] = f2bf(geluf(acc[mi][ni][reg] + bb));
        }
    }
  }
  __threadfence();
  __syncthreads();
  if (tid == 0) {
    const int old = atomicAdd((int*)(ws + OFF_CNT) + l * 32 + item, 1);
    *LDSP(int, lds) = old;
  }
  __syncthreads();
  const int arrived = *LDSP(int, lds);
  if (arrived == 0) return;
  __threadfence();
  f32x16 acc[2][2];
  if (kv == 0) {
    gemm_tile<false>(hid, 256, w2t, 256, 256, lds, acc);
    if (wc == 0) {
      u16* kcmp = (u16*)(ws + OFF_KCMP) + (size_t)bg * 512 * 64;
      const float2* rt = (const float2*)(ws + OFF_ROPE);
#pragma unroll
      for (int mi = 0; mi < 2; ++mi)
#pragma unroll
        for (int ni = 0; ni < 2; ++ni)
#pragma unroll
          for (int reg = 0; reg < 16; ++reg) {
            const int n = 128 * mtile + 64 * wr + 32 * mi + crow(reg, h);
            float v = acc[mi][ni][reg];
            if (ni == 0) {
              const float pv = __shfl_xor(v, 8);
              if (r < 16) {
                int pos = 16 * n + 31; if (pos > 8191) pos = 8191;
                const float2 cs = rt[pos * 8 + (r & 7)];
                v = (r & 8) ? (pv * cs.y + v * cs.x) : (v * cs.x - pv * cs.y);
              }
            }
            kcmp[(size_t)n * 64 + 32 * ni + r] = f2bf(v);
          }
    }
  } else {
    gemm_tile<true>(hid, 256, w2t, 256, 256, lds, acc);
    if (wc == 0) {
      u16* vcmpT = (u16*)(ws + OFF_VCMPT) + (size_t)bg * 64 * 512;
#pragma unroll
      for (int mi = 0; mi < 2; ++mi)
#pragma unroll
        for (int ni = 0; ni < 2; ++ni)
#pragma unroll
          for (int reg = 0; reg < 16; ++reg) {
            const int n = 128 * mtile + 64 * wr + 32 * mi + r;
            const int d = 32 * ni + crow(reg, h);
            vcmpT[(size_t)d * 512 + vperm16(n)] = (n < 511) ? f2bf(acc[mi][ni][reg]) : (u16)0;
          }
    }
  }
  asm volatile("s_waitcnt vmcnt(0)" ::: "memory");
  __syncthreads();
  if (tid == 0) {
    __builtin_amdgcn_fence(__ATOMIC_RELEASE, "agent");
    asm volatile("s_waitcnt vmcnt(0)" ::: "memory");
    __hip_atomic_fetch_add((unsigned*)(ws + OFF_BAR) + 3800 + l * 4 + bg, 1u, __ATOMIC_RELAXED, __HIP_MEMORY_SCOPE_AGENT);
  }
}

struct TileRegs { u32x4 k0, k1, v0, v1; };
DI void tile_gload(TileRegs& tr, const u16* __restrict__ kbase, long kstride, const u16* __restrict__ vbase, long vstride) {
  const int tid = ltid(), row = tid >> 2, c0 = (tid & 3) * 2;
  const u16* kp = kbase + (long)row * kstride + c0 * 8;
  const u16* vp = vbase + (long)row * vstride + c0 * 8;
  tr.k0 = *(const u32x4*)kp; tr.k1 = *(const u32x4*)(kp + 8);
  tr.v0 = *(const u32x4*)vp; tr.v1 = *(const u32x4*)(vp + 8);
}
DI void tile_swrite(const TileRegs& tr, unsigned buf) {
  const int tid = ltid(), row = tid >> 2, c0 = (tid & 3) * 2;
  *LDSP(u32x4, buf + swz(row, c0)) = tr.k0;
  *LDSP(u32x4, buf + swz(row, c0 + 1)) = tr.k1;
  *LDSP(u32x4, buf + 8192 + swz(row, c0)) = tr.v0;
  *LDSP(u32x4, buf + 8192 + swz(row, c0 + 1)) = tr.v1;
}
DI void load_qfrags(bf16x8 (&QB)[2][4], const u16* __restrict__ qrows  ) {
  const int lane = ltid() & 63, r = lane & 31, h = lane >> 5;
#pragma unroll
  for (int ni = 0; ni < 2; ++ni)
#pragma unroll
    for (int ks = 0; ks < 4; ++ks) QB[ni][ks] = *(const bf16x8*)(qrows + (size_t)(32 * ni + r) * 64 + 16 * ks + 8 * h);
}
DI float dpp_xor1(float x) { return __builtin_bit_cast(float, __builtin_amdgcn_mov_dpp(__builtin_bit_cast(int, x), 0xB1, 0xF, 0xF, true)); }
DI float dpp_xor2(float x) { return __builtin_bit_cast(float, __builtin_amdgcn_mov_dpp(__builtin_bit_cast(int, x), 0x4E, 0xF, 0xF, true)); }
DI int dpp_xor1i(int x) { return __builtin_amdgcn_mov_dpp(x, 0xB1, 0xF, 0xF, true); }
DI int dpp_xor2i(int x) { return __builtin_amdgcn_mov_dpp(x, 0x4E, 0xF, 0xF, true); }
DI int dpp_hmi(int x) { return __builtin_amdgcn_mov_dpp(x, 0x141, 0xF, 0xF, true); }
DI float xhalf_max(float x) {
  const unsigned u = __float_as_uint(x);
  const auto rr = __builtin_amdgcn_permlane32_swap(u, u, false, false);
  return fmaxf(__uint_as_float(rr[0]), __uint_as_float(rr[1]));
}
DI float xhalf_sum(float x) {
  const unsigned u = __float_as_uint(x);
  const auto rr = __builtin_amdgcn_permlane32_swap(u, u, false, false);
  return __uint_as_float(rr[0]) + __uint_as_float(rr[1]);
}
template <int MODE, bool BIAS = false>
DI void attn_step1(const bf16x8 (&QB)[2][4], const unsigned Ks, f32x16 (&ot)[2][2], float (&m)[2], float (&l)[2], const int bnd, const bool rowok, const float sc2,
                   const bool first, const float cq = 0.f, const unsigned ck = 0u) {
  const int lane = ltid() & 63, r = lane & 31, h = lane >> 5;
  f32x16 s0, s1;
#pragma unroll
  for (int k = 0; k < 16; ++k) { s0[k] = 0.f; s1[k] = 0.f; }
#pragma unroll
  for (int ks = 0; ks < 4; ++ks) {
    const bf16x8 k0 = *LDSP(bf16x8, Ks + swz(r, 2 * ks + h));
    const bf16x8 k1 = *LDSP(bf16x8, Ks + swz(32 + r, 2 * ks + h));
    s0 = MFMA(k0, QB[0][ks], s0);
    s1 = MFMA(k1, QB[0][ks], s1);
  }
  if (BIAS) {
#pragma unroll
    for (int g4 = 0; g4 < 4; ++g4) {
      const f32x4 ca = *LDSP(f32x4, ck + 4 * (8 * g4 + 4 * h));
      const f32x4 cb = *LDSP(f32x4, ck + 4 * (32 + 8 * g4 + 4 * h));
#pragma unroll
      for (int e = 0; e < 4; ++e) {
        s0[4 * g4 + e] = fmaf(s0[4 * g4 + e], LOG2E, cq - ca[e]);
        s1[4 * g4 + e] = fmaf(s1[4 * g4 + e], LOG2E, cq - cb[e]);
      }
    }
  }
  if (MODE == 1) {
#pragma unroll
    for (int reg = 0; reg < 16; ++reg) {
      const int keyc = (reg & 3) + 8 * (reg >> 2);
      s0[reg] = (keyc <= bnd) ? s0[reg] : -1e30f;
      s1[reg] = (keyc + 32 <= bnd) ? s1[reg] : -1e30f;
    }
  }
  if (MODE == 2) {
#pragma unroll
    for (int reg = 0; reg < 16; ++reg) {
      const int keyc = (reg & 3) + 8 * (reg >> 2);
      s0[reg] = (keyc >= bnd) ? s0[reg] : -1e30f;
      s1[reg] = (keyc + 32 >= bnd) ? s1[reg] : -1e30f;
    }
  }
  if (first) {
    float mx = fmaxf(s0[0], s1[0]);
#pragma unroll
    for (int reg = 1; reg < 16; ++reg) mx = fmaxf(mx, fmaxf(s0[reg], s1[reg]));
    mx = xhalf_max(mx);
    if (MODE == 3) mx = rowok ? mx : -1e30f;
    m[0] = fmaxf(-1e20f, mx);
  }
  float mb = -m[0] * sc2;
  if (MODE == 3) mb = rowok ? mb : -__builtin_inff();
  float rs0 = 0.f, rs1 = 0.f;
#pragma unroll
  for (int reg = 0; reg < 16; ++reg) {
    const float p0 = EXP2(fmaf(s0[reg], sc2, mb)); s0[reg] = p0; rs0 += p0;
    const float p1 = EXP2(fmaf(s1[reg], sc2, mb)); s1[reg] = p1; rs1 += p1;
  }
  l[0] += xhalf_sum(rs0 + rs1);
  const unsigned Vs = Ks + 8192;
#pragma unroll
  for (int kk = 0; kk < 4; ++kk) {
    const int mi = kk >> 1, s = kk & 1;
    u32x4 pk;
#pragma unroll
    for (int i = 0; i < 4; ++i) pk[i] = mi ? pk2(s1[8 * s + 2 * i], s1[8 * s + 2 * i + 1]) : pk2(s0[8 * s + 2 * i], s0[8 * s + 2 * i + 1]);
    const bf16x8 pf = __builtin_bit_cast(bf16x8, pk);
    bf16x8 vf[2];
#pragma unroll
    for (int di = 0; di < 2; ++di) {
      const int d = 32 * di + r;
      const int sw = (d >> 1) & 7;
      vf[di] = *LDSP(bf16x8, Vs + d * 128 + (((4 * mi + 2 * s + h) ^ sw) << 4));
    }
#pragma unroll
    for (int di = 0; di < 2; ++di) ot[di][0] = MFMA(vf[di], pf, ot[di][0]);
  }
}

template <class LoadF, class BodyF>
DI void tile_pipeline(const int n, const unsigned lds, LoadF&& ld, BodyF&& body) {
  TileRegs A, B;
  ld(A, 0);
  __syncthreads();
  tile_swrite(A, lds);
  if (n > 1) ld(A, 1);
  if (n > 2) ld(B, 2);
  __syncthreads();
  int j = 0;
  while (true) {
    body(j, lds);
    if (j + 1 < n) tile_swrite(A, lds + 16384);
    if (j + 3 < n) ld(A, j + 3);
    __syncthreads();
    if (++j >= n) break;
    body(j, lds + 16384);
    if (j + 1 < n) tile_swrite(B, lds);
    if (j + 3 < n) ld(B, j + 3);
    __syncthreads();
    if (++j >= n) break;
  }
}

template <int MI, int NIM>
DI void qk_half(const bf16x8 (&QB)[2][4], const unsigned Ks, f32x16 (&st)[2]) {
  const int lane = ltid() & 63, r = lane & 31, h = lane >> 5;
#pragma unroll
  for (int j = 0; j < 2; ++j)
#pragma unroll
    for (int k = 0; k < 16; ++k) st[j][k] = 0.f;
#pragma unroll
  for (int ks = 0; ks < 4; ++ks) {
    const bf16x8 kf = *LDSP(bf16x8, Ks + swz(32 * MI + r, 2 * ks + h));
#pragma unroll
    for (int ni = 0; ni < 2; ++ni)
      if (NIM & (1 << ni)) st[ni] = MFMA(kf, QB[ni][ks], st[ni]);
  }
}
template <int MI>
DI void mask_hi(f32x16 (&st)[2], const int (&hi)[2]) {
#pragma unroll
  for (int reg = 0; reg < 16; ++reg) {
    const int keyc = 32 * MI + (reg & 3) + 8 * (reg >> 2);
#pragma unroll
    for (int ni = 0; ni < 2; ++ni) st[ni][reg] = (keyc <= hi[ni]) ? st[ni][reg] : -1e30f;
  }
}
template <int MI>
DI void mask_lo(f32x16 (&st)[2], const int (&lo)[2]) {
#pragma unroll
  for (int reg = 0; reg < 16; ++reg) {
    const int keyc = 32 * MI + (reg & 3) + 8 * (reg >> 2);
#pragma unroll
    for (int ni = 0; ni < 2; ++ni) st[ni][reg] = (keyc >= lo[ni]) ? st[ni][reg] : -1e30f;
  }
}
template <int MI, int NIM, bool ROWSEL>
DI void softmax_pv(f32x16 (&st)[2], const unsigned Vs, f32x16 (&ot)[2][2], float (&m)[2], float (&l)[2], const float sc2, const bool (&rowok)[2]) {
  const int lane = ltid() & 63, r = lane & 31, h = lane >> 5;
#pragma unroll
  for (int ni = 0; ni < 2; ++ni) {
    if (!(NIM & (1 << ni))) continue;
    float mx = st[ni][0];
#pragma unroll
    for (int reg = 1; reg < 16; ++reg) mx = fmaxf(mx, st[ni][reg]);
    mx = fmaxf(mx, __shfl_xor(mx, 32));
    if (ROWSEL) mx = rowok[ni] ? mx : -1e30f;
    const float mold = m[ni];
    const float mnew = fmaxf(mold, mx);
    const float alpha = EXP2((mold - mnew) * sc2);
    m[ni] = mnew;
    float mb = -mnew * sc2;
    if (ROWSEL) mb = rowok[ni] ? mb : -__builtin_inff();
    float rs = 0.f;
#pragma unroll
    for (int reg = 0; reg < 16; ++reg) { const float pp = EXP2(fmaf(st[ni][reg], sc2, mb)); st[ni][reg] = pp; rs += pp; }
    rs += __shfl_xor(rs, 32);
    l[ni] = l[ni] * alpha + rs;
    if (__builtin_amdgcn_ballot_w64(mnew > mold) != 0ull) {
#pragma unroll
      for (int di = 0; di < 2; ++di)
#pragma unroll
        for (int reg = 0; reg < 16; ++reg) ot[di][ni][reg] *= alpha;
    }
  }
#pragma unroll
  for (int s = 0; s < 2; ++s) {
    bf16x8 pf[2], vf[2];
#pragma unroll
    for (int ni = 0; ni < 2; ++ni) {
      if (!(NIM & (1 << ni))) continue;
      u32x4 pk;
#pragma unroll
      for (int i = 0; i < 4; ++i) pk[i] = pk2(st[ni][8 * s + 2 * i], st[ni][8 * s + 2 * i + 1]);
      pf[ni] = __builtin_bit_cast(bf16x8, pk);
    }
#pragma unroll
    for (int di = 0; di < 2; ++di) {
      const int d = 32 * di + r;
      const int sw = (d >> 1) & 7;
      const u32x2 lo = *LDSP(u32x2, Vs + d * 128 + (((4 * MI + 2 * s) ^ sw) << 4) + 8 * h);
      const u32x2 hi = *LDSP(u32x2, Vs + d * 128 + (((4 * MI + 2 * s + 1) ^ sw) << 4) + 8 * h);
      u32x4 vv; vv[0] = lo[0]; vv[1] = lo[1]; vv[2] = hi[0]; vv[3] = hi[1];
      vf[di] = __builtin_bit_cast(bf16x8, vv);
    }
#pragma unroll
    for (int di = 0; di < 2; ++di)
#pragma unroll
      for (int ni = 0; ni < 2; ++ni)
        if (NIM & (1 << ni)) ot[di][ni] = MFMA(vf[di], pf[ni], ot[di][ni]);
  }
}
template <int NIM, int MODE>
DI void attn_step(const bf16x8 (&QB)[2][4], const unsigned Ks, f32x16 (&ot)[2][2], float (&m)[2], float (&l)[2], const int (&bnd)[2], const bool (&rowok)[2]) {
  {
    f32x16 st[2];
    qk_half<0, NIM>(QB, Ks, st);
    if (MODE == 1) mask_hi<0>(st, bnd);
    if (MODE == 2) mask_lo<0>(st, bnd);
    softmax_pv<0, NIM, MODE == 3>(st, Ks + 8192, ot, m, l, LOG2E, rowok);
  }
  {
    f32x16 st[2];
    qk_half<1, NIM>(QB, Ks, st);
    if (MODE == 1) mask_hi<1>(st, bnd);
    if (MODE == 2) mask_lo<1>(st, bnd);
    softmax_pv<1, NIM, MODE == 3>(st, Ks + 8192, ot, m, l, LOG2E, rowok);
  }
}

DI void fox_item(const Params& p, int l, int item, unsigned lds) {
  char* ws = lptr(p.ws);
  const int bh = item & 7, qt = 63 - (item >> 3);
  const int b = bh >> 2, hd = bh & 3;
  const int q0 = qt * 128;
  const int tid = ltid(), lane = tid & 63, w = tid >> 6, r = lane & 31, h = lane >> 5;
  const u16* kb = (const u16*)(ws + OFF_FK) + (size_t)bh * T_ * 64;
  const u16* vb = (const u16*)(ws + OFF_FVT) + (size_t)bh * 64 * T_;
  const float* flog = (const float*)(ws + OFF_FLOG) + (size_t)b * T_ * 4 + hd;
  const unsigned rq = lds + 32768, ckb = lds + 32768 + 1024, wsum = lds + 32768 + 1024 + 512;
  __syncthreads();
  bf16x8 QB[2][4];
  {
    const u16* qrows = (const u16*)(ws + OFF_FQ) + ((size_t)bh * T_ + q0 + 32 * w) * 64;
#pragma unroll
    for (int ks = 0; ks < 4; ++ks) { QB[0][ks] = *(const bf16x8*)(qrows + (size_t)r * 64 + 16 * ks + 8 * h); QB[1][ks] = QB[0][ks]; }
  }
  {
    float v = (tid < 128) ? flog[(size_t)(q0 + tid) * 4] * LOG2E : 0.f;
#pragma unroll
    for (int o = 1; o < 64; o <<= 1) { const float u = __shfl_up(v, o); if (lane >= o) v += u; }
    if (tid == 63) *LDSP(float, wsum) = v;
    __syncthreads();
    if (w == 1) v += *LDSP(float, wsum);
    if (tid < 128) *LDSP(float, rq + 4 * tid) = v;
  }
  const int nkt = 2 * qt + 2;
  float qkb;
  {
    const float kn = sqrtf(((const float*)(ws + OFF_KN2))[l * 8 + bh]) * 1.02f + 1e-3f;
    float ss = 0.f;
#pragma unroll
    for (int ks = 0; ks < 4; ++ks)
#pragma unroll
      for (int e = 0; e < 8; ++e) { const float qv = bf2f((u16)QB[0][ks][e]); ss = fmaf(qv, qv, ss); }
    ss = xhalf_sum(ss);
    qkb = sqrtf(ss) * kn * LOG2E;
  }
  TileRegs tr;
  float carry = 0.f;
  float cknext = 0.f;
  tile_gload(tr, kb + (size_t)(nkt - 1) * 64 * 64, 64, vb + (size_t)(nkt - 1) * 64, T_);
  __syncthreads();
  tile_swrite(tr, lds);
  if (w == 0) *LDSP(float, ckb + 4 * lane) = *LDSP(float, rq + 4 * (64 + lane));
  __syncthreads();
  f32x16 ot[2][2]; zero_acc(ot);
  float m[2] = {-1e20f, -1e20f}, ls[2] = {0.f, 0.f};
  const float cq = *LDSP(float, rq + 4 * (32 * w + r));
  int cur = 0;
  for (int kt = nkt - 1; kt >= 0; --kt) {
    const bool more = kt > 0;
    if (more) {
      tile_gload(tr, kb + (size_t)(kt - 1) * 64 * 64, 64, vb + (size_t)(kt - 1) * 64, T_);
      if (w == 0) {
        const int ktn = kt - 1 - 2 * qt;
        if (ktn >= 0) cknext = *LDSP(float, rq + 4 * (64 * ktn + lane));
        else {
          const float v = -flog[(size_t)((kt - 1) * 64 + lane) * 4] * LOG2E;
          float inc = v;
#pragma unroll
          for (int o = 1; o < 64; o <<= 1) { const float u = __shfl_down(inc, o); if (lane + o < 64) inc += u; }
          cknext = carry + inc - v;
          carry += __shfl(inc, 0);
        }
      }
    }
    const int ktp = kt - 2 * qt;
    if (ktp <= 0 || w >= 2) {
      const unsigned Ks = lds + cur * 16384;
      const unsigned ck = ckb + cur * 256;
      const bool masked = (ktp == 1) || (ktp == 0 && w < 2);
      if (masked) attn_step1<1, true>(QB, Ks, ot, m, ls, 32 * w + r - 64 * ktp - 4 * h, true, 1.0f, true, cq, ck);
      else attn_step1<0, true>(QB, Ks, ot, m, ls, 0, true, 1.0f, false, cq, ck);
    }
    if (more) {
      tile_swrite(tr, lds + (cur ^ 1) * 16384);
      if (w == 0) *LDSP(float, ckb + 4 * ((cur ^ 1) * 64 + lane)) = cknext;
    }
    if (kt <= 2 * qt && kt > 0 && (kt & 1) == 0) {
      const float cmin = __shfl(cknext, 63);
      if (w == 0 && lane == 0) *LDSP(float, wsum + 16) = cmin;
      __syncthreads();
      const float cm = *LDSP(float, wsum + 16);
      const bool done = (qkb + cq - cm - m[0] < -40.f);
      if (__syncthreads_and(done ? 1 : 0)) break;
    } else {
      __syncthreads();
    }
    cur ^= 1;
  }
  const u16* gate = (const u16*)(ws + OFF_GATE);
  u16* mixed = (u16*)(ws + OFF_MIXED);
  {
    const float il = 1.f / ls[0];
    const size_t mrow = (size_t)(b * T_ + q0 + 32 * w + r) * 1024 + hd * 64;
#pragma unroll
    for (int di = 0; di < 2; ++di)
#pragma unroll
      for (int g4 = 0; g4 < 4; ++g4) {
        const int d = 32 * di + 8 * g4 + 4 * h;
        const u32x2 gv = *(const u32x2*)(gate + mrow + d);
        u32x2 o;
        o[0] = pk2(ot[di][0][4 * g4] * il * bflo(gv[0]), ot[di][0][4 * g4 + 1] * il * bfhi(gv[0]));
        o[1] = pk2(ot[di][0][4 * g4 + 2] * il * bflo(gv[1]), ot[di][0][4 * g4 + 3] * il * bfhi(gv[1]));
        *(u32x2*)(mixed + mrow + d) = o;
      }
  }
}

DI int tl32() { const int t = ltid(); return ((t >> 6) << 3) + ((t & 31) >> 2); }
DI void nsa_flush32(const Params& p, int mode, f32x16 (&ot)[2][2], const float ls0, int b, int g, int tbase, int br) {
  char* ws = lptr(p.ws);
  const int tid_ = ltid(); const int lane = tid_ & 63, r = lane & 31, h = lane >> 5;
  float* osc = (float*)(ws + OFF_OSC);
  const float* ngl = (const float*)(ws + OFF_NGL);
  const u16* gate = (const u16*)(ws + OFF_GATE);
  u16* mixed = (u16*)(ws + OFF_MIXED);
  const int t = tbase + tl32(), hh = r & 3;
  const size_t m = (size_t)b * T_ + t;
  const float gsig = ngl[m * 24 + (g * 4 + hh) * 3 + br];
  const float sc = (ls0 > 0.f) ? gsig / ls0 : 0.f;
  const size_t cb = m * 512 + (g * 4 + hh) * 64;
#pragma unroll
  for (int di = 0; di < 2; ++di)
#pragma unroll
    for (int g4 = 0; g4 < 4; ++g4) {
      const int d = 32 * di + 8 * g4 + 4 * h;
      float4 v = {ot[di][0][4 * g4] * sc, ot[di][0][4 * g4 + 1] * sc, ot[di][0][4 * g4 + 2] * sc, ot[di][0][4 * g4 + 3] * sc};
      if (mode > 0) { const float4 o = *(const float4*)(osc + cb + d); v.x += o.x; v.y += o.y; v.z += o.z; v.w += o.w; }
      if (mode < 2) *(float4*)(osc + cb + d) = v;
      else {
        const size_t mi2 = m * 1024 + 512 + (g * 4 + hh) * 64 + d;
        const u32x2 gv = *(const u32x2*)(gate + mi2);
        u32x2 o; o[0] = pk2(v.x * bflo(gv[0]), v.y * bfhi(gv[0])); o[1] = pk2(v.z * bflo(gv[1]), v.w * bfhi(gv[1]));
        *(u32x2*)(mixed + mi2) = o;
      }
    }
}

DI void nsa_accum32(const Params& p, f32x16 (&osum)[2], const f32x16 (&ot)[2][2], const float ls0, int b, int g, int tbase, int br, bool first) {
  char* ws = lptr(p.ws);
  const int r = ltid() & 31;
  const float* ngl = (const float*)(ws + OFF_NGL);
  const size_t m = (size_t)b * T_ + tbase + tl32();
  const float gsig = ngl[m * 24 + (g * 4 + (r & 3)) * 3 + br];
  const float sc = (ls0 > 0.f) ? gsig / ls0 : 0.f;
#pragma unroll
  for (int di = 0; di < 2; ++di)
#pragma unroll
    for (int k = 0; k < 16; ++k) osum[di][k] = first ? ot[di][0][k] * sc : fmaf(ot[di][0][k], sc, osum[di][k]);
}
DI void nsa_store32(const Params& p, const f32x16 (&osum)[2], int b, int g, int tbase) {
  char* ws = lptr(p.ws);
  const int lane = ltid() & 63, r = lane & 31, h = lane >> 5;
  const u16* gate = (const u16*)(ws + OFF_GATE);
  u16* mixed = (u16*)(ws + OFF_MIXED);
  const size_t m = (size_t)b * T_ + tbase + tl32();
  const size_t base = m * 1024 + 512 + (g * 4 + (r & 3)) * 64;
#pragma unroll
  for (int di = 0; di < 2; ++di)
#pragma unroll
    for (int g4 = 0; g4 < 4; ++g4) {
      const int d = 32 * di + 8 * g4 + 4 * h;
      const u32x2 gv = *(const u32x2*)(gate + base + d);
      u32x2 o;
      o[0] = pk2(osum[di][4 * g4] * bflo(gv[0]), osum[di][4 * g4 + 1] * bfhi(gv[0]));
      o[1] = pk2(osum[di][4 * g4 + 2] * bflo(gv[1]), osum[di][4 * g4 + 3] * bfhi(gv[1]));
      *(u32x2*)(mixed + base + d) = o;
    }
}

DI void nsa_item32(const Params& p, int l, int item, unsigned lds) {
  char* ws = lptr(p.ws);
  const int bg = item & 3, c32 = 255 - (item >> 2);
  const int b = bg >> 1, g = bg & 1;
  const int tbase = 32 * c32, c = c32 >> 1, toff = tbase & 63;
  const int tid = ltid(), lane = tid & 63, w = tid >> 6, r = lane & 31, h = lane >> 5;
  if (tid == 0 && *LDSP(unsigned, lds + 67540 + 4 * (l * 4 + bg)) == 0u) {
    unsigned* dn = (unsigned*)(ws + OFF_BAR) + 3800 + l * 4 + bg;
    while (__hip_atomic_load(dn, __ATOMIC_RELAXED, __HIP_MEMORY_SCOPE_AGENT) < 8u) __builtin_amdgcn_s_sleep(4);
    __builtin_amdgcn_fence(__ATOMIC_ACQUIRE, "agent");
    asm volatile("s_waitcnt vmcnt(0)" ::: "memory");
    *LDSP(unsigned, lds + 67540 + 4 * (l * 4 + bg)) = 1u;
  }
  const unsigned imp = lds + 32768;
  const unsigned selw = lds + 32768 + 16384;
  __syncthreads();
  bf16x8 QB[2][4];
  {
    const u16* qrows = (const u16*)(ws + OFF_NQ) + (((size_t)bg * T_ + tbase) * 4 + 32 * w) * 64;
#pragma unroll
    for (int ks = 0; ks < 4; ++ks) { QB[0][ks] = *(const bf16x8*)(qrows + (size_t)r * 64 + 16 * ks + 8 * h); QB[1][ks] = QB[0][ks]; }
  }
  for (int i = tid; i < 32 * 128; i += 256) *LDSP(float, imp + 4 * i) = 0.f;
  f32x16 ot[2][2];
  f32x16 osum[2];
  float m[2], ls[2];
  const bool rk[2] = {true, true};
  const u16* kcb = (const u16*)(ws + OFF_KCMP) + (size_t)bg * 512 * 64;
  const u16* vcb = (const u16*)(ws + OFF_VCMPT) + (size_t)bg * 64 * 512;
  const int nbc = (2 * c32) / 64 + 1;
  {
    zero_acc(ot); m[0] = m[1] = -1e20f; ls[0] = ls[1] = 0.f;
    tile_pipeline(nbc, lds,
      [&](TileRegs& t, int nb) __attribute__((always_inline)) { tile_gload(t, kcb + (size_t)nb * 64 * 64, 64, vcb + (size_t)nb * 64, 512); },
      [&](int nb, unsigned Ks) __attribute__((always_inline)) {
        const int hb = ((tbase + tl32() - 31) >> 4) - 64 * nb - 4 * h_of();
        if (64 * nb + 63 <= ((tbase - 31) >> 4)) attn_step1<0>(QB, Ks, ot, m, ls, hb, true, LOG2E, nb == 0);
        else attn_step1<1>(QB, Ks, ot, m, ls, hb, true, LOG2E, nb == 0);
      });
    nsa_accum32(p, osum, ot, ls[0], b, g, tbase, 0, true);
  }
  if (c >= 16) {
    const float il0 = (ls[0] > 0.f) ? 1.f / ls[0] : 0.f;
#define IMP_HALF(MI)                                                                               \
      {                                                                                            \
        f32x16 st[2];                                                                              \
        qk_half<MI, 1>(QB, Ks, st);                                                                \
        const int tlv = tl32(); const int hbv = ((tbase + tlv - 31) >> 4) - 64 * nb - 4 * h_of();  \
        _Pragma("unroll") for (int g4 = 0; g4 < 4; ++g4) {                                         \
          float pg[4];                                                                             \
          _Pragma("unroll") for (int e = 0; e < 4; ++e) {                                          \
            const int keyc = 32 * MI + 8 * g4 + e;                                                 \
            float pp = (keyc <= hbv) ? EXP2((st[0][4 * g4 + e] - m[0]) * LOG2E) * il0 : 0.f;       \
            pp += dpp_xor1(pp);                                                                    \
            pp += dpp_xor2(pp);                                                                    \
            pg[e] = pp;                                                                            \
          }                                                                                        \
          if ((r & 3) == g4) {                                                                     \
            const int j = 16 * nb + 8 * MI + 2 * g4 + h;                                           \
            const float G = (pg[0] + pg[1]) + (pg[2] + pg[3]);                                     \
            __hip_atomic_fetch_add(LDSP(float, imp + 4 * (tlv * 128 + j)), G, __ATOMIC_RELAXED, __HIP_MEMORY_SCOPE_WORKGROUP); \
            if (j + 1 < 128) __hip_atomic_fetch_add(LDSP(float, imp + 4 * (tlv * 128 + j + 1)), pg[3], __ATOMIC_RELAXED, __HIP_MEMORY_SCOPE_WORKGROUP); \
          }                                                                                        \
        }                                                                                          \
      }
    tile_pipeline(nbc, lds,
      [&](TileRegs& t, int nb) __attribute__((always_inline)) { tile_gload(t, kcb + (size_t)nb * 64 * 64, 64, vcb + (size_t)nb * 64, 512); },
      [&](int nb, unsigned Ks) __attribute__((always_inline)) {
        IMP_HALF(0)
        IMP_HALF(1)
      });
#undef IMP_HALF
  }
  {
    const int tok = tid >> 3, sub = tid & 7;
    unsigned word;
    if (c < 16) {
      word = 0xffffu;
    } else {
      unsigned key[16];
      word = 0;
#pragma unroll
      for (int i = 0; i < 16; ++i) {
        const int j = 16 * sub + i;
        const float v = *LDSP(float, imp + 4 * (tok * 128 + j));
        const bool cand = (j >= 1) && (j <= c - 2);
        key[i] = cand ? (__float_as_uint(v) + 1u) : 0u;
        if (j == 0 || j == c || j == c - 1) word |= (1u << i);
      }
      unsigned thr = 0;
      for (int bit = 30; bit >= 0; --bit) {
        const unsigned cd = thr | (1u << bit);
        int cnt = 0;
#pragma unroll
        for (int i = 0; i < 16; ++i) cnt += (key[i] >= cd) ? 1 : 0;
        cnt += dpp_xor1i(cnt);
        cnt += dpp_xor2i(cnt);
        cnt += dpp_hmi(cnt);
        if (cnt >= 13) thr = cd;
      }
      int gt = 0, eq = 0;
#pragma unroll
      for (int i = 0; i < 16; ++i) { gt += (key[i] > thr) ? 1 : 0; eq += (key[i] == thr) ? 1 : 0; }
      int gtt = gt; gtt += dpp_xor1i(gtt); gtt += dpp_xor2i(gtt); gtt += dpp_hmi(gtt);
      int eqb = 0;
#pragma unroll
      for (int k = 0; k < 7; ++k) { const int ek = __shfl(eq, (lane & ~7) + k); if (sub > k) eqb += ek; }
      int need = 13 - gtt - eqb;
#pragma unroll
      for (int i = 0; i < 16; ++i) {
        if (key[i] > thr) word |= (1u << i);
        else if (key[i] == thr && thr != 0u) { if (need > 0) word |= (1u << i); --need; }
      }
    }
    *LDSP(u16, selw + 16 * tok + 2 * sub) = (u16)word;
  }
  __syncthreads();
  {
    const u16* kb = (const u16*)(ws + OFF_KS) + (size_t)bg * T_ * 64;
    const u16* vb = (const u16*)(ws + OFF_VST) + (size_t)bg * 64 * T_;
    zero_acc(ot); m[0] = m[1] = -1e20f; ls[0] = ls[1] = 0.f;
    tile_pipeline(c + 1, lds,
      [&](TileRegs& t, int j) __attribute__((always_inline)) { tile_gload(t, kb + (size_t)j * 64 * 64, 64, vb + (size_t)j * 64, T_); },
      [&](int j, unsigned Ks) __attribute__((always_inline)) {
        const bool selb = ((*LDSP(unsigned, selw + 16 * tl32() + 4 * (j >> 5)) >> (j & 31)) & 1u) != 0u;
        if (j == c) {
          attn_step1<1>(QB, Ks, ot, m, ls, toff + tl32() - 4 * h_of(), true, LOG2E, j == 0);
        } else {
          if (__builtin_amdgcn_ballot_w64(selb) != 0ull) attn_step1<3>(QB, Ks, ot, m, ls, 0, selb, LOG2E, j == 0);
        }
        if (PROBE_REP == 7) attn_step1<3>(QB, Ks, ot, m, ls, 0, false, LOG2E, false);
      });
    nsa_accum32(p, osum, ot, ls[0], b, g, tbase, 1, false);
  }
  {
    const u16* kb = (const u16*)(ws + OFF_KW) + (size_t)bg * T_ * 64;
    const u16* vb = (const u16*)(ws + OFF_VWT) + (size_t)bg * 64 * T_;
    zero_acc(ot); m[0] = m[1] = -1e20f; ls[0] = ls[1] = 0.f;
    const int jlo = (c >= 8) ? c - 8 : 0;
    tile_pipeline(c - jlo + 1, lds,
      [&](TileRegs& t, int i) __attribute__((always_inline)) { const int j = c - i; tile_gload(t, kb + (size_t)j * 64 * 64, 64, vb + (size_t)j * 64, T_); },
      [&](int i, unsigned Ks) __attribute__((always_inline)) {
        const int j = c - i;
        const bool diag = (j == c), far = (j == c - 8);
        if (diag) attn_step1<1>(QB, Ks, ot, m, ls, toff + tl32() - 4 * h_of(), true, LOG2E, true);
        else if (far) attn_step1<2>(QB, Ks, ot, m, ls, toff + tl32() + 1 - 4 * h_of(), true, LOG2E, false);
        else attn_step1<0>(QB, Ks, ot, m, ls, 0, true, LOG2E, false);
      });
    nsa_accum32(p, osum, ot, ls[0], b, g, tbase, 2, false);
    nsa_store32(p, osum, b, g, tbase);
  }
}

#define XB_TMO      128
#define XB_XCNT(j)  (256  + 64 * (j))
#define XB_XSUB(j)  (1280 + 64 * (j))
#define XB_XGEN(j)  (2304 + 64 * (j))
#define XB_TOP      3328
#define XB_TOPGEN   3392
#define XCD_BAR_WORDS 3456
#define XB_SPIN_CAP (1u << 18)
#define LAS __attribute__((address_space(3)))

__device__ __forceinline__ unsigned xb_ld(unsigned* p)              { return __hip_atomic_load(p, __ATOMIC_RELAXED, __HIP_MEMORY_SCOPE_AGENT); }
__device__ __forceinline__ unsigned xb_add(unsigned* p, unsigned v) { return __hip_atomic_fetch_add(p, v, __ATOMIC_RELAXED, __HIP_MEMORY_SCOPE_AGENT); }
__device__ __forceinline__ unsigned xb_xcc_id() { return (unsigned)__builtin_amdgcn_s_getreg((3 << 11) | 20) & 0xFu; }
#define XB_SPIN(cond, bar) do { unsigned _sp = 0; while (cond) { __builtin_amdgcn_s_sleep(1); \
    if ((++_sp & 255u) == 0u) { if (xb_ld(&(bar)[XB_TMO])) break; if (_sp > XB_SPIN_CAP) { atomicAdd(&(bar)[XB_TMO], 1u); break; } } } } while (0)

struct XcdBarrier {
    unsigned* bar; unsigned x;
    volatile LAS unsigned* st;
};

__device__ __forceinline__ XcdBarrier xcd_barrier_post(unsigned* bar, volatile LAS unsigned* st) {
    XcdBarrier b; b.bar = bar; b.x = xb_xcc_id(); b.st = st;
    if (threadIdx.x == 0) (void)xb_add(&bar[XB_XCNT(b.x)], 1u);
    return b;
}
__device__ __forceinline__ void xcd_barrier_complete(unsigned* bar, unsigned x, unsigned& nloc, unsigned& nx) {
    const unsigned G = gridDim.x * gridDim.y * gridDim.z;
    unsigned sum, cnt, mine, sp = 0u;
    for (;;) {
        sum = 0u; cnt = 0u; mine = 0u;
#pragma unroll
        for (unsigned j = 0; j < 16; ++j) { const unsigned c = xb_ld(&bar[XB_XCNT(j)]); sum += c; cnt += (c > 0u) ? 1u : 0u; mine = (j == x) ? c : mine; }
        if (sum == G) break;
        __builtin_amdgcn_s_sleep(1);
        if ((++sp & 255u) == 0u) { if (xb_ld(&bar[XB_TMO])) break; if (sp > XB_SPIN_CAP) { atomicAdd(&bar[XB_TMO], 1u); break; } }
    }
    nloc = mine > 0u ? mine : 1u; nx = cnt > 0u ? cnt : 1u;
}

__device__ __forceinline__ void xcd_barrier(const XcdBarrier& b) {
    asm volatile("s_waitcnt vmcnt(0)" ::: "memory");
    __syncthreads();
    if (threadIdx.x == 0) {
        unsigned* bar = b.bar;
        __builtin_amdgcn_s_waitcnt(0);
        unsigned nloc = b.st[0], nx = b.st[1];
        if (nloc == 0u) { xcd_barrier_complete(bar, b.x, nloc, nx); b.st[0] = nloc; b.st[1] = nx; }
        const unsigned old = xb_add(&bar[XB_XSUB(b.x)], 1u);
        const unsigned gen = old / nloc;
        if (old + 1u == (gen + 1u) * nloc) {
            __builtin_amdgcn_fence(__ATOMIC_RELEASE, "agent");
            asm volatile("s_waitcnt vmcnt(0)" ::: "memory");
            const unsigned og = xb_add(&bar[XB_TOP], 1u);
            const unsigned tg = og / nx;
            if (og + 1u == (tg + 1u) * nx) xb_add(&bar[XB_TOPGEN], 1u);
            else XB_SPIN(xb_ld(&bar[XB_TOPGEN]) == tg, bar);
            __builtin_amdgcn_fence(__ATOMIC_ACQUIRE, "agent");
            xb_add(&bar[XB_XGEN(b.x)], 1u);
            asm volatile("s_waitcnt vmcnt(0)" ::: "memory");
        } else {
            XB_SPIN(xb_ld(&bar[XB_XGEN(b.x)]) == gen, bar);
            __builtin_amdgcn_fence(__ATOMIC_ACQUIRE, "agent");
            asm volatile("s_waitcnt vmcnt(0)" ::: "memory");
        }
    }
    __syncthreads();
}


__global__ void __launch_bounds__(256, 2) fwd_megakernel(Params p) {
  cg::grid_group grid = cg::this_grid();
  __shared__ __attribute__((aligned(16))) char lds_arr[LDS_BYTES];
  const unsigned lds = (unsigned)(size_t)lds_arr;
  if (threadIdx.x < 16) *LDSP(unsigned, lds + 67520 + 4 * threadIdx.x) = 0u;
  __syncthreads();
  const XcdBarrier xb = xcd_barrier_post((unsigned*)(p.ws + OFF_BAR), (volatile LAS unsigned*)(lds + 67520));
#define GSYNC() xcd_barrier(xb)
  if (gridDim.x == 0x7fffffffu) grid.sync();
  const int G = gridDim.x, bid = blockIdx.x;
  for (int whole = 0; whole < (PROBE_REP == 6 ? 2 : 1); ++whole) {
  if (whole) GSYNC();
  for (int rep0 = 0; rep0 < (PROBE_REP == 4 ? 2 : 1); ++rep0) {
  for (int i = bid; i < 2 * P0_PER_LAYER; i += G) phase0_item(p, i, lds);
  for (int i = G - 1 - bid; i < 32; i += G) cbias_item(p, i, lds);
  if (bid == 0 && threadIdx.x < 128) ((unsigned*)(p.ws + OFF_KN2))[threadIdx.x] = 0u;
  for (int i = bid; i < 256; i += G) rope_item(p, i);
  for (int i = bid; i < BT / 4; i += G) norm_item(p.x, p.norm_g, (u16*)(p.ws + OFF_H), nullptr, i, nullptr, nullptr, nullptr, nullptr);
  }
  GSYNC();
  for (int l = 0; l < 2; ++l) {
    for (int rep = 0; rep < (PROBE_REP == 1 ? 2 : 1); ++rep) {
    if (rep) GSYNC();
    if (G == 512 && false) {
      const int xcd = bid & 7, lb = bid >> 3, y = xcd >> 1;
      for (int k = lb; k < 448; k += 64) {
        int mt, nt;
        if ((xcd & 1) == 0) {
          if (k < 256) { mt = k >> 2; nt = 7 * y + (k & 3); } else { const int k2 = k - 256; mt = 64 + k2 / 3; nt = 7 * y + k2 % 3; }
        } else {
          if (k < 192) { mt = k / 3; nt = 7 * y + 4 + k % 3; } else { const int k2 = k - 192; mt = 64 + (k2 >> 2); nt = 7 * y + 3 + (k2 & 3); }
        }
        gemm1_item(p, l, mt * 29 + nt, lds);
      }
    } else {
      for (int i = bid; i < 128 * 28; i += G) gemm1_item(p, l, (i / 28) * 29 + (i % 28), lds);
    }
    for (int i = bid; i < 128; i += G) tail_item(p, l, i);
    }
    GSYNC();
    {
      int i = bid;
      unsigned* qctr = (unsigned*)(p.ws + OFF_BAR) + 3600 + 64 * l;
      while (i < 64 + 512 + 256 + 1024) {
        if (i < 64) {
          compress_item(p, l, i, lds);
        } else if (i < 576) {
          fox_item(p, l, i - 64, lds);
        } else if (i < 832) {
          conv_item(p, l, i - 576, lds);
        } else {
          nsa_item32(p, l, i - 832, lds);
        }
        __syncthreads();
        if (threadIdx.x == 0) *LDSP(unsigned, lds + 67536) = (unsigned)G + __hip_atomic_fetch_add(qctr, 1u, __ATOMIC_RELAXED, __HIP_MEMORY_SCOPE_AGENT);
        __syncthreads();
        i = (int)*LDSP(unsigned, lds + 67536);
      }
    }
    GSYNC();
    if (G == 512) {
      const int xcd = bid & 7, lb = bid >> 3;
      for (int k = lb; k < 128; k += 64) gemm2_item(p, l, xcd * 128 + k, lds);
    } else {
      for (int i = bid; i < 1024; i += G) gemm2_item(p, l, i, lds);
    }
    GSYNC();
    if (l == 0) for (int i = bid; i < BT / 4; i += G) norm_item(p.out, p.norm_g + 1024, (u16*)(p.ws + OFF_H), nullptr, i, nullptr, nullptr, nullptr, nullptr);
    else for (int i = bid; i < BT / 4; i += G) norm_item(p.out, p.final_g, nullptr, p.out, i, nullptr, nullptr, nullptr, nullptr);
    if (l == 0) GSYNC();
  }
  }
}

__global__ void zero_mixed(unsigned* m, size_t n) {
  size_t i = (size_t)blockIdx.x * blockDim.x + threadIdx.x;
  if (i < n) m[i] = 0;
}

extern "C" void kernel_launch(void* const* d_in, const int* in_sizes, int n_in, void* d_out,
                              int out_size, void* d_ws, size_t ws_size, hipStream_t stream) {
  static int grid_blocks = 0;
  if (!grid_blocks) {
    int dev = 0, cus = 0, per_cu = 0;
    (void)hipGetDevice(&dev);
    (void)hipDeviceGetAttribute(&cus, hipDeviceAttributeMultiprocessorCount, dev);
    (void)hipOccupancyMaxActiveBlocksPerMultiprocessor(&per_cu, fwd_megakernel, 256, 0);
    if (per_cu > 2) per_cu = 2;
    if (per_cu < 1) per_cu = 1;
    grid_blocks = cus * per_cu;
  }
  Params p{};
  p.x = (const float*)d_in[0]; p.norm_g = (const float*)d_in[1]; p.w_in = (const float*)d_in[2]; p.fox_b = (const float*)d_in[3];
  p.conv_w = (const float*)d_in[4]; p.conv_b = (const float*)d_in[5]; p.conv_ln_g = (const float*)d_in[6]; p.conv_ln_b = (const float*)d_in[7];
  p.conv_pw = (const float*)d_in[8]; p.cmp_pe_k = (const float*)d_in[9]; p.cmp_pe_v = (const float*)d_in[10];
  p.cmp_k_w1 = (const float*)d_in[11]; p.cmp_k_w2 = (const float*)d_in[12]; p.cmp_v_w1 = (const float*)d_in[13]; p.cmp_v_w2 = (const float*)d_in[14];
  p.w_out = (const float*)d_in[15]; p.final_g = (const float*)d_in[16];
  p.out = (float*)d_out; p.ws = (char*)d_ws;
#if !(EN_FOX && EN_NSA)
  {
    size_t n = (size_t)BT * 1024 / 2;
    zero_mixed<<<(unsigned)((n + 255) / 256), 256, 0, stream>>>((unsigned*)((char*)d_ws + OFF_MIXED), n);
  }
#endif
  (void)hipMemsetAsync((char*)d_ws + OFF_BAR, 0, 16384, stream);
  void* args[] = {&p};
  hipError_t e = hipLaunchCooperativeKernel((void*)fwd_megakernel, dim3(grid_blocks), dim3(256), args, 0, stream);
  if (e != hipSuccess) fprintf(stderr, "cooperative launch failed: %s (grid %d)\n", hipGetErrorString(e), grid_blocks);
}
```

```cpp
#include <hip/hip_runtime.h>
#include <hip/hip_cooperative_groups.h>
#include <cstdio>
namespace cg = cooperative_groups;

#ifndef PROBE_REP
#define PROBE_REP 0
#endif
#ifndef EN_FOX
#define EN_FOX 1
#endif
#ifndef EN_NSA
#define EN_NSA 1
#endif

typedef unsigned short u16;
using bf16x8 = __attribute__((ext_vector_type(8))) short;
using f32x16 = __attribute__((ext_vector_type(16))) float;
using u32x4 = __attribute__((ext_vector_type(4))) unsigned;
using u32x2 = __attribute__((ext_vector_type(2))) unsigned;
using f32x4 = __attribute__((ext_vector_type(4))) float;
typedef __attribute__((ext_vector_type(2))) __bf16 bf2_t;
#define DI __device__ __forceinline__
#define EXP2(x) __builtin_amdgcn_exp2f(x)
#define MFMA(a, b, c) __builtin_amdgcn_mfma_f32_32x32x16_bf16((a), (b), (c), 0, 0, 0)

constexpr int T_ = 8192;
constexpr int BT = 16384;
constexpr int NPAD = 3712;
constexpr float LOG2E = 1.4426950408889634f;
constexpr int LDS_BYTES = 67584;

constexpr size_t SZ_WINT = (size_t)NPAD * 1024 * 2;
constexpr size_t OFF_WINT = 0;
constexpr size_t OFF_WOUTT = OFF_WINT + 2 * SZ_WINT;
constexpr size_t OFF_PWT = OFF_WOUTT + 2 * (size_t)1024 * 1024 * 2;
constexpr size_t OFF_W1T = OFF_PWT + 2 * (size_t)256 * 256 * 2;
constexpr size_t OFF_W2T = OFF_W1T + 4 * (size_t)256 * 2048 * 2;
constexpr size_t OFF_CBIAS = OFF_W2T + 4 * (size_t)128 * 256 * 2;
constexpr size_t OFF_ROPE = OFF_CBIAS + 4 * 256 * 4;
constexpr size_t OFF_H = OFF_ROPE + (size_t)8192 * 8 * 2 * 4;
constexpr size_t OFF_OSC = OFF_H;
constexpr size_t OFF_FQ = OFF_H + (size_t)BT * 1024 * 2;
constexpr size_t OFF_FK = OFF_FQ + (size_t)BT * 256 * 2;
constexpr size_t OFF_FVT = OFF_FK + (size_t)BT * 256 * 2;
constexpr size_t OFF_FLOG = OFF_FVT + (size_t)BT * 256 * 2;
constexpr size_t OFF_GATE = OFF_FLOG + (size_t)BT * 4 * 4;
constexpr size_t OFF_GLU = OFF_GATE + (size_t)BT * 1024 * 2;
constexpr size_t OFF_NQ = OFF_GLU + (size_t)BT * 512 * 2;
constexpr size_t OFF_KC = OFF_NQ + (size_t)BT * 512 * 2;
constexpr size_t SZ_KV = (size_t)BT * 128 * 2;
constexpr size_t OFF_VC = OFF_KC + SZ_KV;
constexpr size_t OFF_KS = OFF_VC + SZ_KV;
constexpr size_t OFF_VST = OFF_KS + SZ_KV;
constexpr size_t OFF_KW = OFF_VST + SZ_KV;
constexpr size_t OFF_VWT = OFF_KW + SZ_KV;
constexpr size_t OFF_NGL = OFF_VWT + SZ_KV;
constexpr size_t OFF_KCMP = OFF_NGL + (size_t)BT * 24 * 4;
constexpr size_t OFF_VCMPT = OFF_KCMP + (size_t)4 * 512 * 64 * 2;
constexpr size_t OFF_HID = OFF_VCMPT + (size_t)4 * 512 * 64 * 2;
constexpr size_t OFF_CONVA = OFF_HID + (size_t)32 * 128 * 256 * 2;
constexpr size_t OFF_MIXED = OFF_CONVA + (size_t)BT * 256 * 2;
constexpr size_t OFF_KN2 = OFF_MIXED + (size_t)BT * 1024 * 2;
constexpr size_t OFF_CNT = OFF_KN2 + 256;
constexpr size_t OFF_BAR = OFF_CNT + 256;
constexpr size_t OFF_WTAIL = OFF_BAR + 16384;
constexpr size_t WS_TOTAL = OFF_WTAIL + (size_t)2 * 32 * 1024 * 4;
static_assert(WS_TOTAL <= (size_t)256 * 1024 * 1024, "ws too large");

struct Params {
  const float* x; const float* norm_g; const float* w_in; const float* fox_b; const float* conv_w; const float* conv_b;
  const float* conv_ln_g; const float* conv_ln_b; const float* conv_pw; const float* cmp_pe_k; const float* cmp_pe_v;
  const float* cmp_k_w1; const float* cmp_k_w2; const float* cmp_v_w1; const float* cmp_v_w2; const float* w_out; const float* final_g;
  float* out; char* ws;
};

DI int ltid() { int t = threadIdx.x; asm volatile("" : "+v"(t)); return t; }
DI char* lptr(char* q) { int z = 0; asm volatile("" : "+s"(z)); return q + z; }
#define LDSP(T, a) ((__attribute__((address_space(3))) T*)(a))
DI int tl_of(int ni) { const int t = ltid(); return ((t >> 6) << 4) + 8 * ni + ((t & 31) >> 2); }
DI int h_of() { return (ltid() >> 5) & 1; }
DI u16 f2bf(float x) { __bf16 b = (__bf16)x; return __builtin_bit_cast(u16, b); }
DI unsigned pk2(float x, float y) { bf2_t v; v[0] = (__bf16)x; v[1] = (__bf16)y; return __builtin_bit_cast(unsigned, v); }
DI float bf2f(u16 v) { return __uint_as_float(((unsigned)v) << 16); }
DI float bflo(unsigned v) { return __uint_as_float(v << 16); }
DI float bfhi(unsigned v) { return __uint_as_float(v & 0xffff0000u); }
DI int vperm16(int t) { return (t & ~15) | (t & 3) | ((t & 4) << 1) | ((t & 8) >> 1); }
DI int crow(int reg, int h) { return (reg & 3) + 8 * (reg >> 2) + 4 * h; }
DI float siluf(float x) { return x / (1.f + __expf(-x)); }
DI float sigmf(float x) { return 1.f / (1.f + __expf(-x)); }
DI float geluf(float x) { return 0.5f * x * (1.f + tanhf(0.7978845608028654f * (x + 0.044715f * x * x * x))); }
DI int swz(int row, int chunk) { return row * 128 + ((chunk ^ ((row >> 1) & 7)) << 4); }
DI void zero_acc(f32x16 (&a)[2][2]) {
#pragma unroll
  for (int i = 0; i < 2; ++i)
#pragma unroll
    for (int j = 0; j < 2; ++j)
#pragma unroll
      for (int k = 0; k < 16; ++k) a[i][j][k] = 0.f;
}

DI int swz32(int row, int chunk) { return row * 64 + ((chunk ^ ((row >> 2) & 3)) << 4); }
template <bool SWAP>
DI void gemm_tile(const u16* __restrict__ A, long lda, const u16* __restrict__ B, long ldb, int K, unsigned lds, f32x16 (&acc)[2][2]) {
  const int tid = ltid(), lane = tid & 63, w = tid >> 6, wr = w >> 1, wc = w & 1, r = lane & 31, h = lane >> 5;
  zero_acc(acc);
  const int lrow = tid >> 2, lch = tid & 3;
  const u16* ga = A + (long)lrow * lda + lch * 8;
  const u16* gb = B + (long)lrow * ldb + lch * 8;
  const long a64 = 64 * lda, b64 = 64 * ldb;
  const int n2 = K >> 6;
  u32x4 a0[4], a1[4], b0[4], b1[4];
#define GLOAD(S, J) { S[0] = *(const u32x4*)(ga + (J) * 32); S[1] = *(const u32x4*)(ga + a64 + (J) * 32); S[2] = *(const u32x4*)(gb + (J) * 32); S[3] = *(const u32x4*)(gb + b64 + (J) * 32); }
#define SWRITE(S, OFF) { const unsigned bb = lds + (OFF); *LDSP(u32x4, bb + swz32(lrow, lch)) = S[0]; *LDSP(u32x4, bb + swz32(lrow + 64, lch)) = S[1]; \
                         *LDSP(u32x4, bb + 8192 + swz32(lrow, lch)) = S[2]; *LDSP(u32x4, bb + 8192 + swz32(lrow + 64, lch)) = S[3]; }
#define COMPUTE(OFF) { const unsigned As = lds + (OFF); const unsigned Bs = As + 8192; \
    _Pragma("unroll") for (int ks = 0; ks < 2; ++ks) { bf16x8 af[2], bf[2]; \
      _Pragma("unroll") for (int i = 0; i < 2; ++i) { af[i] = *LDSP(bf16x8, As + swz32(64 * wr + 32 * i + r, 2 * ks + h)); bf[i] = *LDSP(bf16x8, Bs + swz32(64 * wc + 32 * i + r, 2 * ks + h)); } \
      _Pragma("unroll") for (int mi = 0; mi < 2; ++mi) _Pragma("unroll") for (int ni = 0; ni < 2; ++ni) { \
        if (SWAP) acc[mi][ni] = MFMA(bf[ni], af[mi], acc[mi][ni]); else acc[mi][ni] = MFMA(af[mi], bf[ni], acc[mi][ni]); } } }
  GLOAD(a0, 0)
  GLOAD(a1, 1)
  if (n2 > 1) { GLOAD(b0, 2) GLOAD(b1, 3) }
  __syncthreads();
  SWRITE(a0, 0)
  SWRITE(a1, 16384)
  if (n2 > 2) { GLOAD(a0, 4) GLOAD(a1, 5) }
  __syncthreads();
  int t = 0;
  while (true) {
    COMPUTE(0)
    COMPUTE(16384)
    if (t + 1 < n2) { SWRITE(b0, 32768) SWRITE(b1, 49152) }
    if (t + 3 < n2) { GLOAD(b0, 2 * (t + 3)) GLOAD(b1, 2 * (t + 3) + 1) }
    __syncthreads();
    if (++t >= n2) break;
    COMPUTE(32768)
    COMPUTE(49152)
    if (t + 1 < n2) { SWRITE(a0, 0) SWRITE(a1, 16384) }
    if (t + 3 < n2) { GLOAD(a0, 2 * (t + 3)) GLOAD(a1, 2 * (t + 3) + 1) }
    __syncthreads();
    if (++t >= n2) break;
  }
#undef GLOAD
#undef SWRITE
#undef COMPUTE
}

DI int win_srccol(int n) {
  if (n < 768) return n;
  if (n < 3072) return n + 4;
  if (n < 3584) return n + 28;
  int i = n - 3584;
  if (i < 4) return 768 + i;
  if (i < 28) return 3076 + (i - 4);
  return -1;
}

DI void transpose_tile(const float* __restrict__ src, int ld, int K, int mapkind, int nsrc, u16* __restrict__ dst, int k0, int n0, unsigned lds) {
  const int tid = ltid(), j = tid & 63, i0 = tid >> 6;
  const int n = n0 + j;
  const int sc = mapkind ? win_srccol(n) : (n < nsrc ? n : -1);
  float v[16];
#pragma unroll
  for (int it = 0; it < 16; ++it) v[it] = (sc >= 0) ? src[(size_t)(k0 + i0 + 4 * it) * ld + sc] : 0.f;
  __syncthreads();
#pragma unroll
  for (int it = 0; it < 16; ++it) *LDSP(float, lds + 4 * ((i0 + 4 * it) * 65 + j)) = v[it];
  __syncthreads();
  const int jn = tid >> 2, kc = (tid & 3) * 16;
  u32x4 o0, o1;
#pragma unroll
  for (int e = 0; e < 4; ++e) {
    o0[e] = pk2(*LDSP(float, lds + 4 * ((kc + 2 * e) * 65 + jn)), *LDSP(float, lds + 4 * ((kc + 2 * e + 1) * 65 + jn)));
    o1[e] = pk2(*LDSP(float, lds + 4 * ((kc + 8 + 2 * e) * 65 + jn)), *LDSP(float, lds + 4 * ((kc + 8 + 2 * e + 1) * 65 + jn)));
  }
  u16* dp = dst + (size_t)(n0 + jn) * K + k0 + kc;
  *(u32x4*)dp = o0;
  *(u32x4*)(dp + 8) = o1;
}

constexpr int P0_PER_LAYER = 928 + 256 + 16 + 256 + 16;
DI void phase0_item(const Params& p, int idx, unsigned lds) {
  const int l = idx / P0_PER_LAYER;
  int r = idx % P0_PER_LAYER;
  char* ws = lptr(p.ws);
  if (r < 928) {
    transpose_tile(p.w_in + (size_t)l * 1024 * 3612, 3612, 1024, 1, 0, (u16*)(ws + OFF_WINT + l * SZ_WINT), (r % 16) * 64, (r / 16) * 64, lds);
    return;
  }
  r -= 928;
  if (r < 256) {
    transpose_tile(p.w_out + (size_t)l * 1024 * 1024, 1024, 1024, 0, 1024, (u16*)(ws + OFF_WOUTT) + (size_t)l * 1024 * 1024, (r % 16) * 64, (r / 16) * 64, lds);
    return;
  }
  r -= 256;
  if (r < 16) {
    transpose_tile(p.conv_pw + (size_t)l * 256 * 256, 256, 256, 0, 256, (u16*)(ws + OFF_PWT) + (size_t)l * 256 * 256, (r % 4) * 64, (r / 4) * 64, lds);
    return;
  }
  r -= 16;
  if (r < 256) {
    const int kv = r >> 7; r &= 127;
    const float* src = (kv ? p.cmp_v_w1 : p.cmp_k_w1) + (size_t)l * 2048 * 256;
    transpose_tile(src, 256, 2048, 0, 256, (u16*)(ws + OFF_W1T) + (size_t)(l * 2 + kv) * 256 * 2048, (r % 32) * 64, (r / 32) * 64, lds);
    return;
  }
  r -= 256;
  {
    const int kv = r >> 3; r &= 7;
    const float* src = (kv ? p.cmp_v_w2 : p.cmp_k_w2) + (size_t)l * 256 * 64;
    transpose_tile(src, 64, 256, 0, 64, (u16*)(ws + OFF_W2T) + (size_t)(l * 2 + kv) * 128 * 256, (r % 4) * 64, (r / 4) * 64, lds);
  }
}

DI void cbias_item(const Params& p, int item, unsigned lds) {
  const int idx = item >> 3, ng = item & 7;
  const int l = idx >> 1, kv = idx & 1;
  const float* pe = (kv ? p.cmp_pe_v : p.cmp_pe_k) + (size_t)l * 2048;
  const float* w1 = (kv ? p.cmp_v_w1 : p.cmp_k_w1) + (size_t)l * 2048 * 256;
  const int tid = ltid(), nn = tid & 31, ksl = tid >> 5;
  const int n = ng * 32 + nn;
  float s0 = 0.f, s1 = 0.f, s2 = 0.f, s3 = 0.f;
  const float* wp = w1 + (size_t)(ksl * 256) * 256 + n;
  const float* pp = pe + ksl * 256;
#pragma unroll 4
  for (int i = 0; i < 256; i += 4) {
    s0 = fmaf(pp[i], wp[(size_t)i * 256], s0);
    s1 = fmaf(pp[i + 1], wp[(size_t)(i + 1) * 256], s1);
    s2 = fmaf(pp[i + 2], wp[(size_t)(i + 2) * 256], s2);
    s3 = fmaf(pp[i + 3], wp[(size_t)(i + 3) * 256], s3);
  }
  __syncthreads();
  *LDSP(float, lds + 4 * tid) = (s0 + s1) + (s2 + s3);
  __syncthreads();
  if (tid < 32) {
    float t = 0.f;
#pragma unroll
    for (int k = 0; k < 8; ++k) t += *LDSP(float, lds + 4 * (k * 32 + tid));
    ((float*)(p.ws + OFF_CBIAS))[idx * 256 + n] = t;
  }
}

DI void rope_item(const Params& p, int idx) {
  const int e = idx * 256 + ltid();
  const int pos = e >> 3, i = e & 7;
  const float inv = powf(500000.0f, -(float)(2 * i) / 16.0f);
  const float ang = (float)pos * inv;
  float2 cs; cs.x = cosf(ang); cs.y = sinf(ang);
  ((float2*)(p.ws + OFF_ROPE))[e] = cs;
}

DI void wtail_item(const Params& p, int item) {
  const int l = item >> 5, j = item & 31;
  float* dst = (float*)(p.ws + OFF_WTAIL) + (size_t)item * 1024;
  const int tid = ltid();
  const int col = (j < 4) ? 768 + j : 3076 + (j - 4);
#pragma unroll
  for (int i = 0; i < 4; ++i) {
    const int k = tid + 256 * i;
    dst[k] = (j < 28) ? p.w_in[((size_t)l * 1024 + k) * 3612 + col] : 0.f;
  }
}

DI void norm_item(const float* __restrict__ src, const float* __restrict__ g, u16* dstb, float* dstf, int item,
                  const float* __restrict__ wt, const float* __restrict__ foxb, float* flog, float* ngl) {
  const int tid_ = ltid(); const int lane = tid_ & 63, w = tid_ >> 6;
  const int row = item * 4 + w;
  const float4* s4 = (const float4*)(src + (size_t)row * 1024);
  float4 v[4];
  float ss = 0.f;
#pragma unroll
  for (int i = 0; i < 4; ++i) { v[i] = s4[lane + 64 * i]; ss += v[i].x * v[i].x + v[i].y * v[i].y + v[i].z * v[i].z + v[i].w * v[i].w; }
#pragma unroll
  for (int o = 32; o > 0; o >>= 1) ss += __shfl_xor(ss, o);
  const float rs = rsqrtf(ss * (1.0f / 1024.0f) + 1e-6f);
#pragma unroll
  for (int i = 0; i < 4; ++i) {
    float4 gg = ((const float4*)g)[lane + 64 * i];
    float4 o = {v[i].x * rs * gg.x, v[i].y * rs * gg.y, v[i].z * rs * gg.z, v[i].w * rs * gg.w};
    v[i] = o;
    if (dstb) {
      u32x2 pk; pk[0] = pk2(o.x, o.y); pk[1] = pk2(o.z, o.w);
      *(u32x2*)(dstb + (size_t)row * 1024 + (lane + 64 * i) * 4) = pk;
    } else {
      ((float4*)(dstf + (size_t)row * 1024))[lane + 64 * i] = o;
    }
  }
  if (wt) {
    float a[32];
#pragma unroll
    for (int j = 0; j < 32; ++j) {
      float acc = 0.f;
      if (j < 28) {
#pragma unroll
        for (int i = 0; i < 4; ++i) {
          const float4 ww = ((const float4*)(wt + (size_t)j * 1024))[lane + 64 * i];
          acc = fmaf(v[i].x, ww.x, acc); acc = fmaf(v[i].y, ww.y, acc); acc = fmaf(v[i].z, ww.z, acc); acc = fmaf(v[i].w, ww.w, acc);
        }
      }
      a[j] = acc;
    }
#pragma unroll
    for (int t = 0; t < 16; ++t) { const bool up = (lane & 32) != 0; const float send = up ? a[t] : a[t + 16]; const float keep = up ? a[t + 16] : a[t]; a[t] = keep + __shfl_xor(send, 32); }
#pragma unroll
    for (int t = 0; t < 8; ++t) { const bool up = (lane & 16) != 0; const float send = up ? a[t] : a[t + 8]; const float keep = up ? a[t + 8] : a[t]; a[t] = keep + __shfl_xor(send, 16); }
#pragma unroll
    for (int t = 0; t < 4; ++t) { const bool up = (lane & 8) != 0; const float send = up ? a[t] : a[t + 4]; const float keep = up ? a[t + 4] : a[t]; a[t] = keep + __shfl_xor(send, 8); }
#pragma unroll
    for (int t = 0; t < 2; ++t) { const bool up = (lane & 4) != 0; const float send = up ? a[t] : a[t + 2]; const float keep = up ? a[t + 2] : a[t]; a[t] = keep + __shfl_xor(send, 4); }
    { const bool up = (lane & 2) != 0; const float send = up ? a[0] : a[1]; const float keep = up ? a[1] : a[0]; a[0] = keep + __shfl_xor(send, 2); }
    a[0] += __shfl_xor(a[0], 1);
    const int col = lane >> 1;
    if ((lane & 1) == 0) {
      const float val = a[0];
      if (col < 4) {
        const float xx = val + foxb[col];
        flog[(size_t)row * 4 + col] = fminf(xx, 0.f) - __logf(1.f + __expf(-fabsf(xx)));
      } else if (col < 28) {
        ngl[(size_t)row * 24 + (col - 4)] = sigmf(val);
      }
    }
  }
}

DI void gemm1_item(const Params& p, int l, int item, unsigned lds) {
  const int mt = item / 29, nt = item % 29;
  const int m0 = mt * 128;
  char* ws = lptr(p.ws);
  const u16* A = (const u16*)(ws + OFF_H) + (size_t)m0 * 1024;
  const u16* B = (const u16*)(ws + OFF_WINT + l * SZ_WINT) + (size_t)nt * 128 * 1024;
  const bool swap = (nt == 4 || nt == 5 || nt == 21 || nt == 23);
  f32x16 acc[2][2];
  if (swap) gemm_tile<true>(A, 1024, B, 1024, 1024, lds, acc);
  else gemm_tile<false>(A, 1024, B, 1024, 1024, lds, acc);
  const int tid = ltid(), lane = tid & 63, w = tid >> 6, wr = w >> 1, wc = w & 1, r = lane & 31, h = lane >> 5;
  const int b = m0 >> 13, t0 = m0 & 8191;
  if (swap) {
    u16* base;
    if (nt == 4 || nt == 5) { const int head = (nt - 4) * 2 + wc; base = (u16*)(ws + OFF_FVT) + (size_t)(b * 4 + head) * 64 * T_; }
    else if (nt == 21) base = (u16*)(ws + OFF_VST) + (size_t)(b * 2 + wc) * 64 * T_;
    else base = (u16*)(ws + OFF_VWT) + (size_t)(b * 2 + wc) * 64 * T_;
#pragma unroll
    for (int mi = 0; mi < 2; ++mi)
#pragma unroll
      for (int ni = 0; ni < 2; ++ni)
#pragma unroll
        for (int reg = 0; reg < 16; ++reg) {
          const int d = 32 * ni + crow(reg, h);
          const int t = vperm16(t0 + 64 * wr + 32 * mi + r);
          base[(size_t)d * T_ + t] = f2bf(acc[mi][ni][reg]);
        }
    return;
  }
  if (nt < 4 || nt == 18 || nt == 19 || nt == 20 || nt == 22 || (nt >= 14 && nt <= 17)) {
    u16* base; long rstride; float scale = 1.f; bool rope = false;
    if (nt < 2) { base = (u16*)(ws + OFF_FQ) + ((size_t)(b * 4 + nt * 2 + wc) * T_ + t0) * 64; rstride = 64; scale = 0.125f; }
    else if (nt < 4) { base = (u16*)(ws + OFF_FK) + ((size_t)(b * 4 + (nt - 2) * 2 + wc) * T_ + t0) * 64; rstride = 64; }
    else if (nt >= 14 && nt <= 17) {
      const int head8 = (nt - 14) * 2 + wc, g = head8 >> 2, hh = head8 & 3;
      base = (u16*)(ws + OFF_NQ) + (((size_t)(b * 2 + g) * T_ + t0) * 4 + hh) * 64; rstride = 256; scale = 0.125f; rope = true;
    } else {
      const size_t off = (nt == 18) ? OFF_KC : (nt == 19) ? OFF_VC : (nt == 20) ? OFF_KS : OFF_KW;
      base = (u16*)(ws + off) + ((size_t)(b * 2 + wc) * T_ + t0) * 64; rstride = 64; rope = (nt == 20 || nt == 22);
    }
    const float2* rt = (const float2*)(ws + OFF_ROPE);
    if (nt == 2 || nt == 3) {
      float mxn = 0.f;
#pragma unroll
      for (int mi = 0; mi < 2; ++mi)
#pragma unroll
        for (int reg = 0; reg < 16; ++reg) {
          const float a0 = bf2f(f2bf(acc[mi][0][reg])), a1 = bf2f(f2bf(acc[mi][1][reg]));
          float ss = a0 * a0 + a1 * a1;
          ss += __shfl_xor(ss, 1); ss += __shfl_xor(ss, 2); ss += __shfl_xor(ss, 4); ss += __shfl_xor(ss, 8); ss += __shfl_xor(ss, 16);
          mxn = fmaxf(mxn, ss);
        }
      mxn = fmaxf(mxn, __shfl_xor(mxn, 32));
      if (lane == 0) atomicMax((unsigned*)(ws + OFF_KN2) + l * 8 + b * 4 + (nt - 2) * 2 + wc, __float_as_uint(mxn));
    }
#pragma unroll
    for (int mi = 0; mi < 2; ++mi)
#pragma unroll
      for (int ni = 0; ni < 2; ++ni)
#pragma unroll
        for (int reg = 0; reg < 16; ++reg) {
          const int row = 64 * wr + 32 * mi + crow(reg, h);
          float v = acc[mi][ni][reg];
          if (ni == 0 && rope) {
            const float pv = __shfl_xor(v, 8);
            if (r < 16) {
              const float2 cs = rt[(t0 + row) * 8 + (r & 7)];
              v = (r & 8) ? (pv * cs.y + v * cs.x) : (v * cs.x - pv * cs.y);
            }
          }
          base[(size_t)row * rstride + 32 * ni + r] = f2bf(v * scale);
        }
    return;
  }
  if (nt == 28) {
    float* flog = (float*)(ws + OFF_FLOG);
    float* ngl = (float*)(ws + OFF_NGL);
    if (wc == 0) {
      const int col = r;
      const float fb = (col < 4) ? p.fox_b[l * 4 + col] : 0.f;
#pragma unroll
      for (int mi = 0; mi < 2; ++mi)
#pragma unroll
        for (int reg = 0; reg < 16; ++reg) {
          const int m = m0 + 64 * wr + 32 * mi + crow(reg, h);
          const float v = acc[mi][0][reg];
          if (col < 4) {
            const float xx = v + fb;
            flog[(size_t)m * 4 + col] = fminf(xx, 0.f) - __logf(1.f + __expf(-fabsf(xx)));
          } else if (col < 28) {
            ngl[(size_t)m * 24 + (col - 4)] = sigmf(v);
          }
        }
    }
    return;
  }
  {
    u16* base; int ld; bool silu = true;
    if (nt == 6 || nt == 7) { base = (u16*)(ws + OFF_GATE) + (nt - 6) * 128; ld = 1024; }
    else if (nt >= 8 && nt <= 11) { base = (u16*)(ws + OFF_GLU) + (nt - 8) * 128; ld = 512; silu = false; }
    else if (nt == 12 || nt == 13) { base = (u16*)(ws + OFF_GATE) + 256 + (nt - 12) * 128; ld = 1024; }
    else { base = (u16*)(ws + OFF_GATE) + 512 + (nt - 24) * 128; ld = 1024; }
#pragma unroll
    for (int mi = 0; mi < 2; ++mi)
#pragma unroll
      for (int ni = 0; ni < 2; ++ni)
#pragma unroll
        for (int reg = 0; reg < 16; ++reg) {
          const int m = m0 + 64 * wr + 32 * mi + crow(reg, h);
          float v = acc[mi][ni][reg];
          if (silu) v = siluf(v);
          base[(size_t)m * ld + 64 * wc + 32 * ni + r] = f2bf(v);
        }
  }
}

DI void tail_item(const Params& p, int l, int mt) {
  char* ws = lptr(p.ws);
  const int tid = ltid(), lane = tid & 63, w = tid >> 6, r = lane & 31, h = lane >> 5;
  const int m0 = mt * 128;
  const u16* ap = (const u16*)(ws + OFF_H) + (size_t)(m0 + 32 * w + r) * 1024 + 8 * h;
  const u16* bp = (const u16*)(ws + OFF_WINT + l * SZ_WINT) + (size_t)(3584 + r) * 1024 + 8 * h;
  f32x16 acc0, acc1;
#pragma unroll
  for (int k = 0; k < 16; ++k) { acc0[k] = 0.f; acc1[k] = 0.f; }
  for (int kb = 0; kb < 8; ++kb) {
    bf16x8 af[8], bf[8];
#pragma unroll
    for (int ks = 0; ks < 8; ++ks) { af[ks] = *(const bf16x8*)(ap + (kb * 8 + ks) * 16); bf[ks] = *(const bf16x8*)(bp + (kb * 8 + ks) * 16); }
#pragma unroll
    for (int ks = 0; ks < 8; ks += 2) { acc0 = MFMA(af[ks], bf[ks], acc0); acc1 = MFMA(af[ks + 1], bf[ks + 1], acc1); }
  }
  float* flog = (float*)(ws + OFF_FLOG);
  float* ngl = (float*)(ws + OFF_NGL);
  const int col = r;
  const float fb = (col < 4) ? p.fox_b[l * 4 + col] : 0.f;
#pragma unroll
  for (int reg = 0; reg < 16; ++reg) {
    const int m = m0 + 32 * w + crow(reg, h);
    const float v = acc0[reg] + acc1[reg];
    if (col < 4) {
      const float xx = v + fb;
      flog[(size_t)m * 4 + col] = fminf(xx, 0.f) - __logf(1.f + __expf(-fabsf(xx)));
    } else if (col < 28) {
      ngl[(size_t)m * 24 + (col - 4)] = sigmf(v);
    }
  }
}

DI void gemm2_item(const Params& p, int l, int item, unsigned lds) {
  const int mt = item >> 3, nt = item & 7;
  const int m0 = mt * 128, n0 = nt * 128;
  char* ws = lptr(p.ws);
  const u16* A = (const u16*)(ws + OFF_MIXED) + (size_t)m0 * 1024;
  const u16* B = (const u16*)(ws + OFF_WOUTT) + (size_t)l * 1024 * 1024 + (size_t)n0 * 1024;
  f32x16 acc[2][2];
  gemm_tile<false>(A, 1024, B, 1024, 1024, lds, acc);
  const int tid = ltid(), lane = tid & 63, w = tid >> 6, wr = w >> 1, wc = w & 1, r = lane & 31, h = lane >> 5;
  const float* res = (l == 0) ? p.x : p.out;
#pragma unroll
  for (int mi = 0; mi < 2; ++mi)
#pragma unroll
    for (int ni = 0; ni < 2; ++ni)
#pragma unroll
      for (int reg = 0; reg < 16; ++reg) {
        const size_t idx = (size_t)(m0 + 64 * wr + 32 * mi + crow(reg, h)) * 1024 + n0 + 64 * wc + 32 * ni + r;
        p.out[idx] = res[idx] + acc[mi][ni][reg];
      }
}

DI void conv_item(const Params& p, int l, int item, unsigned lds) {
  char* ws = lptr(p.ws);
  const int m0 = item * 64, t0 = m0 & 8191;
  const int tid = ltid(), lane = tid & 63, w = tid >> 6;
  const u16* glu = (const u16*)(ws + OFF_GLU);
  const unsigned at = lds + 32768;
  {
    f32x4 wt[31];
    const float* cw = p.conv_w + (size_t)l * 31 * 256 + lane * 4;
#pragma unroll
    for (int k = 0; k < 31; ++k) wt[k] = *(const f32x4*)(cw + k * 256);
    const float4 cb = *(const float4*)(p.conv_b + l * 256 + lane * 4);
    const float4 lg = *(const float4*)(p.conv_ln_g + l * 256 + lane * 4);
    const float4 lb = *(const float4*)(p.conv_ln_b + l * 256 + lane * 4);
    for (int sub = 0; sub < 2; ++sub) {
      const int ts = t0 + 32 * sub;
      __syncthreads();
      {
        const int c8 = (tid & 31) * 8, rsub = tid >> 5;
#pragma unroll
        for (int pb = 0; pb < 8; pb += 4) {
          u32x4 av[4], bv[4];
#pragma unroll
          for (int q = 0; q < 4; ++q) {
            const int i = (pb + q) * 8 + rsub;
            int t = ts - 30 + i; if (t < 0) t = 0; if (t > T_ - 1) t = T_ - 1;
            const size_t m = (size_t)(m0 - t0 + t);
            av[q] = *(const u32x4*)(glu + m * 512 + c8);
            bv[q] = *(const u32x4*)(glu + m * 512 + 256 + c8);
          }
#pragma unroll
          for (int q = 0; q < 4; ++q) {
            const int i = (pb + q) * 8 + rsub;
            const bool ok = (ts - 30 + i) >= 0;
            u32x4 yv;
#pragma unroll
            for (int e = 0; e < 4; ++e) {
              const unsigned y = pk2(bflo(av[q][e]) * sigmf(bflo(bv[q][e])), bfhi(av[q][e]) * sigmf(bfhi(bv[q][e])));
              yv[e] = ok ? y : 0u;
            }
            if (i < 62) *LDSP(u32x4, lds + i * 512 + c8 * 2) = yv;
          }
        }
      }
      __syncthreads();
#pragma unroll 2
      for (int j = 0; j < 8; ++j) {
        const int tt = 8 * w + j;
        float4 o = cb;
#pragma unroll
        for (int k = 0; k < 31; ++k) {
          const u32x2 yy = *LDSP(u32x2, lds + (tt + k) * 512 + lane * 8);
          o.x = fmaf(wt[k][0], bflo(yy[0]), o.x);
          o.y = fmaf(wt[k][1], bfhi(yy[0]), o.y);
          o.z = fmaf(wt[k][2], bflo(yy[1]), o.z);
          o.w = fmaf(wt[k][3], bfhi(yy[1]), o.w);
        }
        float s = o.x + o.y + o.z + o.w;
#pragma unroll
        for (int of = 32; of > 0; of >>= 1) s += __shfl_xor(s, of);
        const float mu = s * (1.f / 256.f);
        const float dx = o.x - mu, dy = o.y - mu, dz = o.z - mu, dw = o.w - mu;
        float vs = dx * dx + dy * dy + dz * dz + dw * dw;
#pragma unroll
        for (int of = 32; of > 0; of >>= 1) vs += __shfl_xor(vs, of);
        const float rs = rsqrtf(vs * (1.f / 256.f) + 1e-6f);
        const float y0 = siluf(dx * rs * lg.x + lb.x), y1 = siluf(dy * rs * lg.y + lb.y);
        const float y2 = siluf(dz * rs * lg.z + lb.z), y3 = siluf(dw * rs * lg.w + lb.w);
        u32x2 pk; pk[0] = pk2(y0, y1); pk[1] = pk2(y2, y3);
        const int row = 32 * sub + tt;
        *LDSP(u32x2, at + row * 512 + (((lane >> 1) ^ (row & 15)) << 4) + 8 * (lane & 1)) = pk;
      }
    }
  }
  __syncthreads();
  const int r = lane & 31, h = lane >> 5;
  const u16* pw = (const u16*)(ws + OFF_PWT) + (size_t)l * 65536 + (size_t)(64 * w + r) * 256 + 8 * h;
  f32x16 acc[2][2];
  zero_acc(acc);
#pragma unroll
  for (int kb = 0; kb < 2; ++kb) {
    bf16x8 bfr[8][2];
#pragma unroll
    for (int ks = 0; ks < 8; ++ks)
#pragma unroll
      for (int ni = 0; ni < 2; ++ni) bfr[ks][ni] = *(const bf16x8*)(pw + (size_t)ni * 32 * 256 + (kb * 8 + ks) * 16);
#pragma unroll
    for (int ks = 0; ks < 8; ++ks) {
      const int kk = kb * 8 + ks;
      bf16x8 af[2];
#pragma unroll
      for (int mi = 0; mi < 2; ++mi) { const int row = 32 * mi + r; af[mi] = *LDSP(bf16x8, at + row * 512 + (((2 * kk + h) ^ (row & 15)) << 4)); }
#pragma unroll
      for (int mi = 0; mi < 2; ++mi)
#pragma unroll
        for (int ni = 0; ni < 2; ++ni) acc[mi][ni] = MFMA(af[mi], bfr[ks][ni], acc[mi][ni]);
    }
  }
  const u16* gate = (const u16*)(ws + OFF_GATE);
  u16* mixed = (u16*)(ws + OFF_MIXED);
#pragma unroll
  for (int mi = 0; mi < 2; ++mi)
#pragma unroll
    for (int ni = 0; ni < 2; ++ni)
#pragma unroll
      for (int reg = 0; reg < 16; ++reg) {
        const size_t idx = (size_t)(m0 + 32 * mi + crow(reg, h)) * 1024 + 256 + 64 * w + 32 * ni + r;
        mixed[idx] = f2bf(acc[mi][ni][reg] * bf2f(gate[idx]));
      }
}

DI void compress_item(const Params& p, int l, int item64, unsigned lds) {
  char* ws = lptr(p.ws);
  const int nh = item64 & 1, item = item64 >> 1;
  const int mtile = item & 3, kv = (item >> 2) & 1, bg = item >> 3;
  const u16* src = (const u16*)(ws + (kv ? OFF_VC : OFF_KC)) + ((size_t)bg * T_ + (size_t)16 * 128 * mtile) * 64;
  const u16* w1t = (const u16*)(ws + OFF_W1T) + (size_t)(l * 2 + kv) * 256 * 2048;
  const u16* w2t = (const u16*)(ws + OFF_W2T) + (size_t)(l * 2 + kv) * 128 * 256;
  const float* bias = (const float*)(ws + OFF_CBIAS) + (l * 2 + kv) * 256;
  u16* hid = (u16*)(ws + OFF_HID) + (size_t)item * 128 * 256;
  const int tid = ltid(), lane = tid & 63, w = tid >> 6, wr = w >> 1, wc = w & 1, r = lane & 31, h = lane >> 5;
  {
    f32x16 acc[2][2];
    gemm_tile<false>(src, 1024, w1t + (size_t)nh * 128 * 2048, 2048, 2048, lds, acc);
#pragma unroll
    for (int ni = 0; ni < 2; ++ni) {
      const int col = nh * 128 + 64 * wc + 32 * ni + r;
      const float bb = bias[col];
#pragma unroll
      for (int mi = 0; mi < 2; ++mi)
#pragma unroll
        for (int reg = 0; reg < 16; ++reg) {
          const int row = 64 * wr + 32 * mi + crow(reg, h);
          hid[(size_t)row * 256 + col] = f2bf(geluf(acc[mi][ni][reg] + bb));
        }
    }
  }
  __threadfence();
  __syncthreads();
  if (tid == 0) {
    const int old = atomicAdd((int*)(ws + OFF_CNT) + l * 32 + item, 1);
    *LDSP(int, lds) = old;
  }
  __syncthreads();
  const int arrived = *LDSP(int, lds);
  if (arrived == 0) return;
  __threadfence();
  f32x16 acc[2][2];
  if (kv == 0) {
    gemm_tile<false>(hid, 256, w2t, 256, 256, lds, acc);
    if (wc == 0) {
      u16* kcmp = (u16*)(ws + OFF_KCMP) + (size_t)bg * 512 * 64;
      const float2* rt = (const float2*)(ws + OFF_ROPE);
#pragma unroll
      for (int mi = 0; mi < 2; ++mi)
#pragma unroll
        for (int ni = 0; ni < 2; ++ni)
#pragma unroll
          for (int reg = 0; reg < 16; ++reg) {
            const int n = 128 * mtile + 64 * wr + 32 * mi + crow(reg, h);
            float v = acc[mi][ni][reg];
            if (ni == 0) {
              const float pv = __shfl_xor(v, 8);
              if (r < 16) {
                int pos = 16 * n + 31; if (pos > 8191) pos = 8191;
                const float2 cs = rt[pos * 8 + (r & 7)];
                v = (r & 8) ? (pv * cs.y + v * cs.x) : (v * cs.x - pv * cs.y);
              }
            }
            kcmp[(size_t)n * 64 + 32 * ni + r] = f2bf(v);
          }
    }
  } else {
    gemm_tile<true>(hid, 256, w2t, 256, 256, lds, acc);
    if (wc == 0) {
      u16* vcmpT = (u16*)(ws + OFF_VCMPT) + (size_t)bg * 64 * 512;
#pragma unroll
      for (int mi = 0; mi < 2; ++mi)
#pragma unroll
        for (int ni = 0; ni < 2; ++ni)
#pragma unroll
          for (int reg = 0; reg < 16; ++reg) {
            const int n = 128 * mtile + 64 * wr + 32 * mi + r;
            const int d = 32 * ni + crow(reg, h);
            vcmpT[(size_t)d * 512 + vperm16(n)] = (n < 511) ? f2bf(acc[mi][ni][reg]) : (u16)0;
          }
    }
  }
  asm volatile("s_waitcnt vmcnt(0)" ::: "memory");
  __syncthreads();
  if (tid == 0) {
    __builtin_amdgcn_fence(__ATOMIC_RELEASE, "agent");
    asm volatile("s_waitcnt vmcnt(0)" ::: "memory");
    __hip_atomic_fetch_add((unsigned*)(ws + OFF_BAR) + 3800 + l * 4 + bg, 1u, __ATOMIC_RELAXED, __HIP_MEMORY_SCOPE_AGENT);
  }
}

struct TileRegs { u32x4 k0, k1, v0, v1; };
DI void tile_gload(TileRegs& tr, const u16* __restrict__ kbase, long kstride, const u16* __restrict__ vbase, long vstride) {
  const int tid = ltid(), row = tid >> 2, c0 = (tid & 3) * 2;
  const u16* kp = kbase + (long)row * kstride + c0 * 8;
  const u16* vp = vbase + (long)row * vstride + c0 * 8;
  tr.k0 = *(const u32x4*)kp; tr.k1 = *(const u32x4*)(kp + 8);
  tr.v0 = *(const u32x4*)vp; tr.v1 = *(const u32x4*)(vp + 8);
}
DI void tile_swrite(const TileRegs& tr, unsigned buf) {
  const int tid = ltid(), row = tid >> 2, c0 = (tid & 3) * 2;
  *LDSP(u32x4, buf + swz(row, c0)) = tr.k0;
  *LDSP(u32x4, buf + swz(row, c0 + 1)) = tr.k1;
  *LDSP(u32x4, buf + 8192 + swz(row, c0)) = tr.v0;
  *LDSP(u32x4, buf + 8192 + swz(row, c0 + 1)) = tr.v1;
}
DI void load_qfrags(bf16x8 (&QB)[2][4], const u16* __restrict__ qrows  ) {
  const int lane = ltid() & 63, r = lane & 31, h = lane >> 5;
#pragma unroll
  for (int ni = 0; ni < 2; ++ni)
#pragma unroll
    for (int ks = 0; ks < 4; ++ks) QB[ni][ks] = *(const bf16x8*)(qrows + (size_t)(32 * ni + r) * 64 + 16 * ks + 8 * h);
}
DI float dpp_xor1(float x) { return __builtin_bit_cast(float, __builtin_amdgcn_mov_dpp(__builtin_bit_cast(int, x), 0xB1, 0xF, 0xF, true)); }
DI float dpp_xor2(float x) { return __builtin_bit_cast(float, __builtin_amdgcn_mov_dpp(__builtin_bit_cast(int, x), 0x4E, 0xF, 0xF, true)); }
DI int dpp_xor1i(int x) { return __builtin_amdgcn_mov_dpp(x, 0xB1, 0xF, 0xF, true); }
DI int dpp_xor2i(int x) { return __builtin_amdgcn_mov_dpp(x, 0x4E, 0xF, 0xF, true); }
DI int dpp_hmi(int x) { return __builtin_amdgcn_mov_dpp(x, 0x141, 0xF, 0xF, true); }
DI float xhalf_max(float x) {
  const unsigned u = __float_as_uint(x);
  const auto rr = __builtin_amdgcn_permlane32_swap(u, u, false, false);
  return fmaxf(__uint_as_float(rr[0]), __uint_as_float(rr[1]));
}
DI float xhalf_sum(float x) {
  const unsigned u = __float_as_uint(x);
  const auto rr = __builtin_amdgcn_permlane32_swap(u, u, false, false);
  return __uint_as_float(rr[0]) + __uint_as_float(rr[1]);
}
template <int MODE, bool BIAS = false>
DI void attn_step1(const bf16x8 (&QB)[2][4], const unsigned Ks, f32x16 (&ot)[2][2], float (&m)[2], float (&l)[2], const int bnd, const bool rowok, const float sc2,
                   const bool first, const float cq = 0.f, const unsigned ck = 0u) {
  const int lane = ltid() & 63, r = lane & 31, h = lane >> 5;
  f32x16 s0, s1;
#pragma unroll
  for (int k = 0; k < 16; ++k) { s0[k] = 0.f; s1[k] = 0.f; }
#pragma unroll
  for (int ks = 0; ks < 4; ++ks) {
    const bf16x8 k0 = *LDSP(bf16x8, Ks + swz(r, 2 * ks + h));
    const bf16x8 k1 = *LDSP(bf16x8, Ks + swz(32 + r, 2 * ks + h));
    s0 = MFMA(k0, QB[0][ks], s0);
    s1 = MFMA(k1, QB[0][ks], s1);
  }
  if (BIAS) {
#pragma unroll
    for (int g4 = 0; g4 < 4; ++g4) {
      const f32x4 ca = *LDSP(f32x4, ck + 4 * (8 * g4 + 4 * h));
      const f32x4 cb = *LDSP(f32x4, ck + 4 * (32 + 8 * g4 + 4 * h));
#pragma unroll
      for (int e = 0; e < 4; ++e) {
        s0[4 * g4 + e] = fmaf(s0[4 * g4 + e], LOG2E, cq - ca[e]);
        s1[4 * g4 + e] = fmaf(s1[4 * g4 + e], LOG2E, cq - cb[e]);
      }
    }
  }
  if (MODE == 1) {
#pragma unroll
    for (int reg = 0; reg < 16; ++reg) {
      const int keyc = (reg & 3) + 8 * (reg >> 2);
      s0[reg] = (keyc <= bnd) ? s0[reg] : -1e30f;
      s1[reg] = (keyc + 32 <= bnd) ? s1[reg] : -1e30f;
    }
  }
  if (MODE == 2) {
#pragma unroll
    for (int reg = 0; reg < 16; ++reg) {
      const int keyc = (reg & 3) + 8 * (reg >> 2);
      s0[reg] = (keyc >= bnd) ? s0[reg] : -1e30f;
      s1[reg] = (keyc + 32 >= bnd) ? s1[reg] : -1e30f;
    }
  }
  if (first) {
    float mx = fmaxf(s0[0], s1[0]);
#pragma unroll
    for (int reg = 1; reg < 16; ++reg) mx = fmaxf(mx, fmaxf(s0[reg], s1[reg]));
    mx = xhalf_max(mx);
    if (MODE == 3) mx = rowok ? mx : -1e30f;
    m[0] = fmaxf(-1e20f, mx);
  }
  float mb = -m[0] * sc2;
  if (MODE == 3) mb = rowok ? mb : -__builtin_inff();
  float rs0 = 0.f, rs1 = 0.f;
#pragma unroll
  for (int reg = 0; reg < 16; ++reg) {
    const float p0 = EXP2(fmaf(s0[reg], sc2, mb)); s0[reg] = p0; rs0 += p0;
    const float p1 = EXP2(fmaf(s1[reg], sc2, mb)); s1[reg] = p1; rs1 += p1;
  }
  l[0] += xhalf_sum(rs0 + rs1);
  const unsigned Vs = Ks + 8192;
#pragma unroll
  for (int kk = 0; kk < 4; ++kk) {
    const int mi = kk >> 1, s = kk & 1;
    u32x4 pk;
#pragma unroll
    for (int i = 0; i < 4; ++i) pk[i] = mi ? pk2(s1[8 * s + 2 * i], s1[8 * s + 2 * i + 1]) : pk2(s0[8 * s + 2 * i], s0[8 * s + 2 * i + 1]);
    const bf16x8 pf = __builtin_bit_cast(bf16x8, pk);
    bf16x8 vf[2];
#pragma unroll
    for (int di = 0; di < 2; ++di) {
      const int d = 32 * di + r;
      const int sw = (d >> 1) & 7;
      vf[di] = *LDSP(bf16x8, Vs + d * 128 + (((4 * mi + 2 * s + h) ^ sw) << 4));
    }
#pragma unroll
    for (int di = 0; di < 2; ++di) ot[di][0] = MFMA(vf[di], pf, ot[di][0]);
  }
}

template <class LoadF, class BodyF>
DI void tile_pipeline(const int n, const unsigned lds, LoadF&& ld, BodyF&& body) {
  TileRegs A, B;
  ld(A, 0);
  __syncthreads();
  tile_swrite(A, lds);
  if (n > 1) ld(A, 1);
  if (n > 2) ld(B, 2);
  __syncthreads();
  int j = 0;
  while (true) {
    body(j, lds);
    if (j + 1 < n) tile_swrite(A, lds + 16384);
    if (j + 3 < n) ld(A, j + 3);
    __syncthreads();
    if (++j >= n) break;
    body(j, lds + 16384);
    if (j + 1 < n) tile_swrite(B, lds);
    if (j + 3 < n) ld(B, j + 3);
    __syncthreads();
    if (++j >= n) break;
  }
}

template <int MI, int NIM>
DI void qk_half(const bf16x8 (&QB)[2][4], const unsigned Ks, f32x16 (&st)[2]) {
  const int lane = ltid() & 63, r = lane & 31, h = lane >> 5;
#pragma unroll
  for (int j = 0; j < 2; ++j)
#pragma unroll
    for (int k = 0; k < 16; ++k) st[j][k] = 0.f;
#pragma unroll
  for (int ks = 0; ks < 4; ++ks) {
    const bf16x8 kf = *LDSP(bf16x8, Ks + swz(32 * MI + r, 2 * ks + h));
#pragma unroll
    for (int ni = 0; ni < 2; ++ni)
      if (NIM & (1 << ni)) st[ni] = MFMA(kf, QB[ni][ks], st[ni]);
  }
}
template <int MI>
DI void mask_hi(f32x16 (&st)[2], const int (&hi)[2]) {
#pragma unroll
  for (int reg = 0; reg < 16; ++reg) {
    const int keyc = 32 * MI + (reg & 3) + 8 * (reg >> 2);
#pragma unroll
    for (int ni = 0; ni < 2; ++ni) st[ni][reg] = (keyc <= hi[ni]) ? st[ni][reg] : -1e30f;
  }
}
template <int MI>
DI void mask_lo(f32x16 (&st)[2], const int (&lo)[2]) {
#pragma unroll
  for (int reg = 0; reg < 16; ++reg) {
    const int keyc = 32 * MI + (reg & 3) + 8 * (reg >> 2);
#pragma unroll
    for (int ni = 0; ni < 2; ++ni) st[ni][reg] = (keyc >= lo[ni]) ? st[ni][reg] : -1e30f;
  }
}
template <int MI, int NIM, bool ROWSEL>
DI void softmax_pv(f32x16 (&st)[2], const unsigned Vs, f32x16 (&ot)[2][2], float (&m)[2], float (&l)[2], const float sc2, const bool (&rowok)[2]) {
  const int lane = ltid() & 63, r = lane & 31, h = lane >> 5;
#pragma unroll
  for (int ni = 0; ni < 2; ++ni) {
    if (!(NIM & (1 << ni))) continue;
    float mx = st[ni][0];
#pragma unroll
    for (int reg = 1; reg < 16; ++reg) mx = fmaxf(mx, st[ni][reg]);
    mx = fmaxf(mx, __shfl_xor(mx, 32));
    if (ROWSEL) mx = rowok[ni] ? mx : -1e30f;
    const float mold = m[ni];
    const float mnew = fmaxf(mold, mx);
    const float alpha = EXP2((mold - mnew) * sc2);
    m[ni] = mnew;
    float mb = -mnew * sc2;
    if (ROWSEL) mb = rowok[ni] ? mb : -__builtin_inff();
    float rs = 0.f;
#pragma unroll
    for (int reg = 0; reg < 16; ++reg) { const float pp = EXP2(fmaf(st[ni][reg], sc2, mb)); st[ni][reg] = pp; rs += pp; }
    rs += __shfl_xor(rs, 32);
    l[ni] = l[ni] * alpha + rs;
    if (__builtin_amdgcn_ballot_w64(mnew > mold) != 0ull) {
#pragma unroll
      for (int di = 0; di < 2; ++di)
#pragma unroll
        for (int reg = 0; reg < 16; ++reg) ot[di][ni][reg] *= alpha;
    }
  }
#pragma unroll
  for (int s = 0; s < 2; ++s) {
    bf16x8 pf[2], vf[2];
#pragma unroll
    for (int ni = 0; ni < 2; ++ni) {
      if (!(NIM & (1 << ni))) continue;
      u32x4 pk;
#pragma unroll
      for (int i = 0; i < 4; ++i) pk[i] = pk2(st[ni][8 * s + 2 * i], st[ni][8 * s + 2 * i + 1]);
      pf[ni] = __builtin_bit_cast(bf16x8, pk);
    }
#pragma unroll
    for (int di = 0; di < 2; ++di) {
      const int d = 32 * di + r;
      const int sw = (d >> 1) & 7;
      const u32x2 lo = *LDSP(u32x2, Vs + d * 128 + (((4 * MI + 2 * s) ^ sw) << 4) + 8 * h);
      const u32x2 hi = *LDSP(u32x2, Vs + d * 128 + (((4 * MI + 2 * s + 1) ^ sw) << 4) + 8 * h);
      u32x4 vv; vv[0] = lo[0]; vv[1] = lo[1]; vv[2] = hi[0]; vv[3] = hi[1];
      vf[di] = __builtin_bit_cast(bf16x8, vv);
    }
#pragma unroll
    for (int di = 0; di < 2; ++di)
#pragma unroll
      for (int ni = 0; ni < 2; ++ni)
        if (NIM & (1 << ni)) ot[di][ni] = MFMA(vf[di], pf[ni], ot[di][ni]);
  }
}
template <int NIM, int MODE>
DI void attn_step(const bf16x8 (&QB)[2][4], const unsigned Ks, f32x16 (&ot)[2][2], float (&m)[2], float (&l)[2], const int (&bnd)[2], const bool (&rowok)[2]) {
  {
    f32x16 st[2];
    qk_half<0, NIM>(QB, Ks, st);
    if (MODE == 1) mask_hi<0>(st, bnd);
    if (MODE == 2) mask_lo<0>(st, bnd);
    softmax_pv<0, NIM, MODE == 3>(st, Ks + 8192, ot, m, l, LOG2E, rowok);
  }
  {
    f32x16 st[2];
    qk_half<1, NIM>(QB, Ks, st);
    if (MODE == 1) mask_hi<1>(st, bnd);
    if (MODE == 2) mask_lo<1>(st, bnd);
    softmax_pv<1, NIM, MODE == 3>(st, Ks + 8192, ot, m, l, LOG2E, rowok);
  }
}

DI void fox_item(const Params& p, int l, int item, unsigned lds) {
  char* ws = lptr(p.ws);
  const int bh = item & 7, qt = 63 - (item >> 3);
  const int b = bh >> 2, hd = bh & 3;
  const int q0 = qt * 128;
  const int tid = ltid(), lane = tid & 63, w = tid >> 6, r = lane & 31, h = lane >> 5;
  const u16* kb = (const u16*)(ws + OFF_FK) + (size_t)bh * T_ * 64;
  const u16* vb = (const u16*)(ws + OFF_FVT) + (size_t)bh * 64 * T_;
  const float* flog = (const float*)(ws + OFF_FLOG) + (size_t)b * T_ * 4 + hd;
  const unsigned rq = lds + 32768, ckb = lds + 32768 + 1024, wsum = lds + 32768 + 1024 + 512;
  __syncthreads();
  bf16x8 QB[2][4];
  {
    const u16* qrows = (const u16*)(ws + OFF_FQ) + ((size_t)bh * T_ + q0 + 32 * w) * 64;
#pragma unroll
    for (int ks = 0; ks < 4; ++ks) { QB[0][ks] = *(const bf16x8*)(qrows + (size_t)r * 64 + 16 * ks + 8 * h); QB[1][ks] = QB[0][ks]; }
  }
  {
    float v = (tid < 128) ? flog[(size_t)(q0 + tid) * 4] * LOG2E : 0.f;
#pragma unroll
    for (int o = 1; o < 64; o <<= 1) { const float u = __shfl_up(v, o); if (lane >= o) v += u; }
    if (tid == 63) *LDSP(float, wsum) = v;
    __syncthreads();
    if (w == 1) v += *LDSP(float, wsum);
    if (tid < 128) *LDSP(float, rq + 4 * tid) = v;
  }
  const int nkt = 2 * qt + 2;
  float qkb;
  {
    const float kn = sqrtf(((const float*)(ws + OFF_KN2))[l * 8 + bh]) * 1.02f + 1e-3f;
    float ss = 0.f;
#pragma unroll
    for (int ks = 0; ks < 4; ++ks)
#pragma unroll
      for (int e = 0; e < 8; ++e) { const float qv = bf2f((u16)QB[0][ks][e]); ss = fmaf(qv, qv, ss); }
    ss = xhalf_sum(ss);
    qkb = sqrtf(ss) * kn * LOG2E;
  }
  TileRegs tr;
  float carry = 0.f;
  float cknext = 0.f;
  tile_gload(tr, kb + (size_t)(nkt - 1) * 64 * 64, 64, vb + (size_t)(nkt - 1) * 64, T_);
  __syncthreads();
  tile_swrite(tr, lds);
  if (w == 0) *LDSP(float, ckb + 4 * lane) = *LDSP(float, rq + 4 * (64 + lane));
  __syncthreads();
  f32x16 ot[2][2]; zero_acc(ot);
  float m[2] = {-1e20f, -1e20f}, ls[2] = {0.f, 0.f};
  const float cq = *LDSP(float, rq + 4 * (32 * w + r));
  int cur = 0;
  for (int kt = nkt - 1; kt >= 0; --kt) {
    const bool more = kt > 0;
    if (more) {
      tile_gload(tr, kb + (size_t)(kt - 1) * 64 * 64, 64, vb + (size_t)(kt - 1) * 64, T_);
      if (w == 0) {
        const int ktn = kt - 1 - 2 * qt;
        if (ktn >= 0) cknext = *LDSP(float, rq + 4 * (64 * ktn + lane));
        else {
          const float v = -flog[(size_t)((kt - 1) * 64 + lane) * 4] * LOG2E;
          float inc = v;
#pragma unroll
          for (int o = 1; o < 64; o <<= 1) { const float u = __shfl_down(inc, o); if (lane + o < 64) inc += u; }
          cknext = carry + inc - v;
          carry += __shfl(inc, 0);
        }
      }
    }
    const int ktp = kt - 2 * qt;
    if (ktp <= 0 || w >= 2) {
      const unsigned Ks = lds + cur * 16384;
      const unsigned ck = ckb + cur * 256;
      const bool masked = (ktp == 1) || (ktp == 0 && w < 2);
      if (masked) attn_step1<1, true>(QB, Ks, ot, m, ls, 32 * w + r - 64 * ktp - 4 * h, true, 1.0f, true, cq, ck);
      else attn_step1<0, true>(QB, Ks, ot, m, ls, 0, true, 1.0f, false, cq, ck);
    }
    if (more) {
      tile_swrite(tr, lds + (cur ^ 1) * 16384);
      if (w == 0) *LDSP(float, ckb + 4 * ((cur ^ 1) * 64 + lane)) = cknext;
    }
    if (kt <= 2 * qt && kt > 0 && (kt & 1) == 0) {
      const float cmin = __shfl(cknext, 63);
      if (w == 0 && lane == 0) *LDSP(float, wsum + 16) = cmin;
      __syncthreads();
      const float cm = *LDSP(float, wsum + 16);
      const bool done = (qkb + cq - cm - m[0] < -40.f);
      if (__syncthreads_and(done ? 1 : 0)) break;
    } else {
      __syncthreads();
    }
    cur ^= 1;
  }
  const u16* gate = (const u16*)(ws + OFF_GATE);
  u16* mixed = (u16*)(ws + OFF_MIXED);
  {
    const float il = 1.f / ls[0];
    const size_t mrow = (size_t)(b * T_ + q0 + 32 * w + r) * 1024 + hd * 64;
#pragma unroll
    for (int di = 0; di < 2; ++di)
#pragma unroll
      for (int g4 = 0; g4 < 4; ++g4) {
        const int d = 32 * di + 8 * g4 + 4 * h;
        const u32x2 gv = *(const u32x2*)(gate + mrow + d);
        u32x2 o;
        o[0] = pk2(ot[di][0][4 * g4] * il * bflo(gv[0]), ot[di][0][4 * g4 + 1] * il * bfhi(gv[0]));
        o[1] = pk2(ot[di][0][4 * g4 + 2] * il * bflo(gv[1]), ot[di][0][4 * g4 + 3] * il * bfhi(gv[1]));
        *(u32x2*)(mixed + mrow + d) = o;
      }
  }
}

DI int tl32() { const int t = ltid(); return ((t >> 6) << 3) + ((t & 31) >> 2); }
DI void nsa_flush32(const Params& p, int mode, f32x16 (&ot)[2][2], const float ls0, int b, int g, int tbase, int br) {
  char* ws = lptr(p.ws);
  const int tid_ = ltid(); const int lane = tid_ & 63, r = lane & 31, h = lane >> 5;
  float* osc = (float*)(ws + OFF_OSC);
  const float* ngl = (const float*)(ws + OFF_NGL);
  const u16* gate = (const u16*)(ws + OFF_GATE);
  u16* mixed = (u16*)(ws + OFF_MIXED);
  const int t = tbase + tl32(), hh = r & 3;
  const size_t m = (size_t)b * T_ + t;
  const float gsig = ngl[m * 24 + (g * 4 + hh) * 3 + br];
  const float sc = (ls0 > 0.f) ? gsig / ls0 : 0.f;
  const size_t cb = m * 512 + (g * 4 + hh) * 64;
#pragma unroll
  for (int di = 0; di < 2; ++di)
#pragma unroll
    for (int g4 = 0; g4 < 4; ++g4) {
      const int d = 32 * di + 8 * g4 + 4 * h;
      float4 v = {ot[di][0][4 * g4] * sc, ot[di][0][4 * g4 + 1] * sc, ot[di][0][4 * g4 + 2] * sc, ot[di][0][4 * g4 + 3] * sc};
      if (mode > 0) { const float4 o = *(const float4*)(osc + cb + d); v.x += o.x; v.y += o.y; v.z += o.z; v.w += o.w; }
      if (mode < 2) *(float4*)(osc + cb + d) = v;
      else {
        const size_t mi2 = m * 1024 + 512 + (g * 4 + hh) * 64 + d;
        const u32x2 gv = *(const u32x2*)(gate + mi2);
        u32x2 o; o[0] = pk2(v.x * bflo(gv[0]), v.y * bfhi(gv[0])); o[1] = pk2(v.z * bflo(gv[1]), v.w * bfhi(gv[1]));
        *(u32x2*)(mixed + mi2) = o;
      }
    }
}

DI void nsa_accum32(const Params& p, f32x16 (&osum)[2], const f32x16 (&ot)[2][2], const float ls0, int b, int g, int tbase, int br, bool first) {
  char* ws = lptr(p.ws);
  const int r = ltid() & 31;
  const float* ngl = (const float*)(ws + OFF_NGL);
  const size_t m = (size_t)b * T_ + tbase + tl32();
  const float gsig = ngl[m * 24 + (g * 4 + (r & 3)) * 3 + br];
  const float sc = (ls0 > 0.f) ? gsig / ls0 : 0.f;
#pragma unroll
  for (int di = 0; di < 2; ++di)
#pragma unroll
    for (int k = 0; k < 16; ++k) osum[di][k] = first ? ot[di][0][k] * sc : fmaf(ot[di][0][k], sc, osum[di][k]);
}
DI void nsa_store32(const Params& p, const f32x16 (&osum)[2], int b, int g, int tbase) {
  char* ws = lptr(p.ws);
  const int lane = ltid() & 63, r = lane & 31, h = lane >> 5;
  const u16* gate = (const u16*)(ws + OFF_GATE);
  u16* mixed = (u16*)(ws + OFF_MIXED);
  const size_t m = (size_t)b * T_ + tbase + tl32();
  const size_t base = m * 1024 + 512 + (g * 4 + (r & 3)) * 64;
#pragma unroll
  for (int di = 0; di < 2; ++di)
#pragma unroll
    for (int g4 = 0; g4 < 4; ++g4) {
      const int d = 32 * di + 8 * g4 + 4 * h;
      const u32x2 gv = *(const u32x2*)(gate + base + d);
      u32x2 o;
      o[0] = pk2(osum[di][4 * g4] * bflo(gv[0]), osum[di][4 * g4 + 1] * bfhi(gv[0]));
      o[1] = pk2(osum[di][4 * g4 + 2] * bflo(gv[1]), osum[di][4 * g4 + 3] * bfhi(gv[1]));
      *(u32x2*)(mixed + base + d) = o;
    }
}

DI void nsa_item32(const Params& p, int l, int item, unsigned lds) {
  char* ws = lptr(p.ws);
  const int bg = item & 3, c32 = 255 - (item >> 2);
  const int b = bg >> 1, g = bg & 1;
  const int tbase = 32 * c32, c = c32 >> 1, toff = tbase & 63;
  const int tid = ltid(), lane = tid & 63, w = tid >> 6, r = lane & 31, h = lane >> 5;
  const unsigned imp = lds + 32768;
  const unsigned selw = lds + 32768 + 16384;
  __syncthreads();
  bf16x8 QB[2][4];
  {
    const u16* qrows = (const u16*)(ws + OFF_NQ) + (((size_t)bg * T_ + tbase) * 4 + 32 * w) * 64;
#pragma unroll
    for (int ks = 0; ks < 4; ++ks) { QB[0][ks] = *(const bf16x8*)(qrows + (size_t)r * 64 + 16 * ks + 8 * h); QB[1][ks] = QB[0][ks]; }
  }
  for (int i = tid; i < 32 * 128; i += 256) *LDSP(float, imp + 4 * i) = 0.f;
  f32x16 ot[2][2];
  f32x16 osum[2];
  float m[2], ls[2];
  const bool rk[2] = {true, true};
  {
    const u16* kb = (const u16*)(ws + OFF_KW) + (size_t)bg * T_ * 64;
    const u16* vb = (const u16*)(ws + OFF_VWT) + (size_t)bg * 64 * T_;
    zero_acc(ot); m[0] = m[1] = -1e20f; ls[0] = ls[1] = 0.f;
    const int jlo = (c >= 8) ? c - 8 : 0;
    tile_pipeline(c - jlo + 1, lds,
      [&](TileRegs& t, int i) __attribute__((always_inline)) { const int j = c - i; tile_gload(t, kb + (size_t)j * 64 * 64, 64, vb + (size_t)j * 64, T_); },
      [&](int i, unsigned Ks) __attribute__((always_inline)) {
        const int j = c - i;
        const bool diag = (j == c), far = (j == c - 8);
        if (diag) attn_step1<1>(QB, Ks, ot, m, ls, toff + tl32() - 4 * h_of(), true, LOG2E, true);
        else if (far) attn_step1<2>(QB, Ks, ot, m, ls, toff + tl32() + 1 - 4 * h_of(), true, LOG2E, false);
        else attn_step1<0>(QB, Ks, ot, m, ls, 0, true, LOG2E, false);
      });
    nsa_accum32(p, osum, ot, ls[0], b, g, tbase, 2, true);
  }
  if (tid == 0 && *LDSP(unsigned, lds + 67540 + 4 * (l * 4 + bg)) == 0u) {
    unsigned* dn = (unsigned*)(ws + OFF_BAR) + 3800 + l * 4 + bg;
    while (__hip_atomic_load(dn, __ATOMIC_RELAXED, __HIP_MEMORY_SCOPE_AGENT) < 8u) __builtin_amdgcn_s_sleep(4);
    __builtin_amdgcn_fence(__ATOMIC_ACQUIRE, "agent");
    asm volatile("s_waitcnt vmcnt(0)" ::: "memory");
    *LDSP(unsigned, lds + 67540 + 4 * (l * 4 + bg)) = 1u;
  }
  __syncthreads();
  const u16* kcb = (const u16*)(ws + OFF_KCMP) + (size_t)bg * 512 * 64;
  const u16* vcb = (const u16*)(ws + OFF_VCMPT) + (size_t)bg * 64 * 512;
  const int nbc = (2 * c32) / 64 + 1;
  {
    zero_acc(ot); m[0] = m[1] = -1e20f; ls[0] = ls[1] = 0.f;
    tile_pipeline(nbc, lds,
      [&](TileRegs& t, int nb) __attribute__((always_inline)) { tile_gload(t, kcb + (size_t)nb * 64 * 64, 64, vcb + (size_t)nb * 64, 512); },
      [&](int nb, unsigned Ks) __attribute__((always_inline)) {
        const int hb = ((tbase + tl32() - 31) >> 4) - 64 * nb - 4 * h_of();
        if (64 * nb + 63 <= ((tbase - 31) >> 4)) attn_step1<0>(QB, Ks, ot, m, ls, hb, true, LOG2E, nb == 0);
        else attn_step1<1>(QB, Ks, ot, m, ls, hb, true, LOG2E, nb == 0);
      });
    nsa_accum32(p, osum, ot, ls[0], b, g, tbase, 0, false);
  }
  if (c >= 16) {
    const float il0 = (ls[0] > 0.f) ? 1.f / ls[0] : 0.f;
#define IMP_HALF(MI)                                                                               \
      {                                                                                            \
        f32x16 st[2];                                                                              \
        qk_half<MI, 1>(QB, Ks, st);                                                                \
        const int tlv = tl32(); const int hbv = ((tbase + tlv - 31) >> 4) - 64 * nb - 4 * h_of();  \
        _Pragma("unroll") for (int g4 = 0; g4 < 4; ++g4) {                                         \
          float pg[4];                                                                             \
          _Pragma("unroll") for (int e = 0; e < 4; ++e) {                                          \
            const int keyc = 32 * MI + 8 * g4 + e;                                                 \
            float pp = (keyc <= hbv) ? EXP2((st[0][4 * g4 + e] - m[0]) * LOG2E) * il0 : 0.f;       \
            pp += dpp_xor1(pp);                                                                    \
            pp += dpp_xor2(pp);                                                                    \
            pg[e] = pp;                                                                            \
          }                                                                                        \
          if ((r & 3) == g4) {                                                                     \
            const int j = 16 * nb + 8 * MI + 2 * g4 + h;                                           \
            const float G = (pg[0] + pg[1]) + (pg[2] + pg[3]);                                     \
            __hip_atomic_fetch_add(LDSP(float, imp + 4 * (tlv * 128 + j)), G, __ATOMIC_RELAXED, __HIP_MEMORY_SCOPE_WORKGROUP); \
            if (j + 1 < 128) __hip_atomic_fetch_add(LDSP(float, imp + 4 * (tlv * 128 + j + 1)), pg[3], __ATOMIC_RELAXED, __HIP_MEMORY_SCOPE_WORKGROUP); \
          }                                                                                        \
        }                                                                                          \
      }
    tile_pipeline(nbc, lds,
      [&](TileRegs& t, int nb) __attribute__((always_inline)) { tile_gload(t, kcb + (size_t)nb * 64 * 64, 64, vcb + (size_t)nb * 64, 512); },
      [&](int nb, unsigned Ks) __attribute__((always_inline)) {
        IMP_HALF(0)
        IMP_HALF(1)
      });
#undef IMP_HALF
  }
  {
    const int tok = tid >> 3, sub = tid & 7;
    unsigned word;
    if (c < 16) {
      word = 0xffffu;
    } else {
      unsigned key[16];
      word = 0;
#pragma unroll
      for (int i = 0; i < 16; ++i) {
        const int j = 16 * sub + i;
        const float v = *LDSP(float, imp + 4 * (tok * 128 + j));
        const bool cand = (j >= 1) && (j <= c - 2);
        key[i] = cand ? (__float_as_uint(v) + 1u) : 0u;
        if (j == 0 || j == c || j == c - 1) word |= (1u << i);
      }
      unsigned thr = 0;
      for (int bit = 30; bit >= 0; --bit) {
        const unsigned cd = thr | (1u << bit);
        int cnt = 0;
#pragma unroll
        for (int i = 0; i < 16; ++i) cnt += (key[i] >= cd) ? 1 : 0;
        cnt += dpp_xor1i(cnt);
        cnt += dpp_xor2i(cnt);
        cnt += dpp_hmi(cnt);
        if (cnt >= 13) thr = cd;
      }
      int gt = 0, eq = 0;
#pragma unroll
      for (int i = 0; i < 16; ++i) { gt += (key[i] > thr) ? 1 : 0; eq += (key[i] == thr) ? 1 : 0; }
      int gtt = gt; gtt += dpp_xor1i(gtt); gtt += dpp_xor2i(gtt); gtt += dpp_hmi(gtt);
      int eqb = 0;
#pragma unroll
      for (int k = 0; k < 7; ++k) { const int ek = __shfl(eq, (lane & ~7) + k); if (sub > k) eqb += ek; }
      int need = 13 - gtt - eqb;
#pragma unroll
      for (int i = 0; i < 16; ++i) {
        if (key[i] > thr) word |= (1u << i);
        else if (key[i] == thr && thr != 0u) { if (need > 0) word |= (1u << i); --need; }
      }
    }
    *LDSP(u16, selw + 16 * tok + 2 * sub) = (u16)word;
  }
  __syncthreads();
  {
    const u16* kb = (const u16*)(ws + OFF_KS) + (size_t)bg * T_ * 64;
    const u16* vb = (const u16*)(ws + OFF_VST) + (size_t)bg * 64 * T_;
    zero_acc(ot); m[0] = m[1] = -1e20f; ls[0] = ls[1] = 0.f;
    tile_pipeline(c + 1, lds,
      [&](TileRegs& t, int j) __attribute__((always_inline)) { tile_gload(t, kb + (size_t)j * 64 * 64, 64, vb + (size_t)j * 64, T_); },
      [&](int j, unsigned Ks) __attribute__((always_inline)) {
        const bool selb = ((*LDSP(unsigned, selw + 16 * tl32() + 4 * (j >> 5)) >> (j & 31)) & 1u) != 0u;
        if (j == c) {
          attn_step1<1>(QB, Ks, ot, m, ls, toff + tl32() - 4 * h_of(), true, LOG2E, j == 0);
        } else {
          if (__builtin_amdgcn_ballot_w64(selb) != 0ull) attn_step1<3>(QB, Ks, ot, m, ls, 0, selb, LOG2E, j == 0);
        }
        if (PROBE_REP == 7) attn_step1<3>(QB, Ks, ot, m, ls, 0, false, LOG2E, false);
      });
    nsa_accum32(p, osum, ot, ls[0], b, g, tbase, 1, false);
    nsa_store32(p, osum, b, g, tbase);
  }
}

#define XB_TMO      128
#define XB_XCNT(j)  (256  + 64 * (j))
#define XB_XSUB(j)  (1280 + 64 * (j))
#define XB_XGEN(j)  (2304 + 64 * (j))
#define XB_TOP      3328
#define XB_TOPGEN   3392
#define XCD_BAR_WORDS 3456
#define XB_SPIN_CAP (1u << 18)
#define LAS __attribute__((address_space(3)))

__device__ __forceinline__ unsigned xb_ld(unsigned* p)              { return __hip_atomic_load(p, __ATOMIC_RELAXED, __HIP_MEMORY_SCOPE_AGENT); }
__device__ __forceinline__ unsigned xb_add(unsigned* p, unsigned v) { return __hip_atomic_fetch_add(p, v, __ATOMIC_RELAXED, __HIP_MEMORY_SCOPE_AGENT); }
__device__ __forceinline__ unsigned xb_xcc_id() { return (unsigned)__builtin_amdgcn_s_getreg((3 << 11) | 20) & 0xFu; }
#define XB_SPIN(cond, bar) do { unsigned _sp = 0; while (cond) { __builtin_amdgcn_s_sleep(1); \
    if ((++_sp & 255u) == 0u) { if (xb_ld(&(bar)[XB_TMO])) break; if (_sp > XB_SPIN_CAP) { atomicAdd(&(bar)[XB_TMO], 1u); break; } } } } while (0)

struct XcdBarrier {
    unsigned* bar; unsigned x;
    volatile LAS unsigned* st;
};

__device__ __forceinline__ XcdBarrier xcd_barrier_post(unsigned* bar, volatile LAS unsigned* st) {
    XcdBarrier b; b.bar = bar; b.x = xb_xcc_id(); b.st = st;
    if (threadIdx.x == 0) (void)xb_add(&bar[XB_XCNT(b.x)], 1u);
    return b;
}
__device__ __forceinline__ void xcd_barrier_complete(unsigned* bar, unsigned x, unsigned& nloc, unsigned& nx) {
    const unsigned G = gridDim.x * gridDim.y * gridDim.z;
    unsigned sum, cnt, mine, sp = 0u;
    for (;;) {
        sum = 0u; cnt = 0u; mine = 0u;
#pragma unroll
        for (unsigned j = 0; j < 16; ++j) { const unsigned c = xb_ld(&bar[XB_XCNT(j)]); sum += c; cnt += (c > 0u) ? 1u : 0u; mine = (j == x) ? c : mine; }
        if (sum == G) break;
        __builtin_amdgcn_s_sleep(1);
        if ((++sp & 255u) == 0u) { if (xb_ld(&bar[XB_TMO])) break; if (sp > XB_SPIN_CAP) { atomicAdd(&bar[XB_TMO], 1u); break; } }
    }
    nloc = mine > 0u ? mine : 1u; nx = cnt > 0u ? cnt : 1u;
}

__device__ __forceinline__ void xcd_barrier(const XcdBarrier& b) {
    asm volatile("s_waitcnt vmcnt(0)" ::: "memory");
    __syncthreads();
    if (threadIdx.x == 0) {
        unsigned* bar = b.bar;
        __builtin_amdgcn_s_waitcnt(0);
        unsigned nloc = b.st[0], nx = b.st[1];
        if (nloc == 0u) { xcd_barrier_complete(bar, b.x, nloc, nx); b.st[0] = nloc; b.st[1] = nx; }
        const unsigned old = xb_add(&bar[XB_XSUB(b.x)], 1u);
        const unsigned gen = old / nloc;
        if (old + 1u == (gen + 1u) * nloc) {
            __builtin_amdgcn_fence(__ATOMIC_RELEASE, "agent");
            asm volatile("s_waitcnt vmcnt(0)" ::: "memory");
            const unsigned og = xb_add(&bar[XB_TOP], 1u);
            const unsigned tg = og / nx;
            if (og + 1u == (tg + 1u) * nx) xb_add(&bar[XB_TOPGEN], 1u);
            else XB_SPIN(xb_ld(&bar[XB_TOPGEN]) == tg, bar);
            __builtin_amdgcn_fence(__ATOMIC_ACQUIRE, "agent");
            xb_add(&bar[XB_XGEN(b.x)], 1u);
            asm volatile("s_waitcnt vmcnt(0)" ::: "memory");
        } else {
            XB_SPIN(xb_ld(&bar[XB_XGEN(b.x)]) == gen, bar);
            __builtin_amdgcn_fence(__ATOMIC_ACQUIRE, "agent");
            asm volatile("s_waitcnt vmcnt(0)" ::: "memory");
        }
    }
    __syncthreads();
}


__global__ void __launch_bounds__(256, 2) fwd_megakernel(Params p) {
  cg::grid_group grid = cg::this_grid();
  __shared__ __attribute__((aligned(16))) char lds_arr[LDS_BYTES];
  const unsigned lds = (unsigned)(size_t)lds_arr;
  if (threadIdx.x < 16) *LDSP(unsigned, lds + 67520 + 4 * threadIdx.x) = 0u;
  __syncthreads();
  const XcdBarrier xb = xcd_barrier_post((unsigned*)(p.ws + OFF_BAR), (volatile LAS unsigned*)(lds + 67520));
#define GSYNC() xcd_barrier(xb)
  if (gridDim.x == 0x7fffffffu) grid.sync();
  const int G = gridDim.x, bid = blockIdx.x;
  for (int whole = 0; whole < (PROBE_REP == 6 ? 2 : 1); ++whole) {
  if (whole) GSYNC();
  for (int rep0 = 0; rep0 < (PROBE_REP == 4 ? 2 : 1); ++rep0) {
  for (int i = bid; i < 2 * P0_PER_LAYER; i += G) phase0_item(p, i, lds);
  for (int i = G - 1 - bid; i < 32; i += G) cbias_item(p, i, lds);
  if (bid == 0 && threadIdx.x < 128) ((unsigned*)(p.ws + OFF_KN2))[threadIdx.x] = 0u;
  for (int i = bid; i < 256; i += G) rope_item(p, i);
  for (int i = bid; i < BT / 4; i += G) norm_item(p.x, p.norm_g, (u16*)(p.ws + OFF_H), nullptr, i, nullptr, nullptr, nullptr, nullptr);
  }
  GSYNC();
  for (int l = 0; l < 2; ++l) {
    for (int rep = 0; rep < (PROBE_REP == 1 ? 2 : 1); ++rep) {
    if (rep) GSYNC();
    if (G == 512 && false) {
      const int xcd = bid & 7, lb = bid >> 3, y = xcd >> 1;
      for (int k = lb; k < 448; k += 64) {
        int mt, nt;
        if ((xcd & 1) == 0) {
          if (k < 256) { mt = k >> 2; nt = 7 * y + (k & 3); } else { const int k2 = k - 256; mt = 64 + k2 / 3; nt = 7 * y + k2 % 3; }
        } else {
          if (k < 192) { mt = k / 3; nt = 7 * y + 4 + k % 3; } else { const int k2 = k - 192; mt = 64 + (k2 >> 2); nt = 7 * y + 3 + (k2 & 3); }
        }
        gemm1_item(p, l, mt * 29 + nt, lds);
      }
    } else {
      for (int i = bid; i < 128 * 28; i += G) gemm1_item(p, l, (i / 28) * 29 + (i % 28), lds);
    }
    for (int i = bid; i < 128; i += G) tail_item(p, l, i);
    }
    GSYNC();
    {
      int i = bid;
      unsigned* qctr = (unsigned*)(p.ws + OFF_BAR) + 3600 + 64 * l;
      while (i < 64 + 512 + 256 + 1024) {
        if (i < 64) {
          compress_item(p, l, i, lds);
        } else if (i < 576) {
          fox_item(p, l, i - 64, lds);
        } else if (i < 832) {
          conv_item(p, l, i - 576, lds);
        } else {
          nsa_item32(p, l, i - 832, lds);
        }
        __syncthreads();
        if (threadIdx.x == 0) *LDSP(unsigned, lds + 67536) = (unsigned)G + __hip_atomic_fetch_add(qctr, 1u, __ATOMIC_RELAXED, __HIP_MEMORY_SCOPE_AGENT);
        __syncthreads();
        i = (int)*LDSP(unsigned, lds + 67536);
      }
    }
    GSYNC();
    if (G == 512) {
      const int xcd = bid & 7, lb = bid >> 3;
      for (int k = lb; k < 128; k += 64) gemm2_item(p, l, xcd * 128 + k, lds);
    } else {
      for (int i = bid; i < 1024; i += G) gemm2_item(p, l, i, lds);
    }
    GSYNC();
    if (l == 0) for (int i = bid; i < BT / 4; i += G) norm_item(p.out, p.norm_g + 1024, (u16*)(p.ws + OFF_H), nullptr, i, nullptr, nullptr, nullptr, nullptr);
    else for (int i = bid; i < BT / 4; i += G) norm_item(p.out, p.final_g, nullptr, p.out, i, nullptr, nullptr, nullptr, nullptr);
    if (l == 0) GSYNC();
  }
  }
}

__global__ void zero_mixed(unsigned* m, size_t n) {
  size_t i = (size_t)blockIdx.x * blockDim.x + threadIdx.x;
  if (i < n) m[i] = 0;
}

extern "C" void kernel_launch(void* const* d_in, const int* in_sizes, int n_in, void* d_out,
                              int out_size, void* d_ws, size_t ws_size, hipStream_t stream) {
  static int grid_blocks = 0;
  if (!grid_blocks) {
    int dev = 0, cus = 0, per_cu = 0;
    (void)hipGetDevice(&dev);
    (void)hipDeviceGetAttribute(&cus, hipDeviceAttributeMultiprocessorCount, dev);
    (void)hipOccupancyMaxActiveBlocksPerMultiprocessor(&per_cu, fwd_megakernel, 256, 0);
    if (per_cu > 2) per_cu = 2;
    if (per_cu < 1) per_cu = 1;
    grid_blocks = cus * per_cu;
  }
  Params p{};
  p.x = (const float*)d_in[0]; p.norm_g = (const float*)d_in[1]; p.w_in = (const float*)d_in[2]; p.fox_b = (const float*)d_in[3];
  p.conv_w = (const float*)d_in[4]; p.conv_b = (const float*)d_in[5]; p.conv_ln_g = (const float*)d_in[6]; p.conv_ln_b = (const float*)d_in[7];
  p.conv_pw = (const float*)d_in[8]; p.cmp_pe_k = (const float*)d_in[9]; p.cmp_pe_v = (const float*)d_in[10];
  p.cmp_k_w1 = (const float*)d_in[11]; p.cmp_k_w2 = (const float*)d_in[12]; p.cmp_v_w1 = (const float*)d_in[13]; p.cmp_v_w2 = (const float*)d_in[14];
  p.w_out = (const float*)d_in[15]; p.final_g = (const float*)d_in[16];
  p.out = (float*)d_out; p.ws = (char*)d_ws;
#if !(EN_FOX && EN_NSA)
  {
    size_t n = (size_t)BT * 1024 / 2;
    zero_mixed<<<(unsigned)((n + 255) / 256), 256, 0, stream>>>((unsigned*)((char*)d_ws + OFF_MIXED), n);
  }
#endif
  (void)hipMemsetAsync((char*)d_ws + OFF_BAR, 0, 16384, stream);
  void* args[] = {&p};
  hipError_t e = hipLaunchCooperativeKernel((void*)fwd_megakernel, dim3(grid_blocks), dim3(256), args, 0, stream);
  if (e != hipSuccess) fprintf(stderr, "cooperative launch failed: %s (grid %d)\n", hipGetErrorString(e), grid_blocks);
}
```

```cpp
#include <hip/hip_runtime.h>
#include <hip/hip_cooperative_groups.h>
#include <cstdio>
namespace cg = cooperative_groups;

#ifndef PROBE_REP
#define PROBE_REP 0
#endif
#ifndef EN_FOX
#define EN_FOX 1
#endif
#ifndef EN_NSA
#define EN_NSA 1
#endif

typedef unsigned short u16;
using bf16x8 = __attribute__((ext_vector_type(8))) short;
using f32x16 = __attribute__((ext_vector_type(16))) float;
using u32x4 = __attribute__((ext_vector_type(4))) unsigned;
using u32x2 = __attribute__((ext_vector_type(2))) unsigned;
using f32x4 = __attribute__((ext_vector_type(4))) float;
typedef __attribute__((ext_vector_type(2))) __bf16 bf2_t;
#define DI __device__ __forceinline__
#define EXP2(x) __builtin_amdgcn_exp2f(x)
#define MFMA(a, b, c) __builtin_amdgcn_mfma_f32_32x32x16_bf16((a), (b), (c), 0, 0, 0)

constexpr int T_ = 8192;
constexpr int BT = 16384;
constexpr int NPAD = 3712;
constexpr float LOG2E = 1.4426950408889634f;
constexpr int LDS_BYTES = 67584;

constexpr size_t SZ_WINT = (size_t)NPAD * 1024 * 2;
constexpr size_t OFF_WINT = 0;
constexpr size_t OFF_WOUTT = OFF_WINT + 2 * SZ_WINT;
constexpr size_t OFF_PWT = OFF_WOUTT + 2 * (size_t)1024 * 1024 * 2;
constexpr size_t OFF_W1T = OFF_PWT + 2 * (size_t)256 * 256 * 2;
constexpr size_t OFF_W2T = OFF_W1T + 4 * (size_t)256 * 2048 * 2;
constexpr size_t OFF_CBIAS = OFF_W2T + 4 * (size_t)128 * 256 * 2;
constexpr size_t OFF_ROPE = OFF_CBIAS + 4 * 256 * 4;
constexpr size_t OFF_H = OFF_ROPE + (size_t)8192 * 8 * 2 * 4;
constexpr size_t OFF_OSC = OFF_H;
constexpr size_t OFF_FQ = OFF_H + (size_t)BT * 1024 * 2;
constexpr size_t OFF_FK = OFF_FQ + (size_t)BT * 256 * 2;
constexpr size_t OFF_FVT = OFF_FK + (size_t)BT * 256 * 2;
constexpr size_t OFF_FLOG = OFF_FVT + (size_t)BT * 256 * 2;
constexpr size_t OFF_GATE = OFF_FLOG + (size_t)BT * 4 * 4;
constexpr size_t OFF_GLU = OFF_GATE + (size_t)BT * 1024 * 2;
constexpr size_t OFF_NQ = OFF_GLU + (size_t)BT * 512 * 2;
constexpr size_t OFF_KC = OFF_NQ + (size_t)BT * 512 * 2;
constexpr size_t SZ_KV = (size_t)BT * 128 * 2;
constexpr size_t OFF_VC = OFF_KC + SZ_KV;
constexpr size_t OFF_KS = OFF_VC + SZ_KV;
constexpr size_t OFF_VST = OFF_KS + SZ_KV;
constexpr size_t OFF_KW = OFF_VST + SZ_KV;
constexpr size_t OFF_VWT = OFF_KW + SZ_KV;
constexpr size_t OFF_NGL = OFF_VWT + SZ_KV;
constexpr size_t OFF_KCMP = OFF_NGL + (size_t)BT * 24 * 4;
constexpr size_t OFF_VCMPT = OFF_KCMP + (size_t)4 * 512 * 64 * 2;
constexpr size_t OFF_HID = OFF_VCMPT + (size_t)4 * 512 * 64 * 2;
constexpr size_t OFF_CONVA = OFF_HID + (size_t)32 * 128 * 256 * 2;
constexpr size_t OFF_MIXED = OFF_CONVA + (size_t)BT * 256 * 2;
constexpr size_t OFF_KN2 = OFF_MIXED + (size_t)BT * 1024 * 2;
constexpr size_t OFF_CNT = OFF_KN2 + 256;
constexpr size_t OFF_BAR = OFF_CNT + 256;
constexpr size_t OFF_WTAIL = OFF_BAR + 16384;
constexpr size_t OFF_ROWSS = OFF_WTAIL + (size_t)2 * 32 * 1024 * 4;
constexpr size_t WS_TOTAL = OFF_ROWSS + (size_t)BT * 4;
static_assert(WS_TOTAL <= (size_t)256 * 1024 * 1024, "ws too large");

struct Params {
  const float* x; const float* norm_g; const float* w_in; const float* fox_b; const float* conv_w; const float* conv_b;
  const float* conv_ln_g; const float* conv_ln_b; const float* conv_pw; const float* cmp_pe_k; const float* cmp_pe_v;
  const float* cmp_k_w1; const float* cmp_k_w2; const float* cmp_v_w1; const float* cmp_v_w2; const float* w_out; const float* final_g;
  float* out; char* ws;
};

DI int ltid() { int t = threadIdx.x; asm volatile("" : "+v"(t)); return t; }
DI char* lptr(char* q) { int z = 0; asm volatile("" : "+s"(z)); return q + z; }
#define LDSP(T, a) ((__attribute__((address_space(3))) T*)(a))
DI int tl_of(int ni) { const int t = ltid(); return ((t >> 6) << 4) + 8 * ni + ((t & 31) >> 2); }
DI int h_of() { return (ltid() >> 5) & 1; }
DI u16 f2bf(float x) { __bf16 b = (__bf16)x; return __builtin_bit_cast(u16, b); }
DI unsigned pk2(float x, float y) { bf2_t v; v[0] = (__bf16)x; v[1] = (__bf16)y; return __builtin_bit_cast(unsigned, v); }
DI float bf2f(u16 v) { return __uint_as_float(((unsigned)v) << 16); }
DI float bflo(unsigned v) { return __uint_as_float(v << 16); }
DI float bfhi(unsigned v) { return __uint_as_float(v & 0xffff0000u); }
DI int vperm16(int t) { return (t & ~15) | (t & 3) | ((t & 4) << 1) | ((t & 8) >> 1); }
DI int crow(int reg, int h) { return (reg & 3) + 8 * (reg >> 2) + 4 * h; }
DI float siluf(float x) { return x / (1.f + __expf(-x)); }
DI float sigmf(float x) { return 1.f / (1.f + __expf(-x)); }
DI float geluf(float x) { return 0.5f * x * (1.f + tanhf(0.7978845608028654f * (x + 0.044715f * x * x * x))); }
DI int swz(int row, int chunk) { return row * 128 + ((chunk ^ ((row >> 1) & 7)) << 4); }
DI void zero_acc(f32x16 (&a)[2][2]) {
#pragma unroll
  for (int i = 0; i < 2; ++i)
#pragma unroll
    for (int j = 0; j < 2; ++j)
#pragma unroll
      for (int k = 0; k < 16; ++k) a[i][j][k] = 0.f;
}

DI int swz32(int row, int chunk) { return row * 64 + ((chunk ^ ((row >> 2) & 3)) << 4); }
template <bool SWAP>
DI void gemm_tile(const u16* __restrict__ A, long lda, const u16* __restrict__ B, long ldb, int K, unsigned lds, f32x16 (&acc)[2][2]) {
  const int tid = ltid(), lane = tid & 63, w = tid >> 6, wr = w >> 1, wc = w & 1, r = lane & 31, h = lane >> 5;
  zero_acc(acc);
  const int lrow = tid >> 2, lch = tid & 3;
  const u16* ga = A + (long)lrow * lda + lch * 8;
  const u16* gb = B + (long)lrow * ldb + lch * 8;
  const long a64 = 64 * lda, b64 = 64 * ldb;
  const int n2 = K >> 6;
  u32x4 a0[4], a1[4], b0[4], b1[4];
#define GLOAD(S, J) { S[0] = *(const u32x4*)(ga + (J) * 32); S[1] = *(const u32x4*)(ga + a64 + (J) * 32); S[2] = *(const u32x4*)(gb + (J) * 32); S[3] = *(const u32x4*)(gb + b64 + (J) * 32); }
#define SWRITE(S, OFF) { const unsigned bb = lds + (OFF); *LDSP(u32x4, bb + swz32(lrow, lch)) = S[0]; *LDSP(u32x4, bb + swz32(lrow + 64, lch)) = S[1]; \
                         *LDSP(u32x4, bb + 8192 + swz32(lrow, lch)) = S[2]; *LDSP(u32x4, bb + 8192 + swz32(lrow + 64, lch)) = S[3]; }
#define COMPUTE(OFF) { const unsigned As = lds + (OFF); const unsigned Bs = As + 8192; \
    _Pragma("unroll") for (int ks = 0; ks < 2; ++ks) { bf16x8 af[2], bf[2]; \
      _Pragma("unroll") for (int i = 0; i < 2; ++i) { af[i] = *LDSP(bf16x8, As + swz32(64 * wr + 32 * i + r, 2 * ks + h)); bf[i] = *LDSP(bf16x8, Bs + swz32(64 * wc + 32 * i + r, 2 * ks + h)); } \
      _Pragma("unroll") for (int mi = 0; mi < 2; ++mi) _Pragma("unroll") for (int ni = 0; ni < 2; ++ni) { \
        if (SWAP) acc[mi][ni] = MFMA(bf[ni], af[mi], acc[mi][ni]); else acc[mi][ni] = MFMA(af[mi], bf[ni], acc[mi][ni]); } } }
  GLOAD(a0, 0)
  GLOAD(a1, 1)
  if (n2 > 1) { GLOAD(b0, 2) GLOAD(b1, 3) }
  __syncthreads();
  SWRITE(a0, 0)
  SWRITE(a1, 16384)
  if (n2 > 2) { GLOAD(a0, 4) GLOAD(a1, 5) }
  __syncthreads();
  int t = 0;
  while (true) {
    COMPUTE(0)
    COMPUTE(16384)
    if (t + 1 < n2) { SWRITE(b0, 32768) SWRITE(b1, 49152) }
    if (t + 3 < n2) { GLOAD(b0, 2 * (t + 3)) GLOAD(b1, 2 * (t + 3) + 1) }
    __syncthreads();
    if (++t >= n2) break;
    COMPUTE(32768)
    COMPUTE(49152)
    if (t + 1 < n2) { SWRITE(a0, 0) SWRITE(a1, 16384) }
    if (t + 3 < n2) { GLOAD(a0, 2 * (t + 3)) GLOAD(a1, 2 * (t + 3) + 1) }
    __syncthreads();
    if (++t >= n2) break;
  }
#undef GLOAD
#undef SWRITE
#undef COMPUTE
}

DI int win_srccol(int n) {
  if (n < 768) return n;
  if (n < 3072) return n + 4;
  if (n < 3584) return n + 28;
  int i = n - 3584;
  if (i < 4) return 768 + i;
  if (i < 28) return 3076 + (i - 4);
  return -1;
}

DI void transpose_tile(const float* __restrict__ src, int ld, int K, int mapkind, int nsrc, u16* __restrict__ dst, int k0, int n0, unsigned lds) {
  const int tid = ltid(), j = tid & 63, i0 = tid >> 6;
  const int n = n0 + j;
  const int sc = mapkind ? win_srccol(n) : (n < nsrc ? n : -1);
  float v[16];
#pragma unroll
  for (int it = 0; it < 16; ++it) v[it] = (sc >= 0) ? src[(size_t)(k0 + i0 + 4 * it) * ld + sc] : 0.f;
  __syncthreads();
#pragma unroll
  for (int it = 0; it < 16; ++it) *LDSP(float, lds + 4 * ((i0 + 4 * it) * 65 + j)) = v[it];
  __syncthreads();
  const int jn = tid >> 2, kc = (tid & 3) * 16;
  u32x4 o0, o1;
#pragma unroll
  for (int e = 0; e < 4; ++e) {
    o0[e] = pk2(*LDSP(float, lds + 4 * ((kc + 2 * e) * 65 + jn)), *LDSP(float, lds + 4 * ((kc + 2 * e + 1) * 65 + jn)));
    o1[e] = pk2(*LDSP(float, lds + 4 * ((kc + 8 + 2 * e) * 65 + jn)), *LDSP(float, lds + 4 * ((kc + 8 + 2 * e + 1) * 65 + jn)));
  }
  u16* dp = dst + (size_t)(n0 + jn) * K + k0 + kc;
  *(u32x4*)dp = o0;
  *(u32x4*)(dp + 8) = o1;
}

constexpr int P0_PER_LAYER = 928 + 256 + 16 + 256 + 16;
DI void phase0_item(const Params& p, int idx, unsigned lds) {
  const int l = idx / P0_PER_LAYER;
  int r = idx % P0_PER_LAYER;
  char* ws = lptr(p.ws);
  if (r < 928) {
    transpose_tile(p.w_in + (size_t)l * 1024 * 3612, 3612, 1024, 1, 0, (u16*)(ws + OFF_WINT + l * SZ_WINT), (r % 16) * 64, (r / 16) * 64, lds);
    return;
  }
  r -= 928;
  if (r < 256) {
    transpose_tile(p.w_out + (size_t)l * 1024 * 1024, 1024, 1024, 0, 1024, (u16*)(ws + OFF_WOUTT) + (size_t)l * 1024 * 1024, (r % 16) * 64, (r / 16) * 64, lds);
    return;
  }
  r -= 256;
  if (r < 16) {
    transpose_tile(p.conv_pw + (size_t)l * 256 * 256, 256, 256, 0, 256, (u16*)(ws + OFF_PWT) + (size_t)l * 256 * 256, (r % 4) * 64, (r / 4) * 64, lds);
    return;
  }
  r -= 16;
  if (r < 256) {
    const int kv = r >> 7; r &= 127;
    const float* src = (kv ? p.cmp_v_w1 : p.cmp_k_w1) + (size_t)l * 2048 * 256;
    transpose_tile(src, 256, 2048, 0, 256, (u16*)(ws + OFF_W1T) + (size_t)(l * 2 + kv) * 256 * 2048, (r % 32) * 64, (r / 32) * 64, lds);
    return;
  }
  r -= 256;
  {
    const int kv = r >> 3; r &= 7;
    const float* src = (kv ? p.cmp_v_w2 : p.cmp_k_w2) + (size_t)l * 256 * 64;
    transpose_tile(src, 64, 256, 0, 64, (u16*)(ws + OFF_W2T) + (size_t)(l * 2 + kv) * 128 * 256, (r % 4) * 64, (r / 4) * 64, lds);
  }
}

DI void cbias_item(const Params& p, int item, unsigned lds) {
  const int idx = item >> 3, ng = item & 7;
  const int l = idx >> 1, kv = idx & 1;
  const float* pe = (kv ? p.cmp_pe_v : p.cmp_pe_k) + (size_t)l * 2048;
  const float* w1 = (kv ? p.cmp_v_w1 : p.cmp_k_w1) + (size_t)l * 2048 * 256;
  const int tid = ltid(), nn = tid & 31, ksl = tid >> 5;
  const int n = ng * 32 + nn;
  float s0 = 0.f, s1 = 0.f, s2 = 0.f, s3 = 0.f;
  const float* wp = w1 + (size_t)(ksl * 256) * 256 + n;
  const float* pp = pe + ksl * 256;
#pragma unroll 4
  for (int i = 0; i < 256; i += 4) {
    s0 = fmaf(pp[i], wp[(size_t)i * 256], s0);
    s1 = fmaf(pp[i + 1], wp[(size_t)(i + 1) * 256], s1);
    s2 = fmaf(pp[i + 2], wp[(size_t)(i + 2) * 256], s2);
    s3 = fmaf(pp[i + 3], wp[(size_t)(i + 3) * 256], s3);
  }
  __syncthreads();
  *LDSP(float, lds + 4 * tid) = (s0 + s1) + (s2 + s3);
  __syncthreads();
  if (tid < 32) {
    float t = 0.f;
#pragma unroll
    for (int k = 0; k < 8; ++k) t += *LDSP(float, lds + 4 * (k * 32 + tid));
    ((float*)(p.ws + OFF_CBIAS))[idx * 256 + n] = t;
  }
}

DI void rope_item(const Params& p, int idx) {
  const int e = idx * 256 + ltid();
  const int pos = e >> 3, i = e & 7;
  const float inv = powf(500000.0f, -(float)(2 * i) / 16.0f);
  const float ang = (float)pos * inv;
  float2 cs; cs.x = cosf(ang); cs.y = sinf(ang);
  ((float2*)(p.ws + OFF_ROPE))[e] = cs;
}

DI void wtail_item(const Params& p, int item) {
  const int l = item >> 5, j = item & 31;
  float* dst = (float*)(p.ws + OFF_WTAIL) + (size_t)item * 1024;
  const int tid = ltid();
  const int col = (j < 4) ? 768 + j : 3076 + (j - 4);
#pragma unroll
  for (int i = 0; i < 4; ++i) {
    const int k = tid + 256 * i;
    dst[k] = (j < 28) ? p.w_in[((size_t)l * 1024 + k) * 3612 + col] : 0.f;
  }
}

DI void norm_item(const float* __restrict__ src, const float* __restrict__ g, u16* dstb, float* dstf, int item,
                  const float* __restrict__ wt, const float* __restrict__ foxb, float* flog, float* ngl) {
  const int tid_ = ltid(); const int lane = tid_ & 63, w = tid_ >> 6;
  const int row = item * 4 + w;
  const float4* s4 = (const float4*)(src + (size_t)row * 1024);
  float4 v[4];
  float ss = 0.f;
#pragma unroll
  for (int i = 0; i < 4; ++i) { v[i] = s4[lane + 64 * i]; ss += v[i].x * v[i].x + v[i].y * v[i].y + v[i].z * v[i].z + v[i].w * v[i].w; }
#pragma unroll
  for (int o = 32; o > 0; o >>= 1) ss += __shfl_xor(ss, o);
  const float rs = rsqrtf(ss * (1.0f / 1024.0f) + 1e-6f);
#pragma unroll
  for (int i = 0; i < 4; ++i) {
    float4 gg = ((const float4*)g)[lane + 64 * i];
    float4 o = {v[i].x * rs * gg.x, v[i].y * rs * gg.y, v[i].z * rs * gg.z, v[i].w * rs * gg.w};
    v[i] = o;
    if (dstb) {
      u32x2 pk; pk[0] = pk2(o.x, o.y); pk[1] = pk2(o.z, o.w);
      *(u32x2*)(dstb + (size_t)row * 1024 + (lane + 64 * i) * 4) = pk;
    } else {
      ((float4*)(dstf + (size_t)row * 1024))[lane + 64 * i] = o;
    }
  }
  if (wt) {
    float a[32];
#pragma unroll
    for (int j = 0; j < 32; ++j) {
      float acc = 0.f;
      if (j < 28) {
#pragma unroll
        for (int i = 0; i < 4; ++i) {
          const float4 ww = ((const float4*)(wt + (size_t)j * 1024))[lane + 64 * i];
          acc = fmaf(v[i].x, ww.x, acc); acc = fmaf(v[i].y, ww.y, acc); acc = fmaf(v[i].z, ww.z, acc); acc = fmaf(v[i].w, ww.w, acc);
        }
      }
      a[j] = acc;
    }
#pragma unroll
    for (int t = 0; t < 16; ++t) { const bool up = (lane & 32) != 0; const float send = up ? a[t] : a[t + 16]; const float keep = up ? a[t + 16] : a[t]; a[t] = keep + __shfl_xor(send, 32); }
#pragma unroll
    for (int t = 0; t < 8; ++t) { const bool up = (lane & 16) != 0; const float send = up ? a[t] : a[t + 8]; const float keep = up ? a[t + 8] : a[t]; a[t] = keep + __shfl_xor(send, 16); }
#pragma unroll
    for (int t = 0; t < 4; ++t) { const bool up = (lane & 8) != 0; const float send = up ? a[t] : a[t + 4]; const float keep = up ? a[t + 4] : a[t]; a[t] = keep + __shfl_xor(send, 8); }
#pragma unroll
    for (int t = 0; t < 2; ++t) { const bool up = (lane & 4) != 0; const float send = up ? a[t] : a[t + 2]; const float keep = up ? a[t + 2] : a[t]; a[t] = keep + __shfl_xor(send, 4); }
    { const bool up = (lane & 2) != 0; const float send = up ? a[0] : a[1]; const float keep = up ? a[1] : a[0]; a[0] = keep + __shfl_xor(send, 2); }
    a[0] += __shfl_xor(a[0], 1);
    const int col = lane >> 1;
    if ((lane & 1) == 0) {
      const float val = a[0];
      if (col < 4) {
        const float xx = val + foxb[col];
        flog[(size_t)row * 4 + col] = fminf(xx, 0.f) - __logf(1.f + __expf(-fabsf(xx)));
      } else if (col < 28) {
        ngl[(size_t)row * 24 + (col - 4)] = sigmf(val);
      }
    }
  }
}

DI void gemm1_item(const Params& p, int l, int item, unsigned lds) {
  const int mt = item / 29, nt = item % 29;
  const int m0 = mt * 128;
  char* ws = lptr(p.ws);
  const u16* A = (const u16*)(ws + OFF_H) + (size_t)m0 * 1024;
  const u16* B = (const u16*)(ws + OFF_WINT + l * SZ_WINT) + (size_t)nt * 128 * 1024;
  const bool swap = (nt == 4 || nt == 5 || nt == 21 || nt == 23);
  f32x16 acc[2][2];
  if (swap) gemm_tile<true>(A, 1024, B, 1024, 1024, lds, acc);
  else gemm_tile<false>(A, 1024, B, 1024, 1024, lds, acc);
  const int tid = ltid(), lane = tid & 63, w = tid >> 6, wr = w >> 1, wc = w & 1, r = lane & 31, h = lane >> 5;
  const int b = m0 >> 13, t0 = m0 & 8191;
  if (l == 1) {
    const float* rowss = (const float*)(ws + OFF_ROWSS);
#pragma unroll
    for (int mi = 0; mi < 2; ++mi) {
      if (swap) {
        const float rs = rsqrtf(rowss[m0 + 64 * wr + 32 * mi + r] * (1.0f / 1024.0f) + 1e-6f);
#pragma unroll
        for (int ni = 0; ni < 2; ++ni)
#pragma unroll
          for (int reg = 0; reg < 16; ++reg) acc[mi][ni][reg] *= rs;
      } else {
#pragma unroll
        for (int reg = 0; reg < 16; ++reg) {
          const float rs = rsqrtf(rowss[m0 + 64 * wr + 32 * mi + crow(reg, h)] * (1.0f / 1024.0f) + 1e-6f);
          acc[mi][0][reg] *= rs; acc[mi][1][reg] *= rs;
        }
      }
    }
  }
  if (swap) {
    u16* base;
    if (nt == 4 || nt == 5) { const int head = (nt - 4) * 2 + wc; base = (u16*)(ws + OFF_FVT) + (size_t)(b * 4 + head) * 64 * T_; }
    else if (nt == 21) base = (u16*)(ws + OFF_VST) + (size_t)(b * 2 + wc) * 64 * T_;
    else base = (u16*)(ws + OFF_VWT) + (size_t)(b * 2 + wc) * 64 * T_;
#pragma unroll
    for (int mi = 0; mi < 2; ++mi)
#pragma unroll
      for (int ni = 0; ni < 2; ++ni)
#pragma unroll
        for (int reg = 0; reg < 16; ++reg) {
          const int d = 32 * ni + crow(reg, h);
          const int t = vperm16(t0 + 64 * wr + 32 * mi + r);
          base[(size_t)d * T_ + t] = f2bf(acc[mi][ni][reg]);
        }
    return;
  }
  if (nt < 4 || nt == 18 || nt == 19 || nt == 20 || nt == 22 || (nt >= 14 && nt <= 17)) {
    u16* base; long rstride; float scale = 1.f; bool rope = false;
    if (nt < 2) { base = (u16*)(ws + OFF_FQ) + ((size_t)(b * 4 + nt * 2 + wc) * T_ + t0) * 64; rstride = 64; scale = 0.125f; }
    else if (nt < 4) { base = (u16*)(ws + OFF_FK) + ((size_t)(b * 4 + (nt - 2) * 2 + wc) * T_ + t0) * 64; rstride = 64; }
    else if (nt >= 14 && nt <= 17) {
      const int head8 = (nt - 14) * 2 + wc, g = head8 >> 2, hh = head8 & 3;
      base = (u16*)(ws + OFF_NQ) + (((size_t)(b * 2 + g) * T_ + t0) * 4 + hh) * 64; rstride = 256; scale = 0.125f; rope = true;
    } else {
      const size_t off = (nt == 18) ? OFF_KC : (nt == 19) ? OFF_VC : (nt == 20) ? OFF_KS : OFF_KW;
      base = (u16*)(ws + off) + ((size_t)(b * 2 + wc) * T_ + t0) * 64; rstride = 64; rope = (nt == 20 || nt == 22);
    }
    const float2* rt = (const float2*)(ws + OFF_ROPE);
    if (nt == 2 || nt == 3) {
      float mxn = 0.f;
#pragma unroll
      for (int mi = 0; mi < 2; ++mi)
#pragma unroll
        for (int reg = 0; reg < 16; ++reg) {
          const float a0 = bf2f(f2bf(acc[mi][0][reg])), a1 = bf2f(f2bf(acc[mi][1][reg]));
          float ss = a0 * a0 + a1 * a1;
          ss += __shfl_xor(ss, 1); ss += __shfl_xor(ss, 2); ss += __shfl_xor(ss, 4); ss += __shfl_xor(ss, 8); ss += __shfl_xor(ss, 16);
          mxn = fmaxf(mxn, ss);
        }
      mxn = fmaxf(mxn, __shfl_xor(mxn, 32));
      if (lane == 0) atomicMax((unsigned*)(ws + OFF_KN2) + l * 8 + b * 4 + (nt - 2) * 2 + wc, __float_as_uint(mxn));
    }
#pragma unroll
    for (int mi = 0; mi < 2; ++mi)
#pragma unroll
      for (int ni = 0; ni < 2; ++ni)
#pragma unroll
        for (int reg = 0; reg < 16; ++reg) {
          const int row = 64 * wr + 32 * mi + crow(reg, h);
          float v = acc[mi][ni][reg];
          if (ni == 0 && rope) {
            const float pv = __shfl_xor(v, 8);
            if (r < 16) {
              const float2 cs = rt[(t0 + row) * 8 + (r & 7)];
              v = (r & 8) ? (pv * cs.y + v * cs.x) : (v * cs.x - pv * cs.y);
            }
          }
          base[(size_t)row * rstride + 32 * ni + r] = f2bf(v * scale);
        }
    return;
  }
  if (nt == 28) {
    float* flog = (float*)(ws + OFF_FLOG);
    float* ngl = (float*)(ws + OFF_NGL);
    if (wc == 0) {
      const int col = r;
      const float fb = (col < 4) ? p.fox_b[l * 4 + col] : 0.f;
#pragma unroll
      for (int mi = 0; mi < 2; ++mi)
#pragma unroll
        for (int reg = 0; reg < 16; ++reg) {
          const int m = m0 + 64 * wr + 32 * mi + crow(reg, h);
          const float v = acc[mi][0][reg];
          if (col < 4) {
            const float xx = v + fb;
            flog[(size_t)m * 4 + col] = fminf(xx, 0.f) - __logf(1.f + __expf(-fabsf(xx)));
          } else if (col < 28) {
            ngl[(size_t)m * 24 + (col - 4)] = sigmf(v);
          }
        }
    }
    return;
  }
  {
    u16* base; int ld; bool silu = true;
    if (nt == 6 || nt == 7) { base = (u16*)(ws + OFF_GATE) + (nt - 6) * 128; ld = 1024; }
    else if (nt >= 8 && nt <= 11) { base = (u16*)(ws + OFF_GLU) + (nt - 8) * 128; ld = 512; silu = false; }
    else if (nt == 12 || nt == 13) { base = (u16*)(ws + OFF_GATE) + 256 + (nt - 12) * 128; ld = 1024; }
    else { base = (u16*)(ws + OFF_GATE) + 512 + (nt - 24) * 128; ld = 1024; }
#pragma unroll
    for (int mi = 0; mi < 2; ++mi)
#pragma unroll
      for (int ni = 0; ni < 2; ++ni)
#pragma unroll
        for (int reg = 0; reg < 16; ++reg) {
          const int m = m0 + 64 * wr + 32 * mi + crow(reg, h);
          float v = acc[mi][ni][reg];
          if (silu) v = siluf(v);
          base[(size_t)m * ld + 64 * wc + 32 * ni + r] = f2bf(v);
        }
  }
}

DI void tail_item(const Params& p, int l, int mt) {
  char* ws = lptr(p.ws);
  const int tid = ltid(), lane = tid & 63, w = tid >> 6, r = lane & 31, h = lane >> 5;
  const int m0 = mt * 128;
  const u16* ap = (const u16*)(ws + OFF_H) + (size_t)(m0 + 32 * w + r) * 1024 + 8 * h;
  const u16* bp = (const u16*)(ws + OFF_WINT + l * SZ_WINT) + (size_t)(3584 + r) * 1024 + 8 * h;
  f32x16 acc0, acc1;
#pragma unroll
  for (int k = 0; k < 16; ++k) { acc0[k] = 0.f; acc1[k] = 0.f; }
  for (int kb = 0; kb < 8; ++kb) {
    bf16x8 af[8], bf[8];
#pragma unroll
    for (int ks = 0; ks < 8; ++ks) { af[ks] = *(const bf16x8*)(ap + (kb * 8 + ks) * 16); bf[ks] = *(const bf16x8*)(bp + (kb * 8 + ks) * 16); }
#pragma unroll
    for (int ks = 0; ks < 8; ks += 2) { acc0 = MFMA(af[ks], bf[ks], acc0); acc1 = MFMA(af[ks + 1], bf[ks + 1], acc1); }
  }
  float* flog = (float*)(ws + OFF_FLOG);
  float* ngl = (float*)(ws + OFF_NGL);
  const int col = r;
  const float fb = (col < 4) ? p.fox_b[l * 4 + col] : 0.f;
#pragma unroll
  for (int reg = 0; reg < 16; ++reg) {
    const int m = m0 + 32 * w + crow(reg, h);
    float v = acc0[reg] + acc1[reg];
    if (l == 1) v *= rsqrtf(((const float*)(ws + OFF_ROWSS))[m] * (1.0f / 1024.0f) + 1e-6f);
    if (col < 4) {
      const float xx = v + fb;
      flog[(size_t)m * 4 + col] = fminf(xx, 0.f) - __logf(1.f + __expf(-fabsf(xx)));
    } else if (col < 28) {
      ngl[(size_t)m * 24 + (col - 4)] = sigmf(v);
    }
  }
}

DI void gemm2_item(const Params& p, int l, int item, unsigned lds) {
  const int mt = item >> 3, nt = item & 7;
  const int m0 = mt * 128, n0 = nt * 128;
  char* ws = lptr(p.ws);
  const u16* A = (const u16*)(ws + OFF_MIXED) + (size_t)m0 * 1024;
  const u16* B = (const u16*)(ws + OFF_WOUTT) + (size_t)l * 1024 * 1024 + (size_t)n0 * 1024;
  f32x16 acc[2][2];
  gemm_tile<true>(A, 1024, B, 1024, 1024, lds, acc);
  const int tid = ltid(), lane = tid & 63, w = tid >> 6, wr = w >> 1, wc = w & 1, r = lane & 31, h = lane >> 5;
  const float* res = (l == 0) ? p.x : p.out;
  u16* hb = (u16*)(ws + OFF_H);
  float* rowss = (float*)(ws + OFF_ROWSS);
#pragma unroll
  for (int mi = 0; mi < 2; ++mi) {
    const int m = m0 + 64 * wr + 32 * mi + r;
    float ssq = 0.f;
#pragma unroll
    for (int ni = 0; ni < 2; ++ni)
#pragma unroll
      for (int g4 = 0; g4 < 4; ++g4) {
        const int c0 = n0 + 64 * wc + 32 * ni + 8 * g4 + 4 * h;
        const size_t idx = (size_t)m * 1024 + c0;
        const float4 rv = *(const float4*)(res + idx);
        float4 v = {rv.x + acc[mi][ni][4 * g4], rv.y + acc[mi][ni][4 * g4 + 1], rv.z + acc[mi][ni][4 * g4 + 2], rv.w + acc[mi][ni][4 * g4 + 3]};
        *(float4*)(p.out + idx) = v;
        if (l == 0) {
          const float4 gv = *(const float4*)(p.norm_g + 1024 + c0);
          u32x2 o; o[0] = pk2(v.x * gv.x, v.y * gv.y); o[1] = pk2(v.z * gv.z, v.w * gv.w);
          *(u32x2*)(hb + idx) = o;
          ssq = fmaf(v.x, v.x, ssq); ssq = fmaf(v.y, v.y, ssq); ssq = fmaf(v.z, v.z, ssq); ssq = fmaf(v.w, v.w, ssq);
        }
      }
    if (l == 0) {
      ssq += __shfl_xor(ssq, 32);
      if (h == 0) unsafeAtomicAdd(rowss + m, ssq);
    }
  }
}

DI void conv_item(const Params& p, int l, int item, unsigned lds) {
  char* ws = lptr(p.ws);
  const int m0 = item * 64, t0 = m0 & 8191;
  const int tid = ltid(), lane = tid & 63, w = tid >> 6;
  const u16* glu = (const u16*)(ws + OFF_GLU);
  const unsigned at = lds + 32768;
  {
    f32x4 wt[31];
    const float* cw = p.conv_w + (size_t)l * 31 * 256 + lane * 4;
#pragma unroll
    for (int k = 0; k < 31; ++k) wt[k] = *(const f32x4*)(cw + k * 256);
    const float4 cb = *(const float4*)(p.conv_b + l * 256 + lane * 4);
    const float4 lg = *(const float4*)(p.conv_ln_g + l * 256 + lane * 4);
    const float4 lb = *(const float4*)(p.conv_ln_b + l * 256 + lane * 4);
    for (int sub = 0; sub < 2; ++sub) {
      const int ts = t0 + 32 * sub;
      __syncthreads();
      {
        const int c8 = (tid & 31) * 8, rsub = tid >> 5;
#pragma unroll
        for (int pb = 0; pb < 8; pb += 4) {
          u32x4 av[4], bv[4];
#pragma unroll
          for (int q = 0; q < 4; ++q) {
            const int i = (pb + q) * 8 + rsub;
            int t = ts - 30 + i; if (t < 0) t = 0; if (t > T_ - 1) t = T_ - 1;
            const size_t m = (size_t)(m0 - t0 + t);
            av[q] = *(const u32x4*)(glu + m * 512 + c8);
            bv[q] = *(const u32x4*)(glu + m * 512 + 256 + c8);
          }
#pragma unroll
          for (int q = 0; q < 4; ++q) {
            const int i = (pb + q) * 8 + rsub;
            const bool ok = (ts - 30 + i) >= 0;
            u32x4 yv;
#pragma unroll
            for (int e = 0; e < 4; ++e) {
              const unsigned y = pk2(bflo(av[q][e]) * sigmf(bflo(bv[q][e])), bfhi(av[q][e]) * sigmf(bfhi(bv[q][e])));
              yv[e] = ok ? y : 0u;
            }
            if (i < 62) *LDSP(u32x4, lds + i * 512 + c8 * 2) = yv;
          }
        }
      }
      __syncthreads();
#pragma unroll 2
      for (int j = 0; j < 8; ++j) {
        const int tt = 8 * w + j;
        float4 o = cb;
#pragma unroll
        for (int k = 0; k < 31; ++k) {
          const u32x2 yy = *LDSP(u32x2, lds + (tt + k) * 512 + lane * 8);
          o.x = fmaf(wt[k][0], bflo(yy[0]), o.x);
          o.y = fmaf(wt[k][1], bfhi(yy[0]), o.y);
          o.z = fmaf(wt[k][2], bflo(yy[1]), o.z);
          o.w = fmaf(wt[k][3], bfhi(yy[1]), o.w);
        }
        float s = o.x + o.y + o.z + o.w;
#pragma unroll
        for (int of = 32; of > 0; of >>= 1) s += __shfl_xor(s, of);
        const float mu = s * (1.f / 256.f);
        const float dx = o.x - mu, dy = o.y - mu, dz = o.z - mu, dw = o.w - mu;
        float vs = dx * dx + dy * dy + dz * dz + dw * dw;
#pragma unroll
        for (int of = 32; of > 0; of >>= 1) vs += __shfl_xor(vs, of);
        const float rs = rsqrtf(vs * (1.f / 256.f) + 1e-6f);
        const float y0 = siluf(dx * rs * lg.x + lb.x), y1 = siluf(dy * rs * lg.y + lb.y);
        const float y2 = siluf(dz * rs * lg.z + lb.z), y3 = siluf(dw * rs * lg.w + lb.w);
        u32x2 pk; pk[0] = pk2(y0, y1); pk[1] = pk2(y2, y3);
        const int row = 32 * sub + tt;
        *LDSP(u32x2, at + row * 512 + (((lane >> 1) ^ (row & 15)) << 4) + 8 * (lane & 1)) = pk;
      }
    }
  }
  __syncthreads();
  const int r = lane & 31, h = lane >> 5;
  const u16* pw = (const u16*)(ws + OFF_PWT) + (size_t)l * 65536 + (size_t)(64 * w + r) * 256 + 8 * h;
  f32x16 acc[2][2];
  zero_acc(acc);
#pragma unroll
  for (int kb = 0; kb < 2; ++kb) {
    bf16x8 bfr[8][2];
#pragma unroll
    for (int ks = 0; ks < 8; ++ks)
#pragma unroll
      for (int ni = 0; ni < 2; ++ni) bfr[ks][ni] = *(const bf16x8*)(pw + (size_t)ni * 32 * 256 + (kb * 8 + ks) * 16);
#pragma unroll
    for (int ks = 0; ks < 8; ++ks) {
      const int kk = kb * 8 + ks;
      bf16x8 af[2];
#pragma unroll
      for (int mi = 0; mi < 2; ++mi) { const int row = 32 * mi + r; af[mi] = *LDSP(bf16x8, at + row * 512 + (((2 * kk + h) ^ (row & 15)) << 4)); }
#pragma unroll
      for (int mi = 0; mi < 2; ++mi)
#pragma unroll
        for (int ni = 0; ni < 2; ++ni) acc[mi][ni] = MFMA(af[mi], bfr[ks][ni], acc[mi][ni]);
    }
  }
  const u16* gate = (const u16*)(ws + OFF_GATE);
  u16* mixed = (u16*)(ws + OFF_MIXED);
#pragma unroll
  for (int mi = 0; mi < 2; ++mi)
#pragma unroll
    for (int ni = 0; ni < 2; ++ni)
#pragma unroll
      for (int reg = 0; reg < 16; ++reg) {
        const size_t idx = (size_t)(m0 + 32 * mi + crow(reg, h)) * 1024 + 256 + 64 * w + 32 * ni + r;
        mixed[idx] = f2bf(acc[mi][ni][reg] * bf2f(gate[idx]));
      }
}

DI void compress_item(const Params& p, int l, int item64, unsigned lds) {
  char* ws = lptr(p.ws);
  const int nh = item64 & 1, item = item64 >> 1;
  const int mtile = item & 3, kv = (item >> 2) & 1, bg = item >> 3;
  const u16* src = (const u16*)(ws + (kv ? OFF_VC : OFF_KC)) + ((size_t)bg * T_ + (size_t)16 * 128 * mtile) * 64;
  const u16* w1t = (const u16*)(ws + OFF_W1T) + (size_t)(l * 2 + kv) * 256 * 2048;
  const u16* w2t = (const u16*)(ws + OFF_W2T) + (size_t)(l * 2 + kv) * 128 * 256;
  const float* bias = (const float*)(ws + OFF_CBIAS) + (l * 2 + kv) * 256;
  u16* hid = (u16*)(ws + OFF_HID) + (size_t)item * 128 * 256;
  const int tid = ltid(), lane = tid & 63, w = tid >> 6, wr = w >> 1, wc = w & 1, r = lane & 31, h = lane >> 5;
  {
    f32x16 acc[2][2];
    gemm_tile<false>(src, 1024, w1t + (size_t)nh * 128 * 2048, 2048, 2048, lds, acc);
#pragma unroll
    for (int ni = 0; ni < 2; ++ni) {
      const int col = nh * 128 + 64 * wc + 32 * ni + r;
      const float bb = bias[col];
#pragma unroll
      for (int mi = 0; mi < 2; ++mi)
#pragma unroll
        for (int reg = 0; reg < 16; ++reg) {
          const int row = 64 * wr + 32 * mi + crow(reg, h);
          hid[(size_t)row * 256 + col] = f2bf(geluf(acc[mi][ni][reg] + bb));
        }
    }
  }
  __threadfence();
  __syncthreads();
  if (tid == 0) {
    const int old = atomicAdd((int*)(ws + OFF_CNT) + l * 32 + item, 1);
    *LDSP(int, lds) = old;
  }
  __syncthreads();
  const int arrived = *LDSP(int, lds);
  if (arrived == 0) return;
  __threadfence();
  f32x16 acc[2][2];
  if (kv == 0) {
    gemm_tile<false>(hid, 256, w2t, 256, 256, lds, acc);
    if (wc == 0) {
      u16* kcmp = (u16*)(ws + OFF_KCMP) + (size_t)bg * 512 * 64;
      const float2* rt = (const float2*)(ws + OFF_ROPE);
#pragma unroll
      for (int mi = 0; mi < 2; ++mi)
#pragma unroll
        for (int ni = 0; ni < 2; ++ni)
#pragma unroll
          for (int reg = 0; reg < 16; ++reg) {
            const int n = 128 * mtile + 64 * wr + 32 * mi + crow(reg, h);
            float v = acc[mi][ni][reg];
            if (ni == 0) {
              const float pv = __shfl_xor(v, 8);
              if (r < 16) {
                int pos = 16 * n + 31; if (pos > 8191) pos = 8191;
                const float2 cs = rt[pos * 8 + (r & 7)];
                v = (r & 8) ? (pv * cs.y + v * cs.x) : (v * cs.x - pv * cs.y);
              }
            }
            kcmp[(size_t)n * 64 + 32 * ni + r] = f2bf(v);
          }
    }
  } else {
    gemm_tile<true>(hid, 256, w2t, 256, 256, lds, acc);
    if (wc == 0) {
      u16* vcmpT = (u16*)(ws + OFF_VCMPT) + (size_t)bg * 64 * 512;
#pragma unroll
      for (int mi = 0; mi < 2; ++mi)
#pragma unroll
        for (int ni = 0; ni < 2; ++ni)
#pragma unroll
          for (int reg = 0; reg < 16; ++reg) {
            const int n = 128 * mtile + 64 * wr + 32 * mi + r;
            const int d = 32 * ni + crow(reg, h);
            vcmpT[(size_t)d * 512 + vperm16(n)] = (n < 511) ? f2bf(acc[mi][ni][reg]) : (u16)0;
          }
    }
  }
  asm volatile("s_waitcnt vmcnt(0)" ::: "memory");
  __syncthreads();
  if (tid == 0) {
    __builtin_amdgcn_fence(__ATOMIC_RELEASE, "agent");
    asm volatile("s_waitcnt vmcnt(0)" ::: "memory");
    __hip_atomic_fetch_add((unsigned*)(ws + OFF_BAR) + 3800 + l * 4 + bg, 1u, __ATOMIC_RELAXED, __HIP_MEMORY_SCOPE_AGENT);
  }
}

struct TileRegs { u32x4 k0, k1, v0, v1; };
DI void tile_gload(TileRegs& tr, const u16* __restrict__ kbase, long kstride, const u16* __restrict__ vbase, long vstride) {
  const int tid = ltid(), row = tid >> 2, c0 = (tid & 3) * 2;
  const u16* kp = kbase + (long)row * kstride + c0 * 8;
  const u16* vp = vbase + (long)row * vstride + c0 * 8;
  tr.k0 = *(const u32x4*)kp; tr.k1 = *(const u32x4*)(kp + 8);
  tr.v0 = *(const u32x4*)vp; tr.v1 = *(const u32x4*)(vp + 8);
}
DI void tile_swrite(const TileRegs& tr, unsigned buf) {
  const int tid = ltid(), row = tid >> 2, c0 = (tid & 3) * 2;
  *LDSP(u32x4, buf + swz(row, c0)) = tr.k0;
  *LDSP(u32x4, buf + swz(row, c0 + 1)) = tr.k1;
  *LDSP(u32x4, buf + 8192 + swz(row, c0)) = tr.v0;
  *LDSP(u32x4, buf + 8192 + swz(row, c0 + 1)) = tr.v1;
}
DI void load_qfrags(bf16x8 (&QB)[2][4], const u16* __restrict__ qrows  ) {
  const int lane = ltid() & 63, r = lane & 31, h = lane >> 5;
#pragma unroll
  for (int ni = 0; ni < 2; ++ni)
#pragma unroll
    for (int ks = 0; ks < 4; ++ks) QB[ni][ks] = *(const bf16x8*)(qrows + (size_t)(32 * ni + r) * 64 + 16 * ks + 8 * h);
}
DI float dpp_xor1(float x) { return __builtin_bit_cast(float, __builtin_amdgcn_mov_dpp(__builtin_bit_cast(int, x), 0xB1, 0xF, 0xF, true)); }
DI float dpp_xor2(float x) { return __builtin_bit_cast(float, __builtin_amdgcn_mov_dpp(__builtin_bit_cast(int, x), 0x4E, 0xF, 0xF, true)); }
DI int dpp_xor1i(int x) { return __builtin_amdgcn_mov_dpp(x, 0xB1, 0xF, 0xF, true); }
DI int dpp_xor2i(int x) { return __builtin_amdgcn_mov_dpp(x, 0x4E, 0xF, 0xF, true); }
DI int dpp_hmi(int x) { return __builtin_amdgcn_mov_dpp(x, 0x141, 0xF, 0xF, true); }
DI float xhalf_max(float x) {
  const unsigned u = __float_as_uint(x);
  const auto rr = __builtin_amdgcn_permlane32_swap(u, u, false, false);
  return fmaxf(__uint_as_float(rr[0]), __uint_as_float(rr[1]));
}
DI float xhalf_sum(float x) {
  const unsigned u = __float_as_uint(x);
  const auto rr = __builtin_amdgcn_permlane32_swap(u, u, false, false);
  return __uint_as_float(rr[0]) + __uint_as_float(rr[1]);
}
template <int MODE, bool BIAS = false>
DI void attn_step1(const bf16x8 (&QB)[2][4], const unsigned Ks, f32x16 (&ot)[2][2], float (&m)[2], float (&l)[2], const int bnd, const bool rowok, const float sc2,
                   const bool first, const float cq = 0.f, const unsigned ck = 0u) {
  const int lane = ltid() & 63, r = lane & 31, h = lane >> 5;
  f32x16 s0, s1;
#pragma unroll
  for (int k = 0; k < 16; ++k) { s0[k] = 0.f; s1[k] = 0.f; }
#pragma unroll
  for (int ks = 0; ks < 4; ++ks) {
    const bf16x8 k0 = *LDSP(bf16x8, Ks + swz(r, 2 * ks + h));
    const bf16x8 k1 = *LDSP(bf16x8, Ks + swz(32 + r, 2 * ks + h));
    s0 = MFMA(k0, QB[0][ks], s0);
    s1 = MFMA(k1, QB[0][ks], s1);
  }
  if (BIAS) {
#pragma unroll
    for (int g4 = 0; g4 < 4; ++g4) {
      const f32x4 ca = *LDSP(f32x4, ck + 4 * (8 * g4 + 4 * h));
      const f32x4 cb = *LDSP(f32x4, ck + 4 * (32 + 8 * g4 + 4 * h));
#pragma unroll
      for (int e = 0; e < 4; ++e) {
        s0[4 * g4 + e] = fmaf(s0[4 * g4 + e], LOG2E, cq - ca[e]);
        s1[4 * g4 + e] = fmaf(s1[4 * g4 + e], LOG2E, cq - cb[e]);
      }
    }
  }
  if (MODE == 1) {
#pragma unroll
    for (int reg = 0; reg < 16; ++reg) {
      const int keyc = (reg & 3) + 8 * (reg >> 2);
      s0[reg] = (keyc <= bnd) ? s0[reg] : -1e30f;
      s1[reg] = (keyc + 32 <= bnd) ? s1[reg] : -1e30f;
    }
  }
  if (MODE == 2) {
#pragma unroll
    for (int reg = 0; reg < 16; ++reg) {
      const int keyc = (reg & 3) + 8 * (reg >> 2);
      s0[reg] = (keyc >= bnd) ? s0[reg] : -1e30f;
      s1[reg] = (keyc + 32 >= bnd) ? s1[reg] : -1e30f;
    }
  }
  if (first) {
    float mx = fmaxf(s0[0], s1[0]);
#pragma unroll
    for (int reg = 1; reg < 16; ++reg) mx = fmaxf(mx, fmaxf(s0[reg], s1[reg]));
    mx = xhalf_max(mx);
    if (MODE == 3) mx = rowok ? mx : -1e30f;
    m[0] = fmaxf(-1e20f, mx);
  }
  float mb = -m[0] * sc2;
  if (MODE == 3) mb = rowok ? mb : -__builtin_inff();
  float rs0 = 0.f, rs1 = 0.f;
#pragma unroll
  for (int reg = 0; reg < 16; ++reg) {
    const float p0 = EXP2(fmaf(s0[reg], sc2, mb)); s0[reg] = p0; rs0 += p0;
    const float p1 = EXP2(fmaf(s1[reg], sc2, mb)); s1[reg] = p1; rs1 += p1;
  }
  l[0] += xhalf_sum(rs0 + rs1);
  const unsigned Vs = Ks + 8192;
#pragma unroll
  for (int kk = 0; kk < 4; ++kk) {
    const int mi = kk >> 1, s = kk & 1;
    u32x4 pk;
#pragma unroll
    for (int i = 0; i < 4; ++i) pk[i] = mi ? pk2(s1[8 * s + 2 * i], s1[8 * s + 2 * i + 1]) : pk2(s0[8 * s + 2 * i], s0[8 * s + 2 * i + 1]);
    const bf16x8 pf = __builtin_bit_cast(bf16x8, pk);
    bf16x8 vf[2];
#pragma unroll
    for (int di = 0; di < 2; ++di) {
      const int d = 32 * di + r;
      const int sw = (d >> 1) & 7;
      vf[di] = *LDSP(bf16x8, Vs + d * 128 + (((4 * mi + 2 * s + h) ^ sw) << 4));
    }
#pragma unroll
    for (int di = 0; di < 2; ++di) ot[di][0] = MFMA(vf[di], pf, ot[di][0]);
  }
}

template <class LoadF, class BodyF>
DI void tile_pipeline(const int n, const unsigned lds, LoadF&& ld, BodyF&& body) {
  TileRegs A, B;
  ld(A, 0);
  __syncthreads();
  tile_swrite(A, lds);
  if (n > 1) ld(A, 1);
  if (n > 2) ld(B, 2);
  __syncthreads();
  int j = 0;
  while (true) {
    body(j, lds);
    if (j + 1 < n) tile_swrite(A, lds + 16384);
    if (j + 3 < n) ld(A, j + 3);
    __syncthreads();
    if (++j >= n) break;
    body(j, lds + 16384);
    if (j + 1 < n) tile_swrite(B, lds);
    if (j + 3 < n) ld(B, j + 3);
    __syncthreads();
    if (++j >= n) break;
  }
}

template <int MI, int NIM>
DI void qk_half(const bf16x8 (&QB)[2][4], const unsigned Ks, f32x16 (&st)[2]) {
  const int lane = ltid() & 63, r = lane & 31, h = lane >> 5;
#pragma unroll
  for (int j = 0; j < 2; ++j)
#pragma unroll
    for (int k = 0; k < 16; ++k) st[j][k] = 0.f;
#pragma unroll
  for (int ks = 0; ks < 4; ++ks) {
    const bf16x8 kf = *LDSP(bf16x8, Ks + swz(32 * MI + r, 2 * ks + h));
#pragma unroll
    for (int ni = 0; ni < 2; ++ni)
      if (NIM & (1 << ni)) st[ni] = MFMA(kf, QB[ni][ks], st[ni]);
  }
}
template <int MI>
DI void mask_hi(f32x16 (&st)[2], const int (&hi)[2]) {
#pragma unroll
  for (int reg = 0; reg < 16; ++reg) {
    const int keyc = 32 * MI + (reg & 3) + 8 * (reg >> 2);
#pragma unroll
    for (int ni = 0; ni < 2; ++ni) st[ni][reg] = (keyc <= hi[ni]) ? st[ni][reg] : -1e30f;
  }
}
template <int MI>
DI void mask_lo(f32x16 (&st)[2], const int (&lo)[2]) {
#pragma unroll
  for (int reg = 0; reg < 16; ++reg) {
    const int keyc = 32 * MI + (reg & 3) + 8 * (reg >> 2);
#pragma unroll
    for (int ni = 0; ni < 2; ++ni) st[ni][reg] = (keyc >= lo[ni]) ? st[ni][reg] : -1e30f;
  }
}
template <int MI, int NIM, bool ROWSEL>
DI void softmax_pv(f32x16 (&st)[2], const unsigned Vs, f32x16 (&ot)[2][2], float (&m)[2], float (&l)[2], const float sc2, const bool (&rowok)[2]) {
  const int lane = ltid() & 63, r = lane & 31, h = lane >> 5;
#pragma unroll
  for (int ni = 0; ni < 2; ++ni) {
    if (!(NIM & (1 << ni))) continue;
    float mx = st[ni][0];
#pragma unroll
    for (int reg = 1; reg < 16; ++reg) mx = fmaxf(mx, st[ni][reg]);
    mx = fmaxf(mx, __shfl_xor(mx, 32));
    if (ROWSEL) mx = rowok[ni] ? mx : -1e30f;
    const float mold = m[ni];
    const float mnew = fmaxf(mold, mx);
    const float alpha = EXP2((mold - mnew) * sc2);
    m[ni] = mnew;
    float mb = -mnew * sc2;
    if (ROWSEL) mb = rowok[ni] ? mb : -__builtin_inff();
    float rs = 0.f;
#pragma unroll
    for (int reg = 0; reg < 16; ++reg) { const float pp = EXP2(fmaf(st[ni][reg], sc2, mb)); st[ni][reg] = pp; rs += pp; }
    rs += __shfl_xor(rs, 32);
    l[ni] = l[ni] * alpha + rs;
    if (__builtin_amdgcn_ballot_w64(mnew > mold) != 0ull) {
#pragma unroll
      for (int di = 0; di < 2; ++di)
#pragma unroll
        for (int reg = 0; reg < 16; ++reg) ot[di][ni][reg] *= alpha;
    }
  }
#pragma unroll
  for (int s = 0; s < 2; ++s) {
    bf16x8 pf[2], vf[2];
#pragma unroll
    for (int ni = 0; ni < 2; ++ni) {
      if (!(NIM & (1 << ni))) continue;
      u32x4 pk;
#pragma unroll
      for (int i = 0; i < 4; ++i) pk[i] = pk2(st[ni][8 * s + 2 * i], st[ni][8 * s + 2 * i + 1]);
      pf[ni] = __builtin_bit_cast(bf16x8, pk);
    }
#pragma unroll
    for (int di = 0; di < 2; ++di) {
      const int d = 32 * di + r;
      const int sw = (d >> 1) & 7;
      const u32x2 lo = *LDSP(u32x2, Vs + d * 128 + (((4 * MI + 2 * s) ^ sw) << 4) + 8 * h);
      const u32x2 hi = *LDSP(u32x2, Vs + d * 128 + (((4 * MI + 2 * s + 1) ^ sw) << 4) + 8 * h);
      u32x4 vv; vv[0] = lo[0]; vv[1] = lo[1]; vv[2] = hi[0]; vv[3] = hi[1];
      vf[di] = __builtin_bit_cast(bf16x8, vv);
    }
#pragma unroll
    for (int di = 0; di < 2; ++di)
#pragma unroll
      for (int ni = 0; ni < 2; ++ni)
        if (NIM & (1 << ni)) ot[di][ni] = MFMA(vf[di], pf[ni], ot[di][ni]);
  }
}
template <int NIM, int MODE>
DI void attn_step(const bf16x8 (&QB)[2][4], const unsigned Ks, f32x16 (&ot)[2][2], float (&m)[2], float (&l)[2], const int (&bnd)[2], const bool (&rowok)[2]) {
  {
    f32x16 st[2];
    qk_half<0, NIM>(QB, Ks, st);
    if (MODE == 1) mask_hi<0>(st, bnd);
    if (MODE == 2) mask_lo<0>(st, bnd);
    softmax_pv<0, NIM, MODE == 3>(st, Ks + 8192, ot, m, l, LOG2E, rowok);
  }
  {
    f32x16 st[2];
    qk_half<1, NIM>(QB, Ks, st);
    if (MODE == 1) mask_hi<1>(st, bnd);
    if (MODE == 2) mask_lo<1>(st, bnd);
    softmax_pv<1, NIM, MODE == 3>(st, Ks + 8192, ot, m, l, LOG2E, rowok);
  }
}

DI void fox_item(const Params& p, int l, int item, unsigned lds) {
  char* ws = lptr(p.ws);
  const int bh = item & 7, qt = 63 - (item >> 3);
  const int b = bh >> 2, hd = bh & 3;
  const int q0 = qt * 128;
  const int tid = ltid(), lane = tid & 63, w = tid >> 6, r = lane & 31, h = lane >> 5;
  const u16* kb = (const u16*)(ws + OFF_FK) + (size_t)bh * T_ * 64;
  const u16* vb = (const u16*)(ws + OFF_FVT) + (size_t)bh * 64 * T_;
  const float* flog = (const float*)(ws + OFF_FLOG) + (size_t)b * T_ * 4 + hd;
  const unsigned rq = lds + 32768, ckb = lds + 32768 + 1024, wsum = lds + 32768 + 1024 + 512;
  __syncthreads();
  bf16x8 QB[2][4];
  {
    const u16* qrows = (const u16*)(ws + OFF_FQ) + ((size_t)bh * T_ + q0 + 32 * w) * 64;
#pragma unroll
    for (int ks = 0; ks < 4; ++ks) { QB[0][ks] = *(const bf16x8*)(qrows + (size_t)r * 64 + 16 * ks + 8 * h); QB[1][ks] = QB[0][ks]; }
  }
  {
    float v = (tid < 128) ? flog[(size_t)(q0 + tid) * 4] * LOG2E : 0.f;
#pragma unroll
    for (int o = 1; o < 64; o <<= 1) { const float u = __shfl_up(v, o); if (lane >= o) v += u; }
    if (tid == 63) *LDSP(float, wsum) = v;
    __syncthreads();
    if (w == 1) v += *LDSP(float, wsum);
    if (tid < 128) *LDSP(float, rq + 4 * tid) = v;
  }
  const int nkt = 2 * qt + 2;
  float qkb;
  {
    const float kn = sqrtf(((const float*)(ws + OFF_KN2))[l * 8 + bh]) * 1.02f + 1e-3f;
    float ss = 0.f;
#pragma unroll
    for (int ks = 0; ks < 4; ++ks)
#pragma unroll
      for (int e = 0; e < 8; ++e) { const float qv = bf2f((u16)QB[0][ks][e]); ss = fmaf(qv, qv, ss); }
    ss = xhalf_sum(ss);
    qkb = sqrtf(ss) * kn * LOG2E;
  }
  TileRegs tr;
  float carry = 0.f;
  float cknext = 0.f;
  tile_gload(tr, kb + (size_t)(nkt - 1) * 64 * 64, 64, vb + (size_t)(nkt - 1) * 64, T_);
  __syncthreads();
  tile_swrite(tr, lds);
  if (w == 0) *LDSP(float, ckb + 4 * lane) = *LDSP(float, rq + 4 * (64 + lane));
  __syncthreads();
  f32x16 ot[2][2]; zero_acc(ot);
  float m[2] = {-1e20f, -1e20f}, ls[2] = {0.f, 0.f};
  const float cq = *LDSP(float, rq + 4 * (32 * w + r));
  int cur = 0;
  for (int kt = nkt - 1; kt >= 0; --kt) {
    const bool more = kt > 0;
    if (more) {
      tile_gload(tr, kb + (size_t)(kt - 1) * 64 * 64, 64, vb + (size_t)(kt - 1) * 64, T_);
      if (w == 0) {
        const int ktn = kt - 1 - 2 * qt;
        if (ktn >= 0) cknext = *LDSP(float, rq + 4 * (64 * ktn + lane));
        else {
          const float v = -flog[(size_t)((kt - 1) * 64 + lane) * 4] * LOG2E;
          float inc = v;
#pragma unroll
          for (int o = 1; o < 64; o <<= 1) { const float u = __shfl_down(inc, o); if (lane + o < 64) inc += u; }
          cknext = carry + inc - v;
          carry += __shfl(inc, 0);
        }
      }
    }
    const int ktp = kt - 2 * qt;
    if (ktp <= 0 || w >= 2) {
      const unsigned Ks = lds + cur * 16384;
      const unsigned ck = ckb + cur * 256;
      const bool masked = (ktp == 1) || (ktp == 0 && w < 2);
      if (masked) attn_step1<1, true>(QB, Ks, ot, m, ls, 32 * w + r - 64 * ktp - 4 * h, true, 1.0f, true, cq, ck);
      else attn_step1<0, true>(QB, Ks, ot, m, ls, 0, true, 1.0f, false, cq, ck);
    }
    if (more) {
      tile_swrite(tr, lds + (cur ^ 1) * 16384);
      if (w == 0) *LDSP(float, ckb + 4 * ((cur ^ 1) * 64 + lane)) = cknext;
    }
    if (kt <= 2 * qt && kt > 0 && (kt & 1) == 0) {
      const float cmin = __shfl(cknext, 63);
      if (w == 0 && lane == 0) *LDSP(float, wsum + 16) = cmin;
      __syncthreads();
      const float cm = *LDSP(float, wsum + 16);
      const bool done = (qkb + cq - cm - m[0] < -40.f);
      if (__syncthreads_and(done ? 1 : 0)) break;
    } else {
      __syncthreads();
    }
    cur ^= 1;
  }
  const u16* gate = (const u16*)(ws + OFF_GATE);
  u16* mixed = (u16*)(ws + OFF_MIXED);
  {
    const float il = 1.f / ls[0];
    const size_t mrow = (size_t)(b * T_ + q0 + 32 * w + r) * 1024 + hd * 64;
#pragma unroll
    for (int di = 0; di < 2; ++di)
#pragma unroll
      for (int g4 = 0; g4 < 4; ++g4) {
        const int d = 32 * di + 8 * g4 + 4 * h;
        const u32x2 gv = *(const u32x2*)(gate + mrow + d);
        u32x2 o;
        o[0] = pk2(ot[di][0][4 * g4] * il * bflo(gv[0]), ot[di][0][4 * g4 + 1] * il * bfhi(gv[0]));
        o[1] = pk2(ot[di][0][4 * g4 + 2] * il * bflo(gv[1]), ot[di][0][4 * g4 + 3] * il * bfhi(gv[1]));
        *(u32x2*)(mixed + mrow + d) = o;
      }
  }
}

DI int tl32() { const int t = ltid(); return ((t >> 6) << 3) + ((t & 31) >> 2); }
DI void nsa_flush32(const Params& p, int mode, f32x16 (&ot)[2][2], const float ls0, int b, int g, int tbase, int br) {
  char* ws = lptr(p.ws);
  const int tid_ = ltid(); const int lane = tid_ & 63, r = lane & 31, h = lane >> 5;
  float* osc = (float*)(ws + OFF_OSC);
  const float* ngl = (const float*)(ws + OFF_NGL);
  const u16* gate = (const u16*)(ws + OFF_GATE);
  u16* mixed = (u16*)(ws + OFF_MIXED);
  const int t = tbase + tl32(), hh = r & 3;
  const size_t m = (size_t)b * T_ + t;
  const float gsig = ngl[m * 24 + (g * 4 + hh) * 3 + br];
  const float sc = (ls0 > 0.f) ? gsig / ls0 : 0.f;
  const size_t cb = m * 512 + (g * 4 + hh) * 64;
#pragma unroll
  for (int di = 0; di < 2; ++di)
#pragma unroll
    for (int g4 = 0; g4 < 4; ++g4) {
      const int d = 32 * di + 8 * g4 + 4 * h;
      float4 v = {ot[di][0][4 * g4] * sc, ot[di][0][4 * g4 + 1] * sc, ot[di][0][4 * g4 + 2] * sc, ot[di][0][4 * g4 + 3] * sc};
      if (mode > 0) { const float4 o = *(const float4*)(osc + cb + d); v.x += o.x; v.y += o.y; v.z += o.z; v.w += o.w; }
      if (mode < 2) *(float4*)(osc + cb + d) = v;
      else {
        const size_t mi2 = m * 1024 + 512 + (g * 4 + hh) * 64 + d;
        const u32x2 gv = *(const u32x2*)(gate + mi2);
        u32x2 o; o[0] = pk2(v.x * bflo(gv[0]), v.y * bfhi(gv[0])); o[1] = pk2(v.z * bflo(gv[1]), v.w * bfhi(gv[1]));
        *(u32x2*)(mixed + mi2) = o;
      }
    }
}

DI void nsa_accum32(const Params& p, f32x16 (&osum)[2], const f32x16 (&ot)[2][2], const float ls0, int b, int g, int tbase, int br, bool first) {
  char* ws = lptr(p.ws);
  const int r = ltid() & 31;
  const float* ngl = (const float*)(ws + OFF_NGL);
  const size_t m = (size_t)b * T_ + tbase + tl32();
  const float gsig = ngl[m * 24 + (g * 4 + (r & 3)) * 3 + br];
  const float sc = (ls0 > 0.f) ? gsig / ls0 : 0.f;
#pragma unroll
  for (int di = 0; di < 2; ++di)
#pragma unroll
    for (int k = 0; k < 16; ++k) osum[di][k] = first ? ot[di][0][k] * sc : fmaf(ot[di][0][k], sc, osum[di][k]);
}
DI void nsa_store32(const Params& p, const f32x16 (&osum)[2], int b, int g, int tbase) {
  char* ws = lptr(p.ws);
  const int lane = ltid() & 63, r = lane & 31, h = lane >> 5;
  const u16* gate = (const u16*)(ws + OFF_GATE);
  u16* mixed = (u16*)(ws + OFF_MIXED);
  const size_t m = (size_t)b * T_ + tbase + tl32();
  const size_t base = m * 1024 + 512 + (g * 4 + (r & 3)) * 64;
#pragma unroll
  for (int di = 0; di < 2; ++di)
#pragma unroll
    for (int g4 = 0; g4 < 4; ++g4) {
      const int d = 32 * di + 8 * g4 + 4 * h;
      const u32x2 gv = *(const u32x2*)(gate + base + d);
      u32x2 o;
      o[0] = pk2(osum[di][4 * g4] * bflo(gv[0]), osum[di][4 * g4 + 1] * bfhi(gv[0]));
      o[1] = pk2(osum[di][4 * g4 + 2] * bflo(gv[1]), osum[di][4 * g4 + 3] * bfhi(gv[1]));
      *(u32x2*)(mixed + base + d) = o;
    }
}

DI void nsa_item32(const Params& p, int l, int item, unsigned lds) {
  char* ws = lptr(p.ws);
  const int bg = item & 3, c32 = 255 - (item >> 2);
  const int b = bg >> 1, g = bg & 1;
  const int tbase = 32 * c32, c = c32 >> 1, toff = tbase & 63;
  const int tid = ltid(), lane = tid & 63, w = tid >> 6, r = lane & 31, h = lane >> 5;
  const unsigned imp = lds + 32768;
  const unsigned selw = lds + 32768 + 16384;
  __syncthreads();
  bf16x8 QB[2][4];
  {
    const u16* qrows = (const u16*)(ws + OFF_NQ) + (((size_t)bg * T_ + tbase) * 4 + 32 * w) * 64;
#pragma unroll
    for (int ks = 0; ks < 4; ++ks) { QB[0][ks] = *(const bf16x8*)(qrows + (size_t)r * 64 + 16 * ks + 8 * h); QB[1][ks] = QB[0][ks]; }
  }
  for (int i = tid; i < 32 * 128; i += 256) *LDSP(float, imp + 4 * i) = 0.f;
  f32x16 ot[2][2];
  f32x16 osum[2];
  float m[2], ls[2];
  const bool rk[2] = {true, true};
  {
    const u16* kb = (const u16*)(ws + OFF_KW) + (size_t)bg * T_ * 64;
    const u16* vb = (const u16*)(ws + OFF_VWT) + (size_t)bg * 64 * T_;
    zero_acc(ot); m[0] = m[1] = -1e20f; ls[0] = ls[1] = 0.f;
    const int jlo = (c >= 8) ? c - 8 : 0;
    tile_pipeline(c - jlo + 1, lds,
      [&](TileRegs& t, int i) __attribute__((always_inline)) { const int j = c - i; tile_gload(t, kb + (size_t)j * 64 * 64, 64, vb + (size_t)j * 64, T_); },
      [&](int i, unsigned Ks) __attribute__((always_inline)) {
        const int j = c - i;
        const bool diag = (j == c), far = (j == c - 8);
        if (diag) attn_step1<1>(QB, Ks, ot, m, ls, toff + tl32() - 4 * h_of(), true, LOG2E, true);
        else if (far) attn_step1<2>(QB, Ks, ot, m, ls, toff + tl32() + 1 - 4 * h_of(), true, LOG2E, false);
        else attn_step1<0>(QB, Ks, ot, m, ls, 0, true, LOG2E, false);
      });
    nsa_accum32(p, osum, ot, ls[0], b, g, tbase, 2, true);
  }
  if (tid == 0 && *LDSP(unsigned, lds + 67540 + 4 * (l * 4 + bg)) == 0u) {
    unsigned* dn = (unsigned*)(ws + OFF_BAR) + 3800 + l * 4 + bg;
    while (__hip_atomic_load(dn, __ATOMIC_RELAXED, __HIP_MEMORY_SCOPE_AGENT) < 8u) __builtin_amdgcn_s_sleep(4);
    __builtin_amdgcn_fence(__ATOMIC_ACQUIRE, "agent");
    asm volatile("s_waitcnt vmcnt(0)" ::: "memory");
    *LDSP(unsigned, lds + 67540 + 4 * (l * 4 + bg)) = 1u;
  }
  __syncthreads();
  const u16* kcb = (const u16*)(ws + OFF_KCMP) + (size_t)bg * 512 * 64;
  const u16* vcb = (const u16*)(ws + OFF_VCMPT) + (size_t)bg * 64 * 512;
  const int nbc = (2 * c32) / 64 + 1;
  {
    zero_acc(ot); m[0] = m[1] = -1e20f; ls[0] = ls[1] = 0.f;
    tile_pipeline(nbc, lds,
      [&](TileRegs& t, int nb) __attribute__((always_inline)) { tile_gload(t, kcb + (size_t)nb * 64 * 64, 64, vcb + (size_t)nb * 64, 512); },
      [&](int nb, unsigned Ks) __attribute__((always_inline)) {
        const int hb = ((tbase + tl32() - 31) >> 4) - 64 * nb - 4 * h_of();
        if (64 * nb + 63 <= ((tbase - 31) >> 4)) attn_step1<0>(QB, Ks, ot, m, ls, hb, true, LOG2E, nb == 0);
        else attn_step1<1>(QB, Ks, ot, m, ls, hb, true, LOG2E, nb == 0);
      });
    nsa_accum32(p, osum, ot, ls[0], b, g, tbase, 0, false);
  }
  if (c >= 16) {
    const float il0 = (ls[0] > 0.f) ? 1.f / ls[0] : 0.f;
#define IMP_HALF(MI)                                                                               \
      {                                                                                            \
        f32x16 st[2];                                                                              \
        qk_half<MI, 1>(QB, Ks, st);                                                                \
        const int tlv = tl32(); const int hbv = ((tbase + tlv - 31) >> 4) - 64 * nb - 4 * h_of();  \
        _Pragma("unroll") for (int g4 = 0; g4 < 4; ++g4) {                                         \
          float pg[4];                                                                             \
          _Pragma("unroll") for (int e = 0; e < 4; ++e) {                                          \
            const int keyc = 32 * MI + 8 * g4 + e;                                                 \
            float pp = (keyc <= hbv) ? EXP2((st[0][4 * g4 + e] - m[0]) * LOG2E) * il0 : 0.f;       \
            pp += dpp_xor1(pp);                                                                    \
            pp += dpp_xor2(pp);                                                                    \
            pg[e] = pp;                                                                            \
          }                                                                                        \
          if ((r & 3) == g4) {                                                                     \
            const int j = 16 * nb + 8 * MI + 2 * g4 + h;                                           \
            const float G = (pg[0] + pg[1]) + (pg[2] + pg[3]);                                     \
            __hip_atomic_fetch_add(LDSP(float, imp + 4 * (tlv * 128 + j)), G, __ATOMIC_RELAXED, __HIP_MEMORY_SCOPE_WORKGROUP); \
            if (j + 1 < 128) __hip_atomic_fetch_add(LDSP(float, imp + 4 * (tlv * 128 + j + 1)), pg[3], __ATOMIC_RELAXED, __HIP_MEMORY_SCOPE_WORKGROUP); \
          }                                                                                        \
        }                                                                                          \
      }
    tile_pipeline(nbc, lds,
      [&](TileRegs& t, int nb) __attribute__((always_inline)) { tile_gload(t, kcb + (size_t)nb * 64 * 64, 64, vcb + (size_t)nb * 64, 512); },
      [&](int nb, unsigned Ks) __attribute__((always_inline)) {
        IMP_HALF(0)
        IMP_HALF(1)
      });
#undef IMP_HALF
  }
  {
    const int tok = tid >> 3, sub = tid & 7;
    unsigned word;
    if (c < 16) {
      word = 0xffffu;
    } else {
      unsigned key[16];
      word = 0;
#pragma unroll
      for (int i = 0; i < 16; ++i) {
        const int j = 16 * sub + i;
        const float v = *LDSP(float, imp + 4 * (tok * 128 + j));
        const bool cand = (j >= 1) && (j <= c - 2);
        key[i] = cand ? (__float_as_uint(v) + 1u) : 0u;
        if (j == 0 || j == c || j == c - 1) word |= (1u << i);
      }
      unsigned thr = 0;
      for (int bit = 30; bit >= 0; --bit) {
        const unsigned cd = thr | (1u << bit);
        int cnt = 0;
#pragma unroll
        for (int i = 0; i < 16; ++i) cnt += (key[i] >= cd) ? 1 : 0;
        cnt += dpp_xor1i(cnt);
        cnt += dpp_xor2i(cnt);
        cnt += dpp_hmi(cnt);
        if (cnt >= 13) thr = cd;
      }
      int gt = 0, eq = 0;
#pragma unroll
      for (int i = 0; i < 16; ++i) { gt += (key[i] > thr) ? 1 : 0; eq += (key[i] == thr) ? 1 : 0; }
      int gtt = gt; gtt += dpp_xor1i(gtt); gtt += dpp_xor2i(gtt); gtt += dpp_hmi(gtt);
      int eqb = 0;
#pragma unroll
      for (int k = 0; k < 7; ++k) { const int ek = __shfl(eq, (lane & ~7) + k); if (sub > k) eqb += ek; }
      int need = 13 - gtt - eqb;
#pragma unroll
      for (int i = 0; i < 16; ++i) {
        if (key[i] > thr) word |= (1u << i);
        else if (key[i] == thr && thr != 0u) { if (need > 0) word |= (1u << i); --need; }
      }
    }
    *LDSP(u16, selw + 16 * tok + 2 * sub) = (u16)word;
  }
  __syncthreads();
  {
    const u16* kb = (const u16*)(ws + OFF_KS) + (size_t)bg * T_ * 64;
    const u16* vb = (const u16*)(ws + OFF_VST) + (size_t)bg * 64 * T_;
    zero_acc(ot); m[0] = m[1] = -1e20f; ls[0] = ls[1] = 0.f;
    tile_pipeline(c + 1, lds,
      [&](TileRegs& t, int j) __attribute__((always_inline)) { tile_gload(t, kb + (size_t)j * 64 * 64, 64, vb + (size_t)j * 64, T_); },
      [&](int j, unsigned Ks) __attribute__((always_inline)) {
        const bool selb = ((*LDSP(unsigned, selw + 16 * tl32() + 4 * (j >> 5)) >> (j & 31)) & 1u) != 0u;
        if (j == c) {
          attn_step1<1>(QB, Ks, ot, m, ls, toff + tl32() - 4 * h_of(), true, LOG2E, j == 0);
        } else {
          if (__builtin_amdgcn_ballot_w64(selb) != 0ull) attn_step1<3>(QB, Ks, ot, m, ls, 0, selb, LOG2E, j == 0);
        }
        if (PROBE_REP == 7) attn_step1<3>(QB, Ks, ot, m, ls, 0, false, LOG2E, false);
      });
    nsa_accum32(p, osum, ot, ls[0], b, g, tbase, 1, false);
    nsa_store32(p, osum, b, g, tbase);
  }
}

#define XB_TMO      128
#define XB_XCNT(j)  (256  + 64 * (j))
#define XB_XSUB(j)  (1280 + 64 * (j))
#define XB_XGEN(j)  (2304 + 64 * (j))
#define XB_TOP      3328
#define XB_TOPGEN   3392
#define XCD_BAR_WORDS 3456
#define XB_SPIN_CAP (1u << 18)
#define LAS __attribute__((address_space(3)))

__device__ __forceinline__ unsigned xb_ld(unsigned* p)              { return __hip_atomic_load(p, __ATOMIC_RELAXED, __HIP_MEMORY_SCOPE_AGENT); }
__device__ __forceinline__ unsigned xb_add(unsigned* p, unsigned v) { return __hip_atomic_fetch_add(p, v, __ATOMIC_RELAXED, __HIP_MEMORY_SCOPE_AGENT); }
__device__ __forceinline__ unsigned xb_xcc_id() { return (unsigned)__builtin_amdgcn_s_getreg((3 << 11) | 20) & 0xFu; }
#define XB_SPIN(cond, bar) do { unsigned _sp = 0; while (cond) { __builtin_amdgcn_s_sleep(1); \
    if ((++_sp & 255u) == 0u) { if (xb_ld(&(bar)[XB_TMO])) break; if (_sp > XB_SPIN_CAP) { atomicAdd(&(bar)[XB_TMO], 1u); break; } } } } while (0)

struct XcdBarrier {
    unsigned* bar; unsigned x;
    volatile LAS unsigned* st;
};

__device__ __forceinline__ XcdBarrier xcd_barrier_post(unsigned* bar, volatile LAS unsigned* st) {
    XcdBarrier b; b.bar = bar; b.x = xb_xcc_id(); b.st = st;
    if (threadIdx.x == 0) (void)xb_add(&bar[XB_XCNT(b.x)], 1u);
    return b;
}
__device__ __forceinline__ void xcd_barrier_complete(unsigned* bar, unsigned x, unsigned& nloc, unsigned& nx) {
    const unsigned G = gridDim.x * gridDim.y * gridDim.z;
    unsigned sum, cnt, mine, sp = 0u;
    for (;;) {
        sum = 0u; cnt = 0u; mine = 0u;
#pragma unroll
        for (unsigned j = 0; j < 16; ++j) { const unsigned c = xb_ld(&bar[XB_XCNT(j)]); sum += c; cnt += (c > 0u) ? 1u : 0u; mine = (j == x) ? c : mine; }
        if (sum == G) break;
        __builtin_amdgcn_s_sleep(1);
        if ((++sp & 255u) == 0u) { if (xb_ld(&bar[XB_TMO])) break; if (sp > XB_SPIN_CAP) { atomicAdd(&bar[XB_TMO], 1u); break; } }
    }
    nloc = mine > 0u ? mine : 1u; nx = cnt > 0u ? cnt : 1u;
}

__device__ __forceinline__ void xcd_barrier(const XcdBarrier& b) {
    asm volatile("s_waitcnt vmcnt(0)" ::: "memory");
    __syncthreads();
    if (threadIdx.x == 0) {
        unsigned* bar = b.bar;
        __builtin_amdgcn_s_waitcnt(0);
        unsigned nloc = b.st[0], nx = b.st[1];
        if (nloc == 0u) { xcd_barrier_complete(bar, b.x, nloc, nx); b.st[0] = nloc; b.st[1] = nx; }
        const unsigned old = xb_add(&bar[XB_XSUB(b.x)], 1u);
        const unsigned gen = old / nloc;
        if (old + 1u == (gen + 1u) * nloc) {
            __builtin_amdgcn_fence(__ATOMIC_RELEASE, "agent");
            asm volatile("s_waitcnt vmcnt(0)" ::: "memory");
            const unsigned og = xb_add(&bar[XB_TOP], 1u);
            const unsigned tg = og / nx;
            if (og + 1u == (tg + 1u) * nx) xb_add(&bar[XB_TOPGEN], 1u);
            else XB_SPIN(xb_ld(&bar[XB_TOPGEN]) == tg, bar);
            __builtin_amdgcn_fence(__ATOMIC_ACQUIRE, "agent");
            xb_add(&bar[XB_XGEN(b.x)], 1u);
            asm volatile("s_waitcnt vmcnt(0)" ::: "memory");
        } else {
            XB_SPIN(xb_ld(&bar[XB_XGEN(b.x)]) == gen, bar);
            __builtin_amdgcn_fence(__ATOMIC_ACQUIRE, "agent");
            asm volatile("s_waitcnt vmcnt(0)" ::: "memory");
        }
    }
    __syncthreads();
}


__global__ void __launch_bounds__(256, 2) fwd_megakernel(Params p) {
  cg::grid_group grid = cg::this_grid();
  __shared__ __attribute__((aligned(16))) char lds_arr[LDS_BYTES];
  const unsigned lds = (unsigned)(size_t)lds_arr;
  if (threadIdx.x < 16) *LDSP(unsigned, lds + 67520 + 4 * threadIdx.x) = 0u;
  __syncthreads();
  const XcdBarrier xb = xcd_barrier_post((unsigned*)(p.ws + OFF_BAR), (volatile LAS unsigned*)(lds + 67520));
#define GSYNC() xcd_barrier(xb)
  if (gridDim.x == 0x7fffffffu) grid.sync();
  const int G = gridDim.x, bid = blockIdx.x;
  for (int whole = 0; whole < (PROBE_REP == 6 ? 2 : 1); ++whole) {
  if (whole) GSYNC();
  for (int rep0 = 0; rep0 < (PROBE_REP == 4 ? 2 : 1); ++rep0) {
  for (int i = bid; i < 2 * P0_PER_LAYER; i += G) phase0_item(p, i, lds);
  for (int i = G - 1 - bid; i < 32; i += G) cbias_item(p, i, lds);
  if (bid == 0 && threadIdx.x < 128) ((unsigned*)(p.ws + OFF_KN2))[threadIdx.x] = 0u;
  for (int i = bid; i < 256; i += G) rope_item(p, i);
  for (int i = bid * 256 + (int)threadIdx.x; i < BT; i += G * 256) ((float*)(p.ws + OFF_ROWSS))[i] = 0.f;
  for (int i = bid; i < BT / 4; i += G) norm_item(p.x, p.norm_g, (u16*)(p.ws + OFF_H), nullptr, i, nullptr, nullptr, nullptr, nullptr);
  }
  GSYNC();
  for (int l = 0; l < 2; ++l) {
    for (int rep = 0; rep < (PROBE_REP == 1 ? 2 : 1); ++rep) {
    if (rep) GSYNC();
    if (G == 512 && false) {
      const int xcd = bid & 7, lb = bid >> 3, y = xcd >> 1;
      for (int k = lb; k < 448; k += 64) {
        int mt, nt;
        if ((xcd & 1) == 0) {
          if (k < 256) { mt = k >> 2; nt = 7 * y + (k & 3); } else { const int k2 = k - 256; mt = 64 + k2 / 3; nt = 7 * y + k2 % 3; }
        } else {
          if (k < 192) { mt = k / 3; nt = 7 * y + 4 + k % 3; } else { const int k2 = k - 192; mt = 64 + (k2 >> 2); nt = 7 * y + 3 + (k2 & 3); }
        }
        gemm1_item(p, l, mt * 29 + nt, lds);
      }
    } else {
      for (int i = bid; i < 128 * 28; i += G) gemm1_item(p, l, (i / 28) * 29 + (i % 28), lds);
    }
    for (int i = bid; i < 128; i += G) tail_item(p, l, i);
    }
    GSYNC();
    {
      int i = bid;
      unsigned* qctr = (unsigned*)(p.ws + OFF_BAR) + 3600 + 64 * l;
      while (i < 64 + 512 + 256 + 1024) {
        if (i < 64) {
          compress_item(p, l, i, lds);
        } else if (i < 576) {
          fox_item(p, l, i - 64, lds);
        } else if (i < 832) {
          conv_item(p, l, i - 576, lds);
        } else {
          nsa_item32(p, l, i - 832, lds);
        }
        __syncthreads();
        if (threadIdx.x == 0) *LDSP(unsigned, lds + 67536) = (unsigned)G + __hip_atomic_fetch_add(qctr, 1u, __ATOMIC_RELAXED, __HIP_MEMORY_SCOPE_AGENT);
        __syncthreads();
        i = (int)*LDSP(unsigned, lds + 67536);
      }
    }
    GSYNC();
    if (G == 512) {
      const int xcd = bid & 7, lb = bid >> 3;
      for (int k = lb; k < 128; k += 64) gemm2_item(p, l, xcd * 128 + k, lds);
    } else {
      for (int i = bid; i < 1024; i += G) gemm2_item(p, l, i, lds);
    }
    GSYNC();
    if (l == 1) for (int i = bid; i < BT / 4; i += G) norm_item(p.out, p.final_g, nullptr, p.out, i, nullptr, nullptr, nullptr, nullptr);
  }
  }
}

__global__ void zero_mixed(unsigned* m, size_t n) {
  size_t i = (size_t)blockIdx.x * blockDim.x + threadIdx.x;
  if (i < n) m[i] = 0;
}

extern "C" void kernel_launch(void* const* d_in, const int* in_sizes, int n_in, void* d_out,
                              int out_size, void* d_ws, size_t ws_size, hipStream_t stream) {
  static int grid_blocks = 0;
  if (!grid_blocks) {
    int dev = 0, cus = 0, per_cu = 0;
    (void)hipGetDevice(&dev);
    (void)hipDeviceGetAttribute(&cus, hipDeviceAttributeMultiprocessorCount, dev);
    (void)hipOccupancyMaxActiveBlocksPerMultiprocessor(&per_cu, fwd_megakernel, 256, 0);
    if (per_cu > 2) per_cu = 2;
    if (per_cu < 1) per_cu = 1;
    grid_blocks = cus * per_cu;
  }
  Params p{};
  p.x = (const float*)d_in[0]; p.norm_g = (const float*)d_in[1]; p.w_in = (const float*)d_in[2]; p.fox_b = (const float*)d_in[3];
  p.conv_w = (const float*)d_in[4]; p.conv_b = (const float*)d_in[5]; p.conv_ln_g = (const float*)d_in[6]; p.conv_ln_b = (const float*)d_in[7];
  p.conv_pw = (const float*)d_in[8]; p.cmp_pe_k = (const float*)d_in[9]; p.cmp_pe_v = (const float*)d_in[10];
  p.cmp_k_w1 = (const float*)d_in[11]; p.cmp_k_w2 = (const float*)d_in[12]; p.cmp_v_w1 = (const float*)d_in[13]; p.cmp_v_w2 = (const float*)d_in[14];
  p.w_out = (const float*)d_in[15]; p.final_g = (const float*)d_in[16];
  p.out = (float*)d_out; p.ws = (char*)d_ws;
#if !(EN_FOX && EN_NSA)
  {
    size_t n = (size_t)BT * 1024 / 2;
    zero_mixed<<<(unsigned)((n + 255) / 256), 256, 0, stream>>>((unsigned*)((char*)d_ws + OFF_MIXED), n);
  }
#endif
  (void)hipMemsetAsync((char*)d_ws + OFF_BAR, 0, 16384, stream);
  void* args[] = {&p};
  hipError_t e = hipLaunchCooperativeKernel((void*)fwd_megakernel, dim3(grid_blocks), dim3(256), args, 0, stream);
  if (e != hipSuccess) fprintf(stderr, "cooperative launch failed: %s (grid %d)\n", hipGetErrorString(e), grid_blocks);
}
```

```cpp
#include <hip/hip_runtime.h>
#include <hip/hip_cooperative_groups.h>
#include <cstdio>
namespace cg = cooperative_groups;

#ifndef PROBE_REP
#define PROBE_REP 0
#endif
#ifndef EN_FOX
#define EN_FOX 1
#endif
#ifndef EN_NSA
#define EN_NSA 1
#endif

typedef unsigned short u16;
using bf16x8 = __attribute__((ext_vector_type(8))) short;
using f32x16 = __attribute__((ext_vector_type(16))) float;
using u32x4 = __attribute__((ext_vector_type(4))) unsigned;
using u32x2 = __attribute__((ext_vector_type(2))) unsigned;
using f32x4 = __attribute__((ext_vector_type(4))) float;
typedef __attribute__((ext_vector_type(2))) __bf16 bf2_t;
#define DI __device__ __forceinline__
#define EXP2(x) __builtin_amdgcn_exp2f(x)
#define MFMA(a, b, c) __builtin_amdgcn_mfma_f32_32x32x16_bf16((a), (b), (c), 0, 0, 0)

constexpr int T_ = 8192;
constexpr int BT = 16384;
constexpr int NPAD = 3712;
constexpr float LOG2E = 1.4426950408889634f;
constexpr int LDS_BYTES = 67584;

constexpr size_t SZ_WINT = (size_t)NPAD * 1024 * 2;
constexpr size_t OFF_WINT = 0;
constexpr size_t OFF_WOUTT = OFF_WINT + 2 * SZ_WINT;
constexpr size_t OFF_PWT = OFF_WOUTT + 2 * (size_t)1024 * 1024 * 2;
constexpr size_t OFF_W1T = OFF_PWT + 2 * (size_t)256 * 256 * 2;
constexpr size_t OFF_W2T = OFF_W1T + 4 * (size_t)256 * 2048 * 2;
constexpr size_t OFF_CBIAS = OFF_W2T + 4 * (size_t)128 * 256 * 2;
constexpr size_t OFF_ROPE = OFF_CBIAS + 4 * 256 * 4;
constexpr size_t OFF_H = OFF_ROPE + (size_t)8192 * 8 * 2 * 4;
constexpr size_t OFF_OSC = OFF_H;
constexpr size_t OFF_FQ = OFF_H + (size_t)BT * 1024 * 2;
constexpr size_t OFF_FK = OFF_FQ + (size_t)BT * 256 * 2;
constexpr size_t OFF_FVT = OFF_FK + (size_t)BT * 256 * 2;
constexpr size_t OFF_FLOG = OFF_FVT + (size_t)BT * 256 * 2;
constexpr size_t OFF_GATE = OFF_FLOG + (size_t)BT * 4 * 4;
constexpr size_t OFF_GLU = OFF_GATE + (size_t)BT * 1024 * 2;
constexpr size_t OFF_NQ = OFF_GLU + (size_t)BT * 512 * 2;
constexpr size_t OFF_KC = OFF_NQ + (size_t)BT * 512 * 2;
constexpr size_t SZ_KV = (size_t)BT * 128 * 2;
constexpr size_t OFF_VC = OFF_KC + SZ_KV;
constexpr size_t OFF_KS = OFF_VC + SZ_KV;
constexpr size_t OFF_VST = OFF_KS + SZ_KV;
constexpr size_t OFF_KW = OFF_VST + SZ_KV;
constexpr size_t OFF_VWT = OFF_KW + SZ_KV;
constexpr size_t OFF_NGL = OFF_VWT + SZ_KV;
constexpr size_t OFF_KCMP = OFF_NGL + (size_t)BT * 24 * 4;
constexpr size_t OFF_VCMPT = OFF_KCMP + (size_t)4 * 512 * 64 * 2;
constexpr size_t OFF_HID = OFF_VCMPT + (size_t)4 * 512 * 64 * 2;
constexpr size_t OFF_CONVA = OFF_HID + (size_t)32 * 128 * 256 * 2;
constexpr size_t OFF_MIXED = OFF_CONVA + (size_t)BT * 256 * 2;
constexpr size_t OFF_KN2 = OFF_MIXED + (size_t)BT * 1024 * 2;
constexpr size_t OFF_CNT = OFF_KN2 + 256;
constexpr size_t OFF_BAR = OFF_CNT + 256;
constexpr size_t OFF_WTAIL = OFF_BAR + 16384;
constexpr size_t OFF_ROWSS = OFF_WTAIL + (size_t)2 * 32 * 1024 * 4;
constexpr size_t WS_TOTAL = OFF_ROWSS + (size_t)BT * 16 * 4;
static_assert(WS_TOTAL <= (size_t)256 * 1024 * 1024, "ws too large");

struct Params {
  const float* x; const float* norm_g; const float* w_in; const float* fox_b; const float* conv_w; const float* conv_b;
  const float* conv_ln_g; const float* conv_ln_b; const float* conv_pw; const float* cmp_pe_k; const float* cmp_pe_v;
  const float* cmp_k_w1; const float* cmp_k_w2; const float* cmp_v_w1; const float* cmp_v_w2; const float* w_out; const float* final_g;
  float* out; char* ws;
};

DI int ltid() { int t = threadIdx.x; asm volatile("" : "+v"(t)); return t; }
DI char* lptr(char* q) { int z = 0; asm volatile("" : "+s"(z)); return q + z; }
#define LDSP(T, a) ((__attribute__((address_space(3))) T*)(a))
DI int tl_of(int ni) { const int t = ltid(); return ((t >> 6) << 4) + 8 * ni + ((t & 31) >> 2); }
DI int h_of() { return (ltid() >> 5) & 1; }
DI u16 f2bf(float x) { __bf16 b = (__bf16)x; return __builtin_bit_cast(u16, b); }
DI unsigned pk2(float x, float y) { bf2_t v; v[0] = (__bf16)x; v[1] = (__bf16)y; return __builtin_bit_cast(unsigned, v); }
DI float bf2f(u16 v) { return __uint_as_float(((unsigned)v) << 16); }
DI float bflo(unsigned v) { return __uint_as_float(v << 16); }
DI float bfhi(unsigned v) { return __uint_as_float(v & 0xffff0000u); }
DI int vperm16(int t) { return (t & ~15) | (t & 3) | ((t & 4) << 1) | ((t & 8) >> 1); }
DI int crow(int reg, int h) { return (reg & 3) + 8 * (reg >> 2) + 4 * h; }
DI float siluf(float x) { return x / (1.f + __expf(-x)); }
DI float sigmf(float x) { return 1.f / (1.f + __expf(-x)); }
DI float geluf(float x) { return 0.5f * x * (1.f + tanhf(0.7978845608028654f * (x + 0.044715f * x * x * x))); }
DI int swz(int row, int chunk) { return row * 128 + ((chunk ^ ((row >> 1) & 7)) << 4); }
DI void zero_acc(f32x16 (&a)[2][2]) {
#pragma unroll
  for (int i = 0; i < 2; ++i)
#pragma unroll
    for (int j = 0; j < 2; ++j)
#pragma unroll
      for (int k = 0; k < 16; ++k) a[i][j][k] = 0.f;
}

DI int swz32(int row, int chunk) { return row * 64 + ((chunk ^ ((row >> 2) & 3)) << 4); }
template <bool SWAP>
DI void gemm_tile(const u16* __restrict__ A, long lda, const u16* __restrict__ B, long ldb, int K, unsigned lds, f32x16 (&acc)[2][2]) {
  const int tid = ltid(), lane = tid & 63, w = tid >> 6, wr = w >> 1, wc = w & 1, r = lane & 31, h = lane >> 5;
  zero_acc(acc);
  const int lrow = tid >> 2, lch = tid & 3;
  const u16* ga = A + (long)lrow * lda + lch * 8;
  const u16* gb = B + (long)lrow * ldb + lch * 8;
  const long a64 = 64 * lda, b64 = 64 * ldb;
  const int n2 = K >> 6;
  u32x4 a0[4], a1[4], b0[4], b1[4];
#define GLOAD(S, J) { S[0] = *(const u32x4*)(ga + (J) * 32); S[1] = *(const u32x4*)(ga + a64 + (J) * 32); S[2] = *(const u32x4*)(gb + (J) * 32); S[3] = *(const u32x4*)(gb + b64 + (J) * 32); }
#define SWRITE(S, OFF) { const unsigned bb = lds + (OFF); *LDSP(u32x4, bb + swz32(lrow, lch)) = S[0]; *LDSP(u32x4, bb + swz32(lrow + 64, lch)) = S[1]; \
                         *LDSP(u32x4, bb + 8192 + swz32(lrow, lch)) = S[2]; *LDSP(u32x4, bb + 8192 + swz32(lrow + 64, lch)) = S[3]; }
#define COMPUTE(OFF) { const unsigned As = lds + (OFF); const unsigned Bs = As + 8192; \
    _Pragma("unroll") for (int ks = 0; ks < 2; ++ks) { bf16x8 af[2], bf[2]; \
      _Pragma("unroll") for (int i = 0; i < 2; ++i) { af[i] = *LDSP(bf16x8, As + swz32(64 * wr + 32 * i + r, 2 * ks + h)); bf[i] = *LDSP(bf16x8, Bs + swz32(64 * wc + 32 * i + r, 2 * ks + h)); } \
      _Pragma("unroll") for (int mi = 0; mi < 2; ++mi) _Pragma("unroll") for (int ni = 0; ni < 2; ++ni) { \
        if (SWAP) acc[mi][ni] = MFMA(bf[ni], af[mi], acc[mi][ni]); else acc[mi][ni] = MFMA(af[mi], bf[ni], acc[mi][ni]); } } }
  GLOAD(a0, 0)
  GLOAD(a1, 1)
  if (n2 > 1) { GLOAD(b0, 2) GLOAD(b1, 3) }
  __syncthreads();
  SWRITE(a0, 0)
  SWRITE(a1, 16384)
  if (n2 > 2) { GLOAD(a0, 4) GLOAD(a1, 5) }
  __syncthreads();
  int t = 0;
  while (true) {
    COMPUTE(0)
    COMPUTE(16384)
    if (t + 1 < n2) { SWRITE(b0, 32768) SWRITE(b1, 49152) }
    if (t + 3 < n2) { GLOAD(b0, 2 * (t + 3)) GLOAD(b1, 2 * (t + 3) + 1) }
    __syncthreads();
    if (++t >= n2) break;
    COMPUTE(32768)
    COMPUTE(49152)
    if (t + 1 < n2) { SWRITE(a0, 0) SWRITE(a1, 16384) }
    if (t + 3 < n2) { GLOAD(a0, 2 * (t + 3)) GLOAD(a1, 2 * (t + 3) + 1) }
    __syncthreads();
    if (++t >= n2) break;
  }
#undef GLOAD
#undef SWRITE
#undef COMPUTE
}

DI int win_srccol(int n) {
  if (n < 768) return n;
  if (n < 3072) return n + 4;
  if (n < 3584) return n + 28;
  int i = n - 3584;
  if (i < 4) return 768 + i;
  if (i < 28) return 3076 + (i - 4);
  return -1;
}

DI void transpose_tile(const float* __restrict__ src, int ld, int K, int mapkind, int nsrc, u16* __restrict__ dst, int k0, int n0, unsigned lds) {
  const int tid = ltid(), j = tid & 63, i0 = tid >> 6;
  const int n = n0 + j;
  const int sc = mapkind ? win_srccol(n) : (n < nsrc ? n : -1);
  float v[16];
#pragma unroll
  for (int it = 0; it < 16; ++it) v[it] = (sc >= 0) ? src[(size_t)(k0 + i0 + 4 * it) * ld + sc] : 0.f;
  __syncthreads();
#pragma unroll
  for (int it = 0; it < 16; ++it) *LDSP(float, lds + 4 * ((i0 + 4 * it) * 65 + j)) = v[it];
  __syncthreads();
  const int jn = tid >> 2, kc = (tid & 3) * 16;
  u32x4 o0, o1;
#pragma unroll
  for (int e = 0; e < 4; ++e) {
    o0[e] = pk2(*LDSP(float, lds + 4 * ((kc + 2 * e) * 65 + jn)), *LDSP(float, lds + 4 * ((kc + 2 * e + 1) * 65 + jn)));
    o1[e] = pk2(*LDSP(float, lds + 4 * ((kc + 8 + 2 * e) * 65 + jn)), *LDSP(float, lds + 4 * ((kc + 8 + 2 * e + 1) * 65 + jn)));
  }
  u16* dp = dst + (size_t)(n0 + jn) * K + k0 + kc;
  *(u32x4*)dp = o0;
  *(u32x4*)(dp + 8) = o1;
}

constexpr int P0_PER_LAYER = 928 + 256 + 16 + 256 + 16;
DI void phase0_item(const Params& p, int idx, unsigned lds) {
  const int l = idx / P0_PER_LAYER;
  int r = idx % P0_PER_LAYER;
  char* ws = lptr(p.ws);
  if (r < 928) {
    transpose_tile(p.w_in + (size_t)l * 1024 * 3612, 3612, 1024, 1, 0, (u16*)(ws + OFF_WINT + l * SZ_WINT), (r % 16) * 64, (r / 16) * 64, lds);
    return;
  }
  r -= 928;
  if (r < 256) {
    transpose_tile(p.w_out + (size_t)l * 1024 * 1024, 1024, 1024, 0, 1024, (u16*)(ws + OFF_WOUTT) + (size_t)l * 1024 * 1024, (r % 16) * 64, (r / 16) * 64, lds);
    return;
  }
  r -= 256;
  if (r < 16) {
    transpose_tile(p.conv_pw + (size_t)l * 256 * 256, 256, 256, 0, 256, (u16*)(ws + OFF_PWT) + (size_t)l * 256 * 256, (r % 4) * 64, (r / 4) * 64, lds);
    return;
  }
  r -= 16;
  if (r < 256) {
    const int kv = r >> 7; r &= 127;
    const float* src = (kv ? p.cmp_v_w1 : p.cmp_k_w1) + (size_t)l * 2048 * 256;
    transpose_tile(src, 256, 2048, 0, 256, (u16*)(ws + OFF_W1T) + (size_t)(l * 2 + kv) * 256 * 2048, (r % 32) * 64, (r / 32) * 64, lds);
    return;
  }
  r -= 256;
  {
    const int kv = r >> 3; r &= 7;
    const float* src = (kv ? p.cmp_v_w2 : p.cmp_k_w2) + (size_t)l * 256 * 64;
    transpose_tile(src, 64, 256, 0, 64, (u16*)(ws + OFF_W2T) + (size_t)(l * 2 + kv) * 128 * 256, (r % 4) * 64, (r / 4) * 64, lds);
  }
}

DI void cbias_item(const Params& p, int item, unsigned lds) {
  const int idx = item >> 3, ng = item & 7;
  const int l = idx >> 1, kv = idx & 1;
  const float* pe = (kv ? p.cmp_pe_v : p.cmp_pe_k) + (size_t)l * 2048;
  const float* w1 = (kv ? p.cmp_v_w1 : p.cmp_k_w1) + (size_t)l * 2048 * 256;
  const int tid = ltid(), nn = tid & 31, ksl = tid >> 5;
  const int n = ng * 32 + nn;
  float s0 = 0.f, s1 = 0.f, s2 = 0.f, s3 = 0.f;
  const float* wp = w1 + (size_t)(ksl * 256) * 256 + n;
  const float* pp = pe + ksl * 256;
#pragma unroll 4
  for (int i = 0; i < 256; i += 4) {
    s0 = fmaf(pp[i], wp[(size_t)i * 256], s0);
    s1 = fmaf(pp[i + 1], wp[(size_t)(i + 1) * 256], s1);
    s2 = fmaf(pp[i + 2], wp[(size_t)(i + 2) * 256], s2);
    s3 = fmaf(pp[i + 3], wp[(size_t)(i + 3) * 256], s3);
  }
  __syncthreads();
  *LDSP(float, lds + 4 * tid) = (s0 + s1) + (s2 + s3);
  __syncthreads();
  if (tid < 32) {
    float t = 0.f;
#pragma unroll
    for (int k = 0; k < 8; ++k) t += *LDSP(float, lds + 4 * (k * 32 + tid));
    ((float*)(p.ws + OFF_CBIAS))[idx * 256 + n] = t;
  }
}

DI void rope_item(const Params& p, int idx) {
  const int e = idx * 256 + ltid();
  const int pos = e >> 3, i = e & 7;
  const float inv = powf(500000.0f, -(float)(2 * i) / 16.0f);
  const float ang = (float)pos * inv;
  float2 cs; cs.x = cosf(ang); cs.y = sinf(ang);
  ((float2*)(p.ws + OFF_ROPE))[e] = cs;
}

DI void wtail_item(const Params& p, int item) {
  const int l = item >> 5, j = item & 31;
  float* dst = (float*)(p.ws + OFF_WTAIL) + (size_t)item * 1024;
  const int tid = ltid();
  const int col = (j < 4) ? 768 + j : 3076 + (j - 4);
#pragma unroll
  for (int i = 0; i < 4; ++i) {
    const int k = tid + 256 * i;
    dst[k] = (j < 28) ? p.w_in[((size_t)l * 1024 + k) * 3612 + col] : 0.f;
  }
}

DI void norm_item(const float* __restrict__ src, const float* __restrict__ g, u16* dstb, float* dstf, int item,
                  const float* __restrict__ wt, const float* __restrict__ foxb, float* flog, float* ngl) {
  const int tid_ = ltid(); const int lane = tid_ & 63, w = tid_ >> 6;
  const int row = item * 4 + w;
  const float4* s4 = (const float4*)(src + (size_t)row * 1024);
  float4 v[4];
  float ss = 0.f;
#pragma unroll
  for (int i = 0; i < 4; ++i) { v[i] = s4[lane + 64 * i]; ss += v[i].x * v[i].x + v[i].y * v[i].y + v[i].z * v[i].z + v[i].w * v[i].w; }
#pragma unroll
  for (int o = 32; o > 0; o >>= 1) ss += __shfl_xor(ss, o);
  const float rs = rsqrtf(ss * (1.0f / 1024.0f) + 1e-6f);
#pragma unroll
  for (int i = 0; i < 4; ++i) {
    float4 gg = ((const float4*)g)[lane + 64 * i];
    float4 o = {v[i].x * rs * gg.x, v[i].y * rs * gg.y, v[i].z * rs * gg.z, v[i].w * rs * gg.w};
    v[i] = o;
    if (dstb) {
      u32x2 pk; pk[0] = pk2(o.x, o.y); pk[1] = pk2(o.z, o.w);
      *(u32x2*)(dstb + (size_t)row * 1024 + (lane + 64 * i) * 4) = pk;
    } else {
      ((float4*)(dstf + (size_t)row * 1024))[lane + 64 * i] = o;
    }
  }
  if (wt) {
    float a[32];
#pragma unroll
    for (int j = 0; j < 32; ++j) {
      float acc = 0.f;
      if (j < 28) {
#pragma unroll
        for (int i = 0; i < 4; ++i) {
          const float4 ww = ((const float4*)(wt + (size_t)j * 1024))[lane + 64 * i];
          acc = fmaf(v[i].x, ww.x, acc); acc = fmaf(v[i].y, ww.y, acc); acc = fmaf(v[i].z, ww.z, acc); acc = fmaf(v[i].w, ww.w, acc);
        }
      }
      a[j] = acc;
    }
#pragma unroll
    for (int t = 0; t < 16; ++t) { const bool up = (lane & 32) != 0; const float send = up ? a[t] : a[t + 16]; const float keep = up ? a[t + 16] : a[t]; a[t] = keep + __shfl_xor(send, 32); }
#pragma unroll
    for (int t = 0; t < 8; ++t) { const bool up = (lane & 16) != 0; const float send = up ? a[t] : a[t + 8]; const float keep = up ? a[t + 8] : a[t]; a[t] = keep + __shfl_xor(send, 16); }
#pragma unroll
    for (int t = 0; t < 4; ++t) { const bool up = (lane & 8) != 0; const float send = up ? a[t] : a[t + 4]; const float keep = up ? a[t + 4] : a[t]; a[t] = keep + __shfl_xor(send, 8); }
#pragma unroll
    for (int t = 0; t < 2; ++t) { const bool up = (lane & 4) != 0; const float send = up ? a[t] : a[t + 2]; const float keep = up ? a[t + 2] : a[t]; a[t] = keep + __shfl_xor(send, 4); }
    { const bool up = (lane & 2) != 0; const float send = up ? a[0] : a[1]; const float keep = up ? a[1] : a[0]; a[0] = keep + __shfl_xor(send, 2); }
    a[0] += __shfl_xor(a[0], 1);
    const int col = lane >> 1;
    if ((lane & 1) == 0) {
      const float val = a[0];
      if (col < 4) {
        const float xx = val + foxb[col];
        flog[(size_t)row * 4 + col] = fminf(xx, 0.f) - __logf(1.f + __expf(-fabsf(xx)));
      } else if (col < 28) {
        ngl[(size_t)row * 24 + (col - 4)] = sigmf(val);
      }
    }
  }
}

DI void rstd_to_lds(const float* __restrict__ part, int m0, unsigned ldsoff) {
  const int tid = ltid();
  __syncthreads();
  if (tid < 128) {
    const float4* pp = (const float4*)(part + (size_t)(m0 + tid) * 16);
    const float4 a = pp[0], b = pp[1], c = pp[2], d = pp[3];
    const float ss = (((a.x + a.y) + (a.z + a.w)) + ((b.x + b.y) + (b.z + b.w))) + (((c.x + c.y) + (c.z + c.w)) + ((d.x + d.y) + (d.z + d.w)));
    *LDSP(float, ldsoff + 4 * tid) = rsqrtf(ss * (1.0f / 1024.0f) + 1e-6f);
  }
  __syncthreads();
}

DI void gemm1_item(const Params& p, int l, int item, unsigned lds) {
  const int mt = item / 29, nt = item % 29;
  const int m0 = mt * 128;
  char* ws = lptr(p.ws);
  const u16* A = (const u16*)(ws + OFF_H) + (size_t)m0 * 1024;
  const u16* B = (const u16*)(ws + OFF_WINT + l * SZ_WINT) + (size_t)nt * 128 * 1024;
  const bool swap = (nt == 4 || nt == 5 || nt == 21 || nt == 23);
  f32x16 acc[2][2];
  if (swap) gemm_tile<true>(A, 1024, B, 1024, 1024, lds, acc);
  else gemm_tile<false>(A, 1024, B, 1024, 1024, lds, acc);
  const int tid = ltid(), lane = tid & 63, w = tid >> 6, wr = w >> 1, wc = w & 1, r = lane & 31, h = lane >> 5;
  const int b = m0 >> 13, t0 = m0 & 8191;
  if (l == 1) {
    rstd_to_lds((const float*)(ws + OFF_ROWSS), m0, lds);
#pragma unroll
    for (int mi = 0; mi < 2; ++mi) {
      if (swap) {
        const float rs = *LDSP(float, lds + 4 * (64 * wr + 32 * mi + r));
#pragma unroll
        for (int ni = 0; ni < 2; ++ni)
#pragma unroll
          for (int reg = 0; reg < 16; ++reg) acc[mi][ni][reg] *= rs;
      } else {
#pragma unroll
        for (int reg = 0; reg < 16; ++reg) {
          const float rs = *LDSP(float, lds + 4 * (64 * wr + 32 * mi + crow(reg, h)));
          acc[mi][0][reg] *= rs; acc[mi][1][reg] *= rs;
        }
      }
    }
  }
  if (swap) {
    u16* base;
    if (nt == 4 || nt == 5) { const int head = (nt - 4) * 2 + wc; base = (u16*)(ws + OFF_FVT) + (size_t)(b * 4 + head) * 64 * T_; }
    else if (nt == 21) base = (u16*)(ws + OFF_VST) + (size_t)(b * 2 + wc) * 64 * T_;
    else base = (u16*)(ws + OFF_VWT) + (size_t)(b * 2 + wc) * 64 * T_;
#pragma unroll
    for (int mi = 0; mi < 2; ++mi)
#pragma unroll
      for (int ni = 0; ni < 2; ++ni)
#pragma unroll
        for (int reg = 0; reg < 16; ++reg) {
          const int d = 32 * ni + crow(reg, h);
          const int t = vperm16(t0 + 64 * wr + 32 * mi + r);
          base[(size_t)d * T_ + t] = f2bf(acc[mi][ni][reg]);
        }
    return;
  }
  if (nt < 4 || nt == 18 || nt == 19 || nt == 20 || nt == 22 || (nt >= 14 && nt <= 17)) {
    u16* base; long rstride; float scale = 1.f; bool rope = false;
    if (nt < 2) { base = (u16*)(ws + OFF_FQ) + ((size_t)(b * 4 + nt * 2 + wc) * T_ + t0) * 64; rstride = 64; scale = 0.125f; }
    else if (nt < 4) { base = (u16*)(ws + OFF_FK) + ((size_t)(b * 4 + (nt - 2) * 2 + wc) * T_ + t0) * 64; rstride = 64; }
    else if (nt >= 14 && nt <= 17) {
      const int head8 = (nt - 14) * 2 + wc, g = head8 >> 2, hh = head8 & 3;
      base = (u16*)(ws + OFF_NQ) + (((size_t)(b * 2 + g) * T_ + t0) * 4 + hh) * 64; rstride = 256; scale = 0.125f; rope = true;
    } else {
      const size_t off = (nt == 18) ? OFF_KC : (nt == 19) ? OFF_VC : (nt == 20) ? OFF_KS : OFF_KW;
      base = (u16*)(ws + off) + ((size_t)(b * 2 + wc) * T_ + t0) * 64; rstride = 64; rope = (nt == 20 || nt == 22);
    }
    const float2* rt = (const float2*)(ws + OFF_ROPE);
    if (nt == 2 || nt == 3) {
      float mxn = 0.f;
#pragma unroll
      for (int mi = 0; mi < 2; ++mi)
#pragma unroll
        for (int reg = 0; reg < 16; ++reg) {
          const float a0 = bf2f(f2bf(acc[mi][0][reg])), a1 = bf2f(f2bf(acc[mi][1][reg]));
          float ss = a0 * a0 + a1 * a1;
          ss += __shfl_xor(ss, 1); ss += __shfl_xor(ss, 2); ss += __shfl_xor(ss, 4); ss += __shfl_xor(ss, 8); ss += __shfl_xor(ss, 16);
          mxn = fmaxf(mxn, ss);
        }
      mxn = fmaxf(mxn, __shfl_xor(mxn, 32));
      if (lane == 0) atomicMax((unsigned*)(ws + OFF_KN2) + l * 8 + b * 4 + (nt - 2) * 2 + wc, __float_as_uint(mxn));
    }
#pragma unroll
    for (int mi = 0; mi < 2; ++mi)
#pragma unroll
      for (int ni = 0; ni < 2; ++ni)
#pragma unroll
        for (int reg = 0; reg < 16; ++reg) {
          const int row = 64 * wr + 32 * mi + crow(reg, h);
          float v = acc[mi][ni][reg];
          if (ni == 0 && rope) {
            const float pv = __shfl_xor(v, 8);
            if (r < 16) {
              const float2 cs = rt[(t0 + row) * 8 + (r & 7)];
              v = (r & 8) ? (pv * cs.y + v * cs.x) : (v * cs.x - pv * cs.y);
            }
          }
          base[(size_t)row * rstride + 32 * ni + r] = f2bf(v * scale);
        }
    return;
  }
  if (nt == 28) {
    float* flog = (float*)(ws + OFF_FLOG);
    float* ngl = (float*)(ws + OFF_NGL);
    if (wc == 0) {
      const int col = r;
      const float fb = (col < 4) ? p.fox_b[l * 4 + col] : 0.f;
#pragma unroll
      for (int mi = 0; mi < 2; ++mi)
#pragma unroll
        for (int reg = 0; reg < 16; ++reg) {
          const int m = m0 + 64 * wr + 32 * mi + crow(reg, h);
          const float v = acc[mi][0][reg];
          if (col < 4) {
            const float xx = v + fb;
            flog[(size_t)m * 4 + col] = fminf(xx, 0.f) - __logf(1.f + __expf(-fabsf(xx)));
          } else if (col < 28) {
            ngl[(size_t)m * 24 + (col - 4)] = sigmf(v);
          }
        }
    }
    return;
  }
  {
    u16* base; int ld; bool silu = true;
    if (nt == 6 || nt == 7) { base = (u16*)(ws + OFF_GATE) + (nt - 6) * 128; ld = 1024; }
    else if (nt >= 8 && nt <= 11) { base = (u16*)(ws + OFF_GLU) + (nt - 8) * 128; ld = 512; silu = false; }
    else if (nt == 12 || nt == 13) { base = (u16*)(ws + OFF_GATE) + 256 + (nt - 12) * 128; ld = 1024; }
    else { base = (u16*)(ws + OFF_GATE) + 512 + (nt - 24) * 128; ld = 1024; }
#pragma unroll
    for (int mi = 0; mi < 2; ++mi)
#pragma unroll
      for (int ni = 0; ni < 2; ++ni)
#pragma unroll
        for (int reg = 0; reg < 16; ++reg) {
          const int m = m0 + 64 * wr + 32 * mi + crow(reg, h);
          float v = acc[mi][ni][reg];
          if (silu) v = siluf(v);
          base[(size_t)m * ld + 64 * wc + 32 * ni + r] = f2bf(v);
        }
  }
}

DI void tail_item(const Params& p, int l, int mt, unsigned lds) {
  char* ws = lptr(p.ws);
  const int tid = ltid(), lane = tid & 63, w = tid >> 6, r = lane & 31, h = lane >> 5;
  const int m0 = mt * 128;
  const u16* ap = (const u16*)(ws + OFF_H) + (size_t)(m0 + 32 * w + r) * 1024 + 8 * h;
  const u16* bp = (const u16*)(ws + OFF_WINT + l * SZ_WINT) + (size_t)(3584 + r) * 1024 + 8 * h;
  f32x16 acc0, acc1;
#pragma unroll
  for (int k = 0; k < 16; ++k) { acc0[k] = 0.f; acc1[k] = 0.f; }
  for (int kb = 0; kb < 8; ++kb) {
    bf16x8 af[8], bf[8];
#pragma unroll
    for (int ks = 0; ks < 8; ++ks) { af[ks] = *(const bf16x8*)(ap + (kb * 8 + ks) * 16); bf[ks] = *(const bf16x8*)(bp + (kb * 8 + ks) * 16); }
#pragma unroll
    for (int ks = 0; ks < 8; ks += 2) { acc0 = MFMA(af[ks], bf[ks], acc0); acc1 = MFMA(af[ks + 1], bf[ks + 1], acc1); }
  }
  if (l == 1) rstd_to_lds((const float*)(ws + OFF_ROWSS), m0, lds);
  float* flog = (float*)(ws + OFF_FLOG);
  float* ngl = (float*)(ws + OFF_NGL);
  const int col = r;
  const float fb = (col < 4) ? p.fox_b[l * 4 + col] : 0.f;
#pragma unroll
  for (int reg = 0; reg < 16; ++reg) {
    const int m = m0 + 32 * w + crow(reg, h);
    float v = acc0[reg] + acc1[reg];
    if (l == 1) v *= *LDSP(float, lds + 4 * (32 * w + crow(reg, h)));
    if (col < 4) {
      const float xx = v + fb;
      flog[(size_t)m * 4 + col] = fminf(xx, 0.f) - __logf(1.f + __expf(-fabsf(xx)));
    } else if (col < 28) {
      ngl[(size_t)m * 24 + (col - 4)] = sigmf(v);
    }
  }
}

DI void gemm2_item(const Params& p, int l, int item, unsigned lds) {
  const int mt = item >> 3, nt = item & 7;
  const int m0 = mt * 128, n0 = nt * 128;
  char* ws = lptr(p.ws);
  const u16* A = (const u16*)(ws + OFF_MIXED) + (size_t)m0 * 1024;
  const u16* B = (const u16*)(ws + OFF_WOUTT) + (size_t)l * 1024 * 1024 + (size_t)n0 * 1024;
  f32x16 acc[2][2];
  gemm_tile<true>(A, 1024, B, 1024, 1024, lds, acc);
  const int tid = ltid(), lane = tid & 63, w = tid >> 6, wr = w >> 1, wc = w & 1, r = lane & 31, h = lane >> 5;
  const float* res = (l == 0) ? p.x : p.out;
  u16* hb = (u16*)(ws + OFF_H);
  float* rowss = (float*)(ws + OFF_ROWSS);
#pragma unroll
  for (int mi = 0; mi < 2; ++mi) {
    const int m = m0 + 64 * wr + 32 * mi + r;
    float ssq = 0.f;
#pragma unroll
    for (int ni = 0; ni < 2; ++ni)
#pragma unroll
      for (int g4 = 0; g4 < 4; ++g4) {
        const int c0 = n0 + 64 * wc + 32 * ni + 8 * g4 + 4 * h;
        const size_t idx = (size_t)m * 1024 + c0;
        const float4 rv = *(const float4*)(res + idx);
        float4 v = {rv.x + acc[mi][ni][4 * g4], rv.y + acc[mi][ni][4 * g4 + 1], rv.z + acc[mi][ni][4 * g4 + 2], rv.w + acc[mi][ni][4 * g4 + 3]};
        *(float4*)(p.out + idx) = v;
        if (l == 0) {
          const float4 gv = *(const float4*)(p.norm_g + 1024 + c0);
          u32x2 o; o[0] = pk2(v.x * gv.x, v.y * gv.y); o[1] = pk2(v.z * gv.z, v.w * gv.w);
          *(u32x2*)(hb + idx) = o;
          ssq = fmaf(v.x, v.x, ssq); ssq = fmaf(v.y, v.y, ssq); ssq = fmaf(v.z, v.z, ssq); ssq = fmaf(v.w, v.w, ssq);
        }
      }
    if (l == 0) {
      ssq += __shfl_xor(ssq, 32);
      if (h == 0) rowss[(size_t)m * 16 + nt * 2 + wc] = ssq;
    }
  }
}

DI void conv_item(const Params& p, int l, int item, unsigned lds) {
  char* ws = lptr(p.ws);
  const int m0 = item * 64, t0 = m0 & 8191;
  const int tid = ltid(), lane = tid & 63, w = tid >> 6;
  const u16* glu = (const u16*)(ws + OFF_GLU);
  const unsigned at = lds + 32768;
  {
    f32x4 wt[31];
    const float* cw = p.conv_w + (size_t)l * 31 * 256 + lane * 4;
#pragma unroll
    for (int k = 0; k < 31; ++k) wt[k] = *(const f32x4*)(cw + k * 256);
    const float4 cb = *(const float4*)(p.conv_b + l * 256 + lane * 4);
    const float4 lg = *(const float4*)(p.conv_ln_g + l * 256 + lane * 4);
    const float4 lb = *(const float4*)(p.conv_ln_b + l * 256 + lane * 4);
    for (int sub = 0; sub < 2; ++sub) {
      const int ts = t0 + 32 * sub;
      __syncthreads();
      {
        const int c8 = (tid & 31) * 8, rsub = tid >> 5;
#pragma unroll
        for (int pb = 0; pb < 8; pb += 4) {
          u32x4 av[4], bv[4];
#pragma unroll
          for (int q = 0; q < 4; ++q) {
            const int i = (pb + q) * 8 + rsub;
            int t = ts - 30 + i; if (t < 0) t = 0; if (t > T_ - 1) t = T_ - 1;
            const size_t m = (size_t)(m0 - t0 + t);
            av[q] = *(const u32x4*)(glu + m * 512 + c8);
            bv[q] = *(const u32x4*)(glu + m * 512 + 256 + c8);
          }
#pragma unroll
          for (int q = 0; q < 4; ++q) {
            const int i = (pb + q) * 8 + rsub;
            const bool ok = (ts - 30 + i) >= 0;
            u32x4 yv;
#pragma unroll
            for (int e = 0; e < 4; ++e) {
              const unsigned y = pk2(bflo(av[q][e]) * sigmf(bflo(bv[q][e])), bfhi(av[q][e]) * sigmf(bfhi(bv[q][e])));
              yv[e] = ok ? y : 0u;
            }
            if (i < 62) *LDSP(u32x4, lds + i * 512 + c8 * 2) = yv;
          }
        }
      }
      __syncthreads();
#pragma unroll 2
      for (int j = 0; j < 8; ++j) {
        const int tt = 8 * w + j;
        float4 o = cb;
#pragma unroll
        for (int k = 0; k < 31; ++k) {
          const u32x2 yy = *LDSP(u32x2, lds + (tt + k) * 512 + lane * 8);
          o.x = fmaf(wt[k][0], bflo(yy[0]), o.x);
          o.y = fmaf(wt[k][1], bfhi(yy[0]), o.y);
          o.z = fmaf(wt[k][2], bflo(yy[1]), o.z);
          o.w = fmaf(wt[k][3], bfhi(yy[1]), o.w);
        }
        float s = o.x + o.y + o.z + o.w;
#pragma unroll
        for (int of = 32; of > 0; of >>= 1) s += __shfl_xor(s, of);
        const float mu = s * (1.f / 256.f);
        const float dx = o.x - mu, dy = o.y - mu, dz = o.z - mu, dw = o.w - mu;
        float vs = dx * dx + dy * dy + dz * dz + dw * dw;
#pragma unroll
        for (int of = 32; of > 0; of >>= 1) vs += __shfl_xor(vs, of);
        const float rs = rsqrtf(vs * (1.f / 256.f) + 1e-6f);
        const float y0 = siluf(dx * rs * lg.x + lb.x), y1 = siluf(dy * rs * lg.y + lb.y);
        const float y2 = siluf(dz * rs * lg.z + lb.z), y3 = siluf(dw * rs * lg.w + lb.w);
        u32x2 pk; pk[0] = pk2(y0, y1); pk[1] = pk2(y2, y3);
        const int row = 32 * sub + tt;
        *LDSP(u32x2, at + row * 512 + (((lane >> 1) ^ (row & 15)) << 4) + 8 * (lane & 1)) = pk;
      }
    }
  }
  __syncthreads();
  const int r = lane & 31, h = lane >> 5;
  const u16* pw = (const u16*)(ws + OFF_PWT) + (size_t)l * 65536 + (size_t)(64 * w + r) * 256 + 8 * h;
  f32x16 acc[2][2];
  zero_acc(acc);
#pragma unroll
  for (int kb = 0; kb < 2; ++kb) {
    bf16x8 bfr[8][2];
#pragma unroll
    for (int ks = 0; ks < 8; ++ks)
#pragma unroll
      for (int ni = 0; ni < 2; ++ni) bfr[ks][ni] = *(const bf16x8*)(pw + (size_t)ni * 32 * 256 + (kb * 8 + ks) * 16);
#pragma unroll
    for (int ks = 0; ks < 8; ++ks) {
      const int kk = kb * 8 + ks;
      bf16x8 af[2];
#pragma unroll
      for (int mi = 0; mi < 2; ++mi) { const int row = 32 * mi + r; af[mi] = *LDSP(bf16x8, at + row * 512 + (((2 * kk + h) ^ (row & 15)) << 4)); }
#pragma unroll
      for (int mi = 0; mi < 2; ++mi)
#pragma unroll
        for (int ni = 0; ni < 2; ++ni) acc[mi][ni] = MFMA(af[mi], bfr[ks][ni], acc[mi][ni]);
    }
  }
  const u16* gate = (const u16*)(ws + OFF_GATE);
  u16* mixed = (u16*)(ws + OFF_MIXED);
#pragma unroll
  for (int mi = 0; mi < 2; ++mi)
#pragma unroll
    for (int ni = 0; ni < 2; ++ni)
#pragma unroll
      for (int reg = 0; reg < 16; ++reg) {
        const size_t idx = (size_t)(m0 + 32 * mi + crow(reg, h)) * 1024 + 256 + 64 * w + 32 * ni + r;
        mixed[idx] = f2bf(acc[mi][ni][reg] * bf2f(gate[idx]));
      }
}

DI void compress_item(const Params& p, int l, int item64, unsigned lds) {
  char* ws = lptr(p.ws);
  const int nh = item64 & 1, item = item64 >> 1;
  const int mtile = item & 3, kv = (item >> 2) & 1, bg = item >> 3;
  const u16* src = (const u16*)(ws + (kv ? OFF_VC : OFF_KC)) + ((size_t)bg * T_ + (size_t)16 * 128 * mtile) * 64;
  const u16* w1t = (const u16*)(ws + OFF_W1T) + (size_t)(l * 2 + kv) * 256 * 2048;
  const u16* w2t = (const u16*)(ws + OFF_W2T) + (size_t)(l * 2 + kv) * 128 * 256;
  const float* bias = (const float*)(ws + OFF_CBIAS) + (l * 2 + kv) * 256;
  u16* hid = (u16*)(ws + OFF_HID) + (size_t)item * 128 * 256;
  const int tid = ltid(), lane = tid & 63, w = tid >> 6, wr = w >> 1, wc = w & 1, r = lane & 31, h = lane >> 5;
  {
    f32x16 acc[2][2];
    gemm_tile<false>(src, 1024, w1t + (size_t)nh * 128 * 2048, 2048, 2048, lds, acc);
#pragma unroll
    for (int ni = 0; ni < 2; ++ni) {
      const int col = nh * 128 + 64 * wc + 32 * ni + r;
      const float bb = bias[col];
#pragma unroll
      for (int mi = 0; mi < 2; ++mi)
#pragma unroll
        for (int reg = 0; reg < 16; ++reg) {
          const int row = 64 * wr + 32 * mi + crow(reg, h);
          hid[(size_t)row * 256 + col] = f2bf(geluf(acc[mi][ni][reg] + bb));
        }
    }
  }
  __threadfence();
  __syncthreads();
  if (tid == 0) {
    const int old = atomicAdd((int*)(ws + OFF_CNT) + l * 32 + item, 1);
    *LDSP(int, lds) = old;
  }
  __syncthreads();
  const int arrived = *LDSP(int, lds);
  if (arrived == 0) return;
  __threadfence();
  f32x16 acc[2][2];
  if (kv == 0) {
    gemm_tile<false>(hid, 256, w2t, 256, 256, lds, acc);
    if (wc == 0) {
      u16* kcmp = (u16*)(ws + OFF_KCMP) + (size_t)bg * 512 * 64;
      const float2* rt = (const float2*)(ws + OFF_ROPE);
#pragma unroll
      for (int mi = 0; mi < 2; ++mi)
#pragma unroll
        for (int ni = 0; ni < 2; ++ni)
#pragma unroll
          for (int reg = 0; reg < 16; ++reg) {
            const int n = 128 * mtile + 64 * wr + 32 * mi + crow(reg, h);
            float v = acc[mi][ni][reg];
            if (ni == 0) {
              const float pv = __shfl_xor(v, 8);
              if (r < 16) {
                int pos = 16 * n + 31; if (pos > 8191) pos = 8191;
                const float2 cs = rt[pos * 8 + (r & 7)];
                v = (r & 8) ? (pv * cs.y + v * cs.x) : (v * cs.x - pv * cs.y);
              }
            }
            kcmp[(size_t)n * 64 + 32 * ni + r] = f2bf(v);
          }
    }
  } else {
    gemm_tile<true>(hid, 256, w2t, 256, 256, lds, acc);
    if (wc == 0) {
      u16* vcmpT = (u16*)(ws + OFF_VCMPT) + (size_t)bg * 64 * 512;
#pragma unroll
      for (int mi = 0; mi < 2; ++mi)
#pragma unroll
        for (int ni = 0; ni < 2; ++ni)
#pragma unroll
          for (int reg = 0; reg < 16; ++reg) {
            const int n = 128 * mtile + 64 * wr + 32 * mi + r;
            const int d = 32 * ni + crow(reg, h);
            vcmpT[(size_t)d * 512 + vperm16(n)] = (n < 511) ? f2bf(acc[mi][ni][reg]) : (u16)0;
          }
    }
  }
  asm volatile("s_waitcnt vmcnt(0)" ::: "memory");
  __syncthreads();
  if (tid == 0) {
    __builtin_amdgcn_fence(__ATOMIC_RELEASE, "agent");
    asm volatile("s_waitcnt vmcnt(0)" ::: "memory");
    __hip_atomic_fetch_add((unsigned*)(ws + OFF_BAR) + 3800 + l * 4 + bg, 1u, __ATOMIC_RELAXED, __HIP_MEMORY_SCOPE_AGENT);
  }
}

struct TileRegs { u32x4 k0, k1, v0, v1; };
DI void tile_gload(TileRegs& tr, const u16* __restrict__ kbase, long kstride, const u16* __restrict__ vbase, long vstride) {
  const int tid = ltid(), row = tid >> 2, c0 = (tid & 3) * 2;
  const u16* kp = kbase + (long)row * kstride + c0 * 8;
  const u16* vp = vbase + (long)row * vstride + c0 * 8;
  tr.k0 = *(const u32x4*)kp; tr.k1 = *(const u32x4*)(kp + 8);
  tr.v0 = *(const u32x4*)vp; tr.v1 = *(const u32x4*)(vp + 8);
}
DI void tile_swrite(const TileRegs& tr, unsigned buf) {
  const int tid = ltid(), row = tid >> 2, c0 = (tid & 3) * 2;
  *LDSP(u32x4, buf + swz(row, c0)) = tr.k0;
  *LDSP(u32x4, buf + swz(row, c0 + 1)) = tr.k1;
  *LDSP(u32x4, buf + 8192 + swz(row, c0)) = tr.v0;
  *LDSP(u32x4, buf + 8192 + swz(row, c0 + 1)) = tr.v1;
}
DI void load_qfrags(bf16x8 (&QB)[2][4], const u16* __restrict__ qrows  ) {
  const int lane = ltid() & 63, r = lane & 31, h = lane >> 5;
#pragma unroll
  for (int ni = 0; ni < 2; ++ni)
#pragma unroll
    for (int ks = 0; ks < 4; ++ks) QB[ni][ks] = *(const bf16x8*)(qrows + (size_t)(32 * ni + r) * 64 + 16 * ks + 8 * h);
}
DI float dpp_xor1(float x) { return __builtin_bit_cast(float, __builtin_amdgcn_mov_dpp(__builtin_bit_cast(int, x), 0xB1, 0xF, 0xF, true)); }
DI float dpp_xor2(float x) { return __builtin_bit_cast(float, __builtin_amdgcn_mov_dpp(__builtin_bit_cast(int, x), 0x4E, 0xF, 0xF, true)); }
DI int dpp_xor1i(int x) { return __builtin_amdgcn_mov_dpp(x, 0xB1, 0xF, 0xF, true); }
DI int dpp_xor2i(int x) { return __builtin_amdgcn_mov_dpp(x, 0x4E, 0xF, 0xF, true); }
DI int dpp_hmi(int x) { return __builtin_amdgcn_mov_dpp(x, 0x141, 0xF, 0xF, true); }
DI float xhalf_max(float x) {
  const unsigned u = __float_as_uint(x);
  const auto rr = __builtin_amdgcn_permlane32_swap(u, u, false, false);
  return fmaxf(__uint_as_float(rr[0]), __uint_as_float(rr[1]));
}
DI float xhalf_sum(float x) {
  const unsigned u = __float_as_uint(x);
  const auto rr = __builtin_amdgcn_permlane32_swap(u, u, false, false);
  return __uint_as_float(rr[0]) + __uint_as_float(rr[1]);
}
template <int MODE, bool BIAS = false>
DI void attn_step1(const bf16x8 (&QB)[2][4], const unsigned Ks, f32x16 (&ot)[2][2], float (&m)[2], float (&l)[2], const int bnd, const bool rowok, const float sc2,
                   const bool first, const float cq = 0.f, const unsigned ck = 0u) {
  const int lane = ltid() & 63, r = lane & 31, h = lane >> 5;
  f32x16 s0, s1;
#pragma unroll
  for (int k = 0; k < 16; ++k) { s0[k] = 0.f; s1[k] = 0.f; }
#pragma unroll
  for (int ks = 0; ks < 4; ++ks) {
    const bf16x8 k0 = *LDSP(bf16x8, Ks + swz(r, 2 * ks + h));
    const bf16x8 k1 = *LDSP(bf16x8, Ks + swz(32 + r, 2 * ks + h));
    s0 = MFMA(k0, QB[0][ks], s0);
    s1 = MFMA(k1, QB[0][ks], s1);
  }
  if (BIAS) {
#pragma unroll
    for (int g4 = 0; g4 < 4; ++g4) {
      const f32x4 ca = *LDSP(f32x4, ck + 4 * (8 * g4 + 4 * h));
      const f32x4 cb = *LDSP(f32x4, ck + 4 * (32 + 8 * g4 + 4 * h));
#pragma unroll
      for (int e = 0; e < 4; ++e) {
        s0[4 * g4 + e] = fmaf(s0[4 * g4 + e], LOG2E, cq - ca[e]);
        s1[4 * g4 + e] = fmaf(s1[4 * g4 + e], LOG2E, cq - cb[e]);
      }
    }
  }
  if (MODE == 1) {
#pragma unroll
    for (int reg = 0; reg < 16; ++reg) {
      const int keyc = (reg & 3) + 8 * (reg >> 2);
      s0[reg] = (keyc <= bnd) ? s0[reg] : -1e30f;
      s1[reg] = (keyc + 32 <= bnd) ? s1[reg] : -1e30f;
    }
  }
  if (MODE == 2) {
#pragma unroll
    for (int reg = 0; reg < 16; ++reg) {
      const int keyc = (reg & 3) + 8 * (reg >> 2);
      s0[reg] = (keyc >= bnd) ? s0[reg] : -1e30f;
      s1[reg] = (keyc + 32 >= bnd) ? s1[reg] : -1e30f;
    }
  }
  if (first) {
    float mx = fmaxf(s0[0], s1[0]);
#pragma unroll
    for (int reg = 1; reg < 16; ++reg) mx = fmaxf(mx, fmaxf(s0[reg], s1[reg]));
    mx = xhalf_max(mx);
    if (MODE == 3) mx = rowok ? mx : -1e30f;
    m[0] = fmaxf(-1e20f, mx);
  }
  float mb = -m[0] * sc2;
  if (MODE == 3) mb = rowok ? mb : -__builtin_inff();
  float rs0 = 0.f, rs1 = 0.f;
#pragma unroll
  for (int reg = 0; reg < 16; ++reg) {
    const float p0 = EXP2(fmaf(s0[reg], sc2, mb)); s0[reg] = p0; rs0 += p0;
    const float p1 = EXP2(fmaf(s1[reg], sc2, mb)); s1[reg] = p1; rs1 += p1;
  }
  l[0] += xhalf_sum(rs0 + rs1);
  const unsigned Vs = Ks + 8192;
#pragma unroll
  for (int kk = 0; kk < 4; ++kk) {
    const int mi = kk >> 1, s = kk & 1;
    u32x4 pk;
#pragma unroll
    for (int i = 0; i < 4; ++i) pk[i] = mi ? pk2(s1[8 * s + 2 * i], s1[8 * s + 2 * i + 1]) : pk2(s0[8 * s + 2 * i], s0[8 * s + 2 * i + 1]);
    const bf16x8 pf = __builtin_bit_cast(bf16x8, pk);
    bf16x8 vf[2];
#pragma unroll
    for (int di = 0; di < 2; ++di) {
      const int d = 32 * di + r;
      const int sw = (d >> 1) & 7;
      vf[di] = *LDSP(bf16x8, Vs + d * 128 + (((4 * mi + 2 * s + h) ^ sw) << 4));
    }
#pragma unroll
    for (int di = 0; di < 2; ++di) ot[di][0] = MFMA(vf[di], pf, ot[di][0]);
  }
}

template <class LoadF, class BodyF>
DI void tile_pipeline(const int n, const unsigned lds, LoadF&& ld, BodyF&& body) {
  TileRegs A, B;
  ld(A, 0);
  __syncthreads();
  tile_swrite(A, lds);
  if (n > 1) ld(A, 1);
  if (n > 2) ld(B, 2);
  __syncthreads();
  int j = 0;
  while (true) {
    body(j, lds);
    if (j + 1 < n) tile_swrite(A, lds + 16384);
    if (j + 3 < n) ld(A, j + 3);
    __syncthreads();
    if (++j >= n) break;
    body(j, lds + 16384);
    if (j + 1 < n) tile_swrite(B, lds);
    if (j + 3 < n) ld(B, j + 3);
    __syncthreads();
    if (++j >= n) break;
  }
}

template <int MI, int NIM>
DI void qk_half(const bf16x8 (&QB)[2][4], const unsigned Ks, f32x16 (&st)[2]) {
  const int lane = ltid() & 63, r = lane & 31, h = lane >> 5;
#pragma unroll
  for (int j = 0; j < 2; ++j)
#pragma unroll
    for (int k = 0; k < 16; ++k) st[j][k] = 0.f;
#pragma unroll
  for (int ks = 0; ks < 4; ++ks) {
    const bf16x8 kf = *LDSP(bf16x8, Ks + swz(32 * MI + r, 2 * ks + h));
#pragma unroll
    for (int ni = 0; ni < 2; ++ni)
      if (NIM & (1 << ni)) st[ni] = MFMA(kf, QB[ni][ks], st[ni]);
  }
}
template <int MI>
DI void mask_hi(f32x16 (&st)[2], const int (&hi)[2]) {
#pragma unroll
  for (int reg = 0; reg < 16; ++reg) {
    const int keyc = 32 * MI + (reg & 3) + 8 * (reg >> 2);
#pragma unroll
    for (int ni = 0; ni < 2; ++ni) st[ni][reg] = (keyc <= hi[ni]) ? st[ni][reg] : -1e30f;
  }
}
template <int MI>
DI void mask_lo(f32x16 (&st)[2], const int (&lo)[2]) {
#pragma unroll
  for (int reg = 0; reg < 16; ++reg) {
    const int keyc = 32 * MI + (reg & 3) + 8 * (reg >> 2);
#pragma unroll
    for (int ni = 0; ni < 2; ++ni) st[ni][reg] = (keyc >= lo[ni]) ? st[ni][reg] : -1e30f;
  }
}
template <int MI, int NIM, bool ROWSEL>
DI void softmax_pv(f32x16 (&st)[2], const unsigned Vs, f32x16 (&ot)[2][2], float (&m)[2], float (&l)[2], const float sc2, const bool (&rowok)[2]) {
  const int lane = ltid() & 63, r = lane & 31, h = lane >> 5;
#pragma unroll
  for (int ni = 0; ni < 2; ++ni) {
    if (!(NIM & (1 << ni))) continue;
    float mx = st[ni][0];
#pragma unroll
    for (int reg = 1; reg < 16; ++reg) mx = fmaxf(mx, st[ni][reg]);
    mx = fmaxf(mx, __shfl_xor(mx, 32));
    if (ROWSEL) mx = rowok[ni] ? mx : -1e30f;
    const float mold = m[ni];
    const float mnew = fmaxf(mold, mx);
    const float alpha = EXP2((mold - mnew) * sc2);
    m[ni] = mnew;
    float mb = -mnew * sc2;
    if (ROWSEL) mb = rowok[ni] ? mb : -__builtin_inff();
    float rs = 0.f;
#pragma unroll
    for (int reg = 0; reg < 16; ++reg) { const float pp = EXP2(fmaf(st[ni][reg], sc2, mb)); st[ni][reg] = pp; rs += pp; }
    rs += __shfl_xor(rs, 32);
    l[ni] = l[ni] * alpha + rs;
    if (__builtin_amdgcn_ballot_w64(mnew > mold) != 0ull) {
#pragma unroll
      for (int di = 0; di < 2; ++di)
#pragma unroll
        for (int reg = 0; reg < 16; ++reg) ot[di][ni][reg] *= alpha;
    }
  }
#pragma unroll
  for (int s = 0; s < 2; ++s) {
    bf16x8 pf[2], vf[2];
#pragma unroll
    for (int ni = 0; ni < 2; ++ni) {
      if (!(NIM & (1 << ni))) continue;
      u32x4 pk;
#pragma unroll
      for (int i = 0; i < 4; ++i) pk[i] = pk2(st[ni][8 * s + 2 * i], st[ni][8 * s + 2 * i + 1]);
      pf[ni] = __builtin_bit_cast(bf16x8, pk);
    }
#pragma unroll
    for (int di = 0; di < 2; ++di) {
      const int d = 32 * di + r;
      const int sw = (d >> 1) & 7;
      const u32x2 lo = *LDSP(u32x2, Vs + d * 128 + (((4 * MI + 2 * s) ^ sw) << 4) + 8 * h);
      const u32x2 hi = *LDSP(u32x2, Vs + d * 128 + (((4 * MI + 2 * s + 1) ^ sw) << 4) + 8 * h);
      u32x4 vv; vv[0] = lo[0]; vv[1] = lo[1]; vv[2] = hi[0]; vv[3] = hi[1];
      vf[di] = __builtin_bit_cast(bf16x8, vv);
    }
#pragma unroll
    for (int di = 0; di < 2; ++di)
#pragma unroll
      for (int ni = 0; ni < 2; ++ni)
        if (NIM & (1 << ni)) ot[di][ni] = MFMA(vf[di], pf[ni], ot[di][ni]);
  }
}
template <int NIM, int MODE>
DI void attn_step(const bf16x8 (&QB)[2][4], const unsigned Ks, f32x16 (&ot)[2][2], float (&m)[2], float (&l)[2], const int (&bnd)[2], const bool (&rowok)[2]) {
  {
    f32x16 st[2];
    qk_half<0, NIM>(QB, Ks, st);
    if (MODE == 1) mask_hi<0>(st, bnd);
    if (MODE == 2) mask_lo<0>(st, bnd);
    softmax_pv<0, NIM, MODE == 3>(st, Ks + 8192, ot, m, l, LOG2E, rowok);
  }
  {
    f32x16 st[2];
    qk_half<1, NIM>(QB, Ks, st);
    if (MODE == 1) mask_hi<1>(st, bnd);
    if (MODE == 2) mask_lo<1>(st, bnd);
    softmax_pv<1, NIM, MODE == 3>(st, Ks + 8192, ot, m, l, LOG2E, rowok);
  }
}

DI void fox_item(const Params& p, int l, int item, unsigned lds) {
  char* ws = lptr(p.ws);
  const int bh = item & 7, qt = 63 - (item >> 3);
  const int b = bh >> 2, hd = bh & 3;
  const int q0 = qt * 128;
  const int tid = ltid(), lane = tid & 63, w = tid >> 6, r = lane & 31, h = lane >> 5;
  const u16* kb = (const u16*)(ws + OFF_FK) + (size_t)bh * T_ * 64;
  const u16* vb = (const u16*)(ws + OFF_FVT) + (size_t)bh * 64 * T_;
  const float* flog = (const float*)(ws + OFF_FLOG) + (size_t)b * T_ * 4 + hd;
  const unsigned rq = lds + 32768, ckb = lds + 32768 + 1024, wsum = lds + 32768 + 1024 + 512;
  __syncthreads();
  bf16x8 QB[2][4];
  {
    const u16* qrows = (const u16*)(ws + OFF_FQ) + ((size_t)bh * T_ + q0 + 32 * w) * 64;
#pragma unroll
    for (int ks = 0; ks < 4; ++ks) { QB[0][ks] = *(const bf16x8*)(qrows + (size_t)r * 64 + 16 * ks + 8 * h); QB[1][ks] = QB[0][ks]; }
  }
  {
    float v = (tid < 128) ? flog[(size_t)(q0 + tid) * 4] * LOG2E : 0.f;
#pragma unroll
    for (int o = 1; o < 64; o <<= 1) { const float u = __shfl_up(v, o); if (lane >= o) v += u; }
    if (tid == 63) *LDSP(float, wsum) = v;
    __syncthreads();
    if (w == 1) v += *LDSP(float, wsum);
    if (tid < 128) *LDSP(float, rq + 4 * tid) = v;
  }
  const int nkt = 2 * qt + 2;
  float qkb;
  {
    const float kn = sqrtf(((const float*)(ws + OFF_KN2))[l * 8 + bh]) * 1.02f + 1e-3f;
    float ss = 0.f;
#pragma unroll
    for (int ks = 0; ks < 4; ++ks)
#pragma unroll
      for (int e = 0; e < 8; ++e) { const float qv = bf2f((u16)QB[0][ks][e]); ss = fmaf(qv, qv, ss); }
    ss = xhalf_sum(ss);
    qkb = sqrtf(ss) * kn * LOG2E;
  }
  TileRegs tr;
  float carry = 0.f;
  float cknext = 0.f;
  tile_gload(tr, kb + (size_t)(nkt - 1) * 64 * 64, 64, vb + (size_t)(nkt - 1) * 64, T_);
  __syncthreads();
  tile_swrite(tr, lds);
  if (w == 0) *LDSP(float, ckb + 4 * lane) = *LDSP(float, rq + 4 * (64 + lane));
  __syncthreads();
  f32x16 ot[2][2]; zero_acc(ot);
  float m[2] = {-1e20f, -1e20f}, ls[2] = {0.f, 0.f};
  const float cq = *LDSP(float, rq + 4 * (32 * w + r));
  int cur = 0;
  for (int kt = nkt - 1; kt >= 0; --kt) {
    const bool more = kt > 0;
    if (more) {
      tile_gload(tr, kb + (size_t)(kt - 1) * 64 * 64, 64, vb + (size_t)(kt - 1) * 64, T_);
      if (w == 0) {
        const int ktn = kt - 1 - 2 * qt;
        if (ktn >= 0) cknext = *LDSP(float, rq + 4 * (64 * ktn + lane));
        else {
          const float v = -flog[(size_t)((kt - 1) * 64 + lane) * 4] * LOG2E;
          float inc = v;
#pragma unroll
          for (int o = 1; o < 64; o <<= 1) { const float u = __shfl_down(inc, o); if (lane + o < 64) inc += u; }
          cknext = carry + inc - v;
          carry += __shfl(inc, 0);
        }
      }
    }
    const int ktp = kt - 2 * qt;
    if (ktp <= 0 || w >= 2) {
      const unsigned Ks = lds + cur * 16384;
      const unsigned ck = ckb + cur * 256;
      const bool masked = (ktp == 1) || (ktp == 0 && w < 2);
      if (masked) attn_step1<1, true>(QB, Ks, ot, m, ls, 32 * w + r - 64 * ktp - 4 * h, true, 1.0f, true, cq, ck);
      else attn_step1<0, true>(QB, Ks, ot, m, ls, 0, true, 1.0f, false, cq, ck);
    }
    if (more) {
      tile_swrite(tr, lds + (cur ^ 1) * 16384);
      if (w == 0) *LDSP(float, ckb + 4 * ((cur ^ 1) * 64 + lane)) = cknext;
    }
    if (kt <= 2 * qt && kt > 0 && (kt & 1) == 0) {
      const float cmin = __shfl(cknext, 63);
      if (w == 0 && lane == 0) *LDSP(float, wsum + 16) = cmin;
      __syncthreads();
      const float cm = *LDSP(float, wsum + 16);
      const bool done = (qkb + cq - cm - m[0] < -40.f);
      if (__syncthreads_and(done ? 1 : 0)) break;
    } else {
      __syncthreads();
    }
    cur ^= 1;
  }
  const u16* gate = (const u16*)(ws + OFF_GATE);
  u16* mixed = (u16*)(ws + OFF_MIXED);
  {
    const float il = 1.f / ls[0];
    const size_t mrow = (size_t)(b * T_ + q0 + 32 * w + r) * 1024 + hd * 64;
#pragma unroll
    for (int di = 0; di < 2; ++di)
#pragma unroll
      for (int g4 = 0; g4 < 4; ++g4) {
        const int d = 32 * di + 8 * g4 + 4 * h;
        const u32x2 gv = *(const u32x2*)(gate + mrow + d);
        u32x2 o;
        o[0] = pk2(ot[di][0][4 * g4] * il * bflo(gv[0]), ot[di][0][4 * g4 + 1] * il * bfhi(gv[0]));
        o[1] = pk2(ot[di][0][4 * g4 + 2] * il * bflo(gv[1]), ot[di][0][4 * g4 + 3] * il * bfhi(gv[1]));
        *(u32x2*)(mixed + mrow + d) = o;
      }
  }
}

DI int tl32() { const int t = ltid(); return ((t >> 6) << 3) + ((t & 31) >> 2); }
DI void nsa_flush32(const Params& p, int mode, f32x16 (&ot)[2][2], const float ls0, int b, int g, int tbase, int br) {
  char* ws = lptr(p.ws);
  const int tid_ = ltid(); const int lane = tid_ & 63, r = lane & 31, h = lane >> 5;
  float* osc = (float*)(ws + OFF_OSC);
  const float* ngl = (const float*)(ws + OFF_NGL);
  const u16* gate = (const u16*)(ws + OFF_GATE);
  u16* mixed = (u16*)(ws + OFF_MIXED);
  const int t = tbase + tl32(), hh = r & 3;
  const size_t m = (size_t)b * T_ + t;
  const float gsig = ngl[m * 24 + (g * 4 + hh) * 3 + br];
  const float sc = (ls0 > 0.f) ? gsig / ls0 : 0.f;
  const size_t cb = m * 512 + (g * 4 + hh) * 64;
#pragma unroll
  for (int di = 0; di < 2; ++di)
#pragma unroll
    for (int g4 = 0; g4 < 4; ++g4) {
      const int d = 32 * di + 8 * g4 + 4 * h;
      float4 v = {ot[di][0][4 * g4] * sc, ot[di][0][4 * g4 + 1] * sc, ot[di][0][4 * g4 + 2] * sc, ot[di][0][4 * g4 + 3] * sc};
      if (mode > 0) { const float4 o = *(const float4*)(osc + cb + d); v.x += o.x; v.y += o.y; v.z += o.z; v.w += o.w; }
      if (mode < 2) *(float4*)(osc + cb + d) = v;
      else {
        const size_t mi2 = m * 1024 + 512 + (g * 4 + hh) * 64 + d;
        const u32x2 gv = *(const u32x2*)(gate + mi2);
        u32x2 o; o[0] = pk2(v.x * bflo(gv[0]), v.y * bfhi(gv[0])); o[1] = pk2(v.z * bflo(gv[1]), v.w * bfhi(gv[1]));
        *(u32x2*)(mixed + mi2) = o;
      }
    }
}

DI void nsa_accum32(const Params& p, f32x16 (&osum)[2], const f32x16 (&ot)[2][2], const float ls0, int b, int g, int tbase, int br, bool first) {
  char* ws = lptr(p.ws);
  const int r = ltid() & 31;
  const float* ngl = (const float*)(ws + OFF_NGL);
  const size_t m = (size_t)b * T_ + tbase + tl32();
  const float gsig = ngl[m * 24 + (g * 4 + (r & 3)) * 3 + br];
  const float sc = (ls0 > 0.f) ? gsig / ls0 : 0.f;
#pragma unroll
  for (int di = 0; di < 2; ++di)
#pragma unroll
    for (int k = 0; k < 16; ++k) osum[di][k] = first ? ot[di][0][k] * sc : fmaf(ot[di][0][k], sc, osum[di][k]);
}
DI void nsa_store32(const Params& p, const f32x16 (&osum)[2], int b, int g, int tbase) {
  char* ws = lptr(p.ws);
  const int lane = ltid() & 63, r = lane & 31, h = lane >> 5;
  const u16* gate = (const u16*)(ws + OFF_GATE);
  u16* mixed = (u16*)(ws + OFF_MIXED);
  const size_t m = (size_t)b * T_ + tbase + tl32();
  const size_t base = m * 1024 + 512 + (g * 4 + (r & 3)) * 64;
#pragma unroll
  for (int di = 0; di < 2; ++di)
#pragma unroll
    for (int g4 = 0; g4 < 4; ++g4) {
      const int d = 32 * di + 8 * g4 + 4 * h;
      const u32x2 gv = *(const u32x2*)(gate + base + d);
      u32x2 o;
      o[0] = pk2(osum[di][4 * g4] * bflo(gv[0]), osum[di][4 * g4 + 1] * bfhi(gv[0]));
      o[1] = pk2(osum[di][4 * g4 + 2] * bflo(gv[1]), osum[di][4 * g4 + 3] * bfhi(gv[1]));
      *(u32x2*)(mixed + base + d) = o;
    }
}

DI void nsa_item32(const Params& p, int l, int item, unsigned lds) {
  char* ws = lptr(p.ws);
  const int bg = item & 3, c32 = 255 - (item >> 2);
  const int b = bg >> 1, g = bg & 1;
  const int tbase = 32 * c32, c = c32 >> 1, toff = tbase & 63;
  const int tid = ltid(), lane = tid & 63, w = tid >> 6, r = lane & 31, h = lane >> 5;
  const unsigned imp = lds + 32768;
  const unsigned selw = lds + 32768 + 16384;
  __syncthreads();
  bf16x8 QB[2][4];
  {
    const u16* qrows = (const u16*)(ws + OFF_NQ) + (((size_t)bg * T_ + tbase) * 4 + 32 * w) * 64;
#pragma unroll
    for (int ks = 0; ks < 4; ++ks) { QB[0][ks] = *(const bf16x8*)(qrows + (size_t)r * 64 + 16 * ks + 8 * h); QB[1][ks] = QB[0][ks]; }
  }
  for (int i = tid; i < 32 * 128; i += 256) *LDSP(float, imp + 4 * i) = 0.f;
  f32x16 ot[2][2];
  f32x16 osum[2];
  float m[2], ls[2];
  const bool rk[2] = {true, true};
  {
    const u16* kb = (const u16*)(ws + OFF_KW) + (size_t)bg * T_ * 64;
    const u16* vb = (const u16*)(ws + OFF_VWT) + (size_t)bg * 64 * T_;
    zero_acc(ot); m[0] = m[1] = -1e20f; ls[0] = ls[1] = 0.f;
    const int jlo = (c >= 8) ? c - 8 : 0;
    tile_pipeline(c - jlo + 1, lds,
      [&](TileRegs& t, int i) __attribute__((always_inline)) { const int j = c - i; tile_gload(t, kb + (size_t)j * 64 * 64, 64, vb + (size_t)j * 64, T_); },
      [&](int i, unsigned Ks) __attribute__((always_inline)) {
        const int j = c - i;
        const bool diag = (j == c), far = (j == c - 8);
        if (diag) attn_step1<1>(QB, Ks, ot, m, ls, toff + tl32() - 4 * h_of(), true, LOG2E, true);
        else if (far) attn_step1<2>(QB, Ks, ot, m, ls, toff + tl32() + 1 - 4 * h_of(), true, LOG2E, false);
        else attn_step1<0>(QB, Ks, ot, m, ls, 0, true, LOG2E, false);
      });
    nsa_accum32(p, osum, ot, ls[0], b, g, tbase, 2, true);
  }
  if (tid == 0 && *LDSP(unsigned, lds + 67540 + 4 * (l * 4 + bg)) == 0u) {
    unsigned* dn = (unsigned*)(ws + OFF_BAR) + 3800 + l * 4 + bg;
    while (__hip_atomic_load(dn, __ATOMIC_RELAXED, __HIP_MEMORY_SCOPE_AGENT) < 8u) __builtin_amdgcn_s_sleep(4);
    __builtin_amdgcn_fence(__ATOMIC_ACQUIRE, "agent");
    asm volatile("s_waitcnt vmcnt(0)" ::: "memory");
    *LDSP(unsigned, lds + 67540 + 4 * (l * 4 + bg)) = 1u;
  }
  __syncthreads();
  const u16* kcb = (const u16*)(ws + OFF_KCMP) + (size_t)bg * 512 * 64;
  const u16* vcb = (const u16*)(ws + OFF_VCMPT) + (size_t)bg * 64 * 512;
  const int nbc = (2 * c32) / 64 + 1;
  {
    zero_acc(ot); m[0] = m[1] = -1e20f; ls[0] = ls[1] = 0.f;
    tile_pipeline(nbc, lds,
      [&](TileRegs& t, int nb) __attribute__((always_inline)) { tile_gload(t, kcb + (size_t)nb * 64 * 64, 64, vcb + (size_t)nb * 64, 512); },
      [&](int nb, unsigned Ks) __attribute__((always_inline)) {
        const int hb = ((tbase + tl32() - 31) >> 4) - 64 * nb - 4 * h_of();
        if (64 * nb + 63 <= ((tbase - 31) >> 4)) attn_step1<0>(QB, Ks, ot, m, ls, hb, true, LOG2E, nb == 0);
        else attn_step1<1>(QB, Ks, ot, m, ls, hb, true, LOG2E, nb == 0);
      });
    nsa_accum32(p, osum, ot, ls[0], b, g, tbase, 0, false);
  }
  if (c >= 16) {
    const float il0 = (ls[0] > 0.f) ? 1.f / ls[0] : 0.f;
#define IMP_HALF(MI)                                                                               \
      {                                                                                            \
        f32x16 st[2];                                                                              \
        qk_half<MI, 1>(QB, Ks, st);                                                                \
        const int tlv = tl32(); const int hbv = ((tbase + tlv - 31) >> 4) - 64 * nb - 4 * h_of();  \
        _Pragma("unroll") for (int g4 = 0; g4 < 4; ++g4) {                                         \
          float pg[4];                                                                             \
          _Pragma("unroll") for (int e = 0; e < 4; ++e) {                                          \
            const int keyc = 32 * MI + 8 * g4 + e;                                                 \
            float pp = (keyc <= hbv) ? EXP2((st[0][4 * g4 + e] - m[0]) * LOG2E) * il0 : 0.f;       \
            pp += dpp_xor1(pp);                                                                    \
            pp += dpp_xor2(pp);                                                                    \
            pg[e] = pp;                                                                            \
          }                                                                                        \
          if ((r & 3) == g4) {                                                                     \
            const int j = 16 * nb + 8 * MI + 2 * g4 + h;                                           \
            const float G = (pg[0] + pg[1]) + (pg[2] + pg[3]);                                     \
            __hip_atomic_fetch_add(LDSP(float, imp + 4 * (tlv * 128 + j)), G, __ATOMIC_RELAXED, __HIP_MEMORY_SCOPE_WORKGROUP); \
            if (j + 1 < 128) __hip_atomic_fetch_add(LDSP(float, imp + 4 * (tlv * 128 + j + 1)), pg[3], __ATOMIC_RELAXED, __HIP_MEMORY_SCOPE_WORKGROUP); \
          }                                                                                        \
        }                                                                                          \
      }
    tile_pipeline(nbc, lds,
      [&](TileRegs& t, int nb) __attribute__((always_inline)) { tile_gload(t, kcb + (size_t)nb * 64 * 64, 64, vcb + (size_t)nb * 64, 512); },
      [&](int nb, unsigned Ks) __attribute__((always_inline)) {
        IMP_HALF(0)
        IMP_HALF(1)
      });
#undef IMP_HALF
  }
  {
    const int tok = tid >> 3, sub = tid & 7;
    unsigned word;
    if (c < 16) {
      word = 0xffffu;
    } else {
      unsigned key[16];
      word = 0;
#pragma unroll
      for (int i = 0; i < 16; ++i) {
        const int j = 16 * sub + i;
        const float v = *LDSP(float, imp + 4 * (tok * 128 + j));
        const bool cand = (j >= 1) && (j <= c - 2);
        key[i] = cand ? (__float_as_uint(v) + 1u) : 0u;
        if (j == 0 || j == c || j == c - 1) word |= (1u << i);
      }
      unsigned thr = 0;
      for (int bit = 30; bit >= 0; --bit) {
        const unsigned cd = thr | (1u << bit);
        int cnt = 0;
#pragma unroll
        for (int i = 0; i < 16; ++i) cnt += (key[i] >= cd) ? 1 : 0;
        cnt += dpp_xor1i(cnt);
        cnt += dpp_xor2i(cnt);
        cnt += dpp_hmi(cnt);
        if (cnt >= 13) thr = cd;
      }
      int gt = 0, eq = 0;
#pragma unroll
      for (int i = 0; i < 16; ++i) { gt += (key[i] > thr) ? 1 : 0; eq += (key[i] == thr) ? 1 : 0; }
      int gtt = gt; gtt += dpp_xor1i(gtt); gtt += dpp_xor2i(gtt); gtt += dpp_hmi(gtt);
      int eqb = 0;
#pragma unroll
      for (int k = 0; k < 7; ++k) { const int ek = __shfl(eq, (lane & ~7) + k); if (sub > k) eqb += ek; }
      int need = 13 - gtt - eqb;
#pragma unroll
      for (int i = 0; i < 16; ++i) {
        if (key[i] > thr) word |= (1u << i);
        else if (key[i] == thr && thr != 0u) { if (need > 0) word |= (1u << i); --need; }
      }
    }
    *LDSP(u16, selw + 16 * tok + 2 * sub) = (u16)word;
  }
  __syncthreads();
  {
    const u16* kb = (const u16*)(ws + OFF_KS) + (size_t)bg * T_ * 64;
    const u16* vb = (const u16*)(ws + OFF_VST) + (size_t)bg * 64 * T_;
    zero_acc(ot); m[0] = m[1] = -1e20f; ls[0] = ls[1] = 0.f;
    tile_pipeline(c + 1, lds,
      [&](TileRegs& t, int j) __attribute__((always_inline)) { tile_gload(t, kb + (size_t)j * 64 * 64, 64, vb + (size_t)j * 64, T_); },
      [&](int j, unsigned Ks) __attribute__((always_inline)) {
        const bool selb = ((*LDSP(unsigned, selw + 16 * tl32() + 4 * (j >> 5)) >> (j & 31)) & 1u) != 0u;
        if (j == c) {
          attn_step1<1>(QB, Ks, ot, m, ls, toff + tl32() - 4 * h_of(), true, LOG2E, j == 0);
        } else {
          if (__builtin_amdgcn_ballot_w64(selb) != 0ull) attn_step1<3>(QB, Ks, ot, m, ls, 0, selb, LOG2E, j == 0);
        }
        if (PROBE_REP == 7) attn_step1<3>(QB, Ks, ot, m, ls, 0, false, LOG2E, false);
      });
    nsa_accum32(p, osum, ot, ls[0], b, g, tbase, 1, false);
    nsa_store32(p, osum, b, g, tbase);
  }
}

#define XB_TMO      128
#define XB_XCNT(j)  (256  + 64 * (j))
#define XB_XSUB(j)  (1280 + 64 * (j))
#define XB_XGEN(j)  (2304 + 64 * (j))
#define XB_TOP      3328
#define XB_TOPGEN   3392
#define XCD_BAR_WORDS 3456
#define XB_SPIN_CAP (1u << 18)
#define LAS __attribute__((address_space(3)))

__device__ __forceinline__ unsigned xb_ld(unsigned* p)              { return __hip_atomic_load(p, __ATOMIC_RELAXED, __HIP_MEMORY_SCOPE_AGENT); }
__device__ __forceinline__ unsigned xb_add(unsigned* p, unsigned v) { return __hip_atomic_fetch_add(p, v, __ATOMIC_RELAXED, __HIP_MEMORY_SCOPE_AGENT); }
__device__ __forceinline__ unsigned xb_xcc_id() { return (unsigned)__builtin_amdgcn_s_getreg((3 << 11) | 20) & 0xFu; }
#define XB_SPIN(cond, bar) do { unsigned _sp = 0; while (cond) { __builtin_amdgcn_s_sleep(1); \
    if ((++_sp & 255u) == 0u) { if (xb_ld(&(bar)[XB_TMO])) break; if (_sp > XB_SPIN_CAP) { atomicAdd(&(bar)[XB_TMO], 1u); break; } } } } while (0)

struct XcdBarrier {
    unsigned* bar; unsigned x;
    volatile LAS unsigned* st;
};

__device__ __forceinline__ XcdBarrier xcd_barrier_post(unsigned* bar, volatile LAS unsigned* st) {
    XcdBarrier b; b.bar = bar; b.x = xb_xcc_id(); b.st = st;
    if (threadIdx.x == 0) (void)xb_add(&bar[XB_XCNT(b.x)], 1u);
    return b;
}
__device__ __forceinline__ void xcd_barrier_complete(unsigned* bar, unsigned x, unsigned& nloc, unsigned& nx) {
    const unsigned G = gridDim.x * gridDim.y * gridDim.z;
    unsigned sum, cnt, mine, sp = 0u;
    for (;;) {
        sum = 0u; cnt = 0u; mine = 0u;
#pragma unroll
        for (unsigned j = 0; j < 16; ++j) { const unsigned c = xb_ld(&bar[XB_XCNT(j)]); sum += c; cnt += (c > 0u) ? 1u : 0u; mine = (j == x) ? c : mine; }
        if (sum == G) break;
        __builtin_amdgcn_s_sleep(1);
        if ((++sp & 255u) == 0u) { if (xb_ld(&bar[XB_TMO])) break; if (sp > XB_SPIN_CAP) { atomicAdd(&bar[XB_TMO], 1u); break; } }
    }
    nloc = mine > 0u ? mine : 1u; nx = cnt > 0u ? cnt : 1u;
}

__device__ __forceinline__ void xcd_barrier(const XcdBarrier& b) {
    asm volatile("s_waitcnt vmcnt(0)" ::: "memory");
    __syncthreads();
    if (threadIdx.x == 0) {
        unsigned* bar = b.bar;
        __builtin_amdgcn_s_waitcnt(0);
        unsigned nloc = b.st[0], nx = b.st[1];
        if (nloc == 0u) { xcd_barrier_complete(bar, b.x, nloc, nx); b.st[0] = nloc; b.st[1] = nx; }
        const unsigned old = xb_add(&bar[XB_XSUB(b.x)], 1u);
        const unsigned gen = old / nloc;
        if (old + 1u == (gen + 1u) * nloc) {
            __builtin_amdgcn_fence(__ATOMIC_RELEASE, "agent");
            asm volatile("s_waitcnt vmcnt(0)" ::: "memory");
            const unsigned og = xb_add(&bar[XB_TOP], 1u);
            const unsigned tg = og / nx;
            if (og + 1u == (tg + 1u) * nx) xb_add(&bar[XB_TOPGEN], 1u);
            else XB_SPIN(xb_ld(&bar[XB_TOPGEN]) == tg, bar);
            __builtin_amdgcn_fence(__ATOMIC_ACQUIRE, "agent");
            xb_add(&bar[XB_XGEN(b.x)], 1u);
            asm volatile("s_waitcnt vmcnt(0)" ::: "memory");
        } else {
            XB_SPIN(xb_ld(&bar[XB_XGEN(b.x)]) == gen, bar);
            __builtin_amdgcn_fence(__ATOMIC_ACQUIRE, "agent");
            asm volatile("s_waitcnt vmcnt(0)" ::: "memory");
        }
    }
    __syncthreads();
}


__global__ void __launch_bounds__(256, 2) fwd_megakernel(Params p) {
  cg::grid_group grid = cg::this_grid();
  __shared__ __attribute__((aligned(16))) char lds_arr[LDS_BYTES];
  const unsigned lds = (unsigned)(size_t)lds_arr;
  if (threadIdx.x < 16) *LDSP(unsigned, lds + 67520 + 4 * threadIdx.x) = 0u;
  __syncthreads();
  const XcdBarrier xb = xcd_barrier_post((unsigned*)(p.ws + OFF_BAR), (volatile LAS unsigned*)(lds + 67520));
#define GSYNC() xcd_barrier(xb)
  if (gridDim.x == 0x7fffffffu) grid.sync();
  const int G = gridDim.x, bid = blockIdx.x;
  for (int whole = 0; whole < (PROBE_REP == 6 ? 2 : 1); ++whole) {
  if (whole) GSYNC();
  for (int rep0 = 0; rep0 < (PROBE_REP == 4 ? 2 : 1); ++rep0) {
  for (int i = bid; i < 2 * P0_PER_LAYER; i += G) phase0_item(p, i, lds);
  for (int i = G - 1 - bid; i < 32; i += G) cbias_item(p, i, lds);
  if (bid == 0 && threadIdx.x < 128) ((unsigned*)(p.ws + OFF_KN2))[threadIdx.x] = 0u;
  for (int i = bid; i < 256; i += G) rope_item(p, i);
  for (int i = bid; i < BT / 4; i += G) norm_item(p.x, p.norm_g, (u16*)(p.ws + OFF_H), nullptr, i, nullptr, nullptr, nullptr, nullptr);
  }
  GSYNC();
  for (int l = 0; l < 2; ++l) {
    for (int rep = 0; rep < (PROBE_REP == 1 ? 2 : 1); ++rep) {
    if (rep) GSYNC();
    if (G == 512 && false) {
      const int xcd = bid & 7, lb = bid >> 3, y = xcd >> 1;
      for (int k = lb; k < 448; k += 64) {
        int mt, nt;
        if ((xcd & 1) == 0) {
          if (k < 256) { mt = k >> 2; nt = 7 * y + (k & 3); } else { const int k2 = k - 256; mt = 64 + k2 / 3; nt = 7 * y + k2 % 3; }
        } else {
          if (k < 192) { mt = k / 3; nt = 7 * y + 4 + k % 3; } else { const int k2 = k - 192; mt = 64 + (k2 >> 2); nt = 7 * y + 3 + (k2 & 3); }
        }
        gemm1_item(p, l, mt * 29 + nt, lds);
      }
    } else {
      for (int i = bid; i < 128 * 28; i += G) gemm1_item(p, l, (i / 28) * 29 + (i % 28), lds);
    }
    for (int i = bid; i < 128; i += G) tail_item(p, l, i, lds);
    }
    GSYNC();
    {
      int i = bid;
      unsigned* qctr = (unsigned*)(p.ws + OFF_BAR) + 3600 + 64 * l;
      while (i < 64 + 512 + 256 + 1024) {
        if (i < 64) {
          compress_item(p, l, i, lds);
        } else if (i < 576) {
          fox_item(p, l, i - 64, lds);
        } else if (i < 832) {
          conv_item(p, l, i - 576, lds);
        } else {
          nsa_item32(p, l, i - 832, lds);
        }
        __syncthreads();
        if (threadIdx.x == 0) *LDSP(unsigned, lds + 67536) = (unsigned)G + __hip_atomic_fetch_add(qctr, 1u, __ATOMIC_RELAXED, __HIP_MEMORY_SCOPE_AGENT);
        __syncthreads();
        i = (int)*LDSP(unsigned, lds + 67536);
      }
    }
    GSYNC();
    if (G == 512) {
      const int xcd = bid & 7, lb = bid >> 3;
      for (int k = lb; k < 128; k += 64) gemm2_item(p, l, xcd * 128 + k, lds);
    } else {
      for (int i = bid; i < 1024; i += G) gemm2_item(p, l, i, lds);
    }
    GSYNC();
    if (l == 1) for (int i = bid; i < BT / 4; i += G) norm_item(p.out, p.final_g, nullptr, p.out, i, nullptr, nullptr, nullptr, nullptr);
  }
  }
}

__global__ void zero_mixed(unsigned* m, size_t n) {
  size_t i = (size_t)blockIdx.x * blockDim.x + threadIdx.x;
  if (i < n) m[i] = 0;
}

extern "C" void kernel_launch(void* const* d_in, const int* in_sizes, int n_in, void* d_out,
                              int out_size, void* d_ws, size_t ws_size, hipStream_t stream) {
  static int grid_blocks = 0;
  if (!grid_blocks) {
    int dev = 0, cus = 0, per_cu = 0;
    (void)hipGetDevice(&dev);
    (void)hipDeviceGetAttribute(&cus, hipDeviceAttributeMultiprocessorCount, dev);
    (void)hipOccupancyMaxActiveBlocksPerMultiprocessor(&per_cu, fwd_megakernel, 256, 0);
    if (per_cu > 2) per_cu = 2;
    if (per_cu < 1) per_cu = 1;
    grid_blocks = cus * per_cu;
  }
  Params p{};
  p.x = (const float*)d_in[0]; p.norm_g = (const float*)d_in[1]; p.w_in = (const float*)d_in[2]; p.fox_b = (const float*)d_in[3];
  p.conv_w = (const float*)d_in[4]; p.conv_b = (const float*)d_in[5]; p.conv_ln_g = (const float*)d_in[6]; p.conv_ln_b = (const float*)d_in[7];
  p.conv_pw = (const float*)d_in[8]; p.cmp_pe_k = (const float*)d_in[9]; p.cmp_pe_v = (const float*)d_in[10];
  p.cmp_k_w1 = (const float*)d_in[11]; p.cmp_k_w2 = (const float*)d_in[12]; p.cmp_v_w1 = (const float*)d_in[13]; p.cmp_v_w2 = (const float*)d_in[14];
  p.w_out = (const float*)d_in[15]; p.final_g = (const float*)d_in[16];
  p.out = (float*)d_out; p.ws = (char*)d_ws;
#if !(EN_FOX && EN_NSA)
  {
    size_t n = (size_t)BT * 1024 / 2;
    zero_mixed<<<(unsigned)((n + 255) / 256), 256, 0, stream>>>((unsigned*)((char*)d_ws + OFF_MIXED), n);
  }
#endif
  (void)hipMemsetAsync((char*)d_ws + OFF_BAR, 0, 16384, stream);
  void* args[] = {&p};
  hipError_t e = hipLaunchCooperativeKernel((void*)fwd_megakernel, dim3(grid_blocks), dim3(256), args, 0, stream);
  if (e != hipSuccess) fprintf(stderr, "cooperative launch failed: %s (grid %d)\n", hipGetErrorString(e), grid_blocks);
}
```
